# Optimizing an MI355X kernel written in HIP

```python
import math
import jax, jax.numpy as jnp
from jax import lax
import numpy as np

D_MODEL = 2048
BATCH = 32
SEQ = 256
DEPTH = 4
DEC_BATCH = 4
DEC_SEQ = 4096
PAST_LEN = 512

GRID_W = 64
BLOCK = 128
HEAD_DIM = 64
N_FREQ = HEAD_DIM // 4
ROPE_BASE = 10000.0
ATTN_SCALE = HEAD_DIM ** -0.5
RMS_EPS = 1e-6
N_MOD = 6
N_BRANCH = 4
BRANCH_W = D_MODEL // 4
LRU_W = BRANCH_W
LRU_BLOCKS = 8
LRU_BW = LRU_W // LRU_BLOCKS
LRU_C = 8.0
CONV_W = 4
CONV_PAD = (1, 2)
WIN_HEADS = BRANCH_W // HEAD_DIM
WIN_KV = 2
WIN_G = WIN_HEADS // WIN_KV
WINDOW = 128
GRID_HEADS = BRANCH_W // HEAD_DIM
GRID_KV = 2
GRID_G = GRID_HEADS // GRID_KV
DIFF_HEADS = BRANCH_W // (2 * HEAD_DIM)
D_FF = 4 * D_MODEL
IN_SIZES = (LRU_W, LRU_W,
            WIN_HEADS * HEAD_DIM, WIN_KV * HEAD_DIM, WIN_KV * HEAD_DIM,
            GRID_HEADS * HEAD_DIM, GRID_KV * HEAD_DIM, GRID_KV * HEAD_DIM,
            DIFF_HEADS * 2 * HEAD_DIM, DIFF_HEADS * 2 * HEAD_DIM, DIFF_HEADS * 2 * HEAD_DIM)
D_IN = sum(IN_SIZES)

kernel_name = 'hybrid_flow_prefix_trunk_step'


def rms_norm(x, g, eps=RMS_EPS):
    xf = x.astype(jnp.float32)
    y = xf * lax.rsqrt(jnp.mean(xf * xf, axis=-1, keepdims=True) + eps)
    return y.astype(x.dtype) * g


def modulation(cond, w_ada, b_ada):
    m = jax.nn.silu(cond) @ w_ada + b_ada
    return m.reshape(m.shape[:-1] + (N_MOD, D_MODEL))


def grid_rope(n_tokens):
    n_rows = n_tokens // GRID_W
    row = jnp.repeat(jnp.arange(n_rows, dtype=jnp.float32), GRID_W)
    col = jnp.tile(jnp.arange(GRID_W, dtype=jnp.float32), n_rows)
    inv = ROPE_BASE ** (-jnp.arange(N_FREQ, dtype=jnp.float32) / N_FREQ)
    ang = jnp.stack([row[:, None] * inv, col[:, None] * inv], axis=1)
    return jnp.cos(ang), jnp.sin(ang)


def apply_rope(x, cos, sin):
    shp = x.shape
    xr = x.reshape(shp[0], shp[1], -1, 2, 2, N_FREQ)
    x1, x2 = xr[..., 0, :], xr[..., 1, :]
    c = cos[None, :, None].astype(x.dtype)
    s = sin[None, :, None].astype(x.dtype)
    out = jnp.stack([x1 * c - x2 * s, x2 * c + x1 * s], axis=-2)
    return out.reshape(shp)


def sweep_query_blocks(fn, q):
    b, t = q.shape[0], q.shape[1]
    nb = t // BLOCK
    qb = jnp.moveaxis(q.reshape((b, nb, BLOCK) + q.shape[2:]), 1, 0)
    out = lax.map(fn, qb)
    return jnp.moveaxis(out, 0, 1).reshape((b, t) + out.shape[3:])


def gqa_dense(qb, k, v, sink):
    s = jnp.einsum('bqhgd,bkhd->bhgqk', qb, k, preferred_element_type=jnp.float32) * ATTN_SCALE
    n_keys = k.shape[1]
    if sink is not None:
        sink_col = jnp.broadcast_to(sink.astype(jnp.float32)[None, :, :, None, None], s.shape[:-1] + (1,))
        s = jnp.concatenate([s, sink_col], axis=-1)
    p = jax.nn.softmax(s, axis=-1)[..., :n_keys]
    return jnp.einsum('bhgqk,bkhd->bqhgd', p.astype(v.dtype), v)


def banded_window_attention(q, k, v, kc, vc, sink):
    b, t = q.shape[0], q.shape[1]
    nb = t // BLOCK
    n_ctx = kc.shape[1]
    qb = q.reshape(b, nb, BLOCK, WIN_KV, WIN_G, HEAD_DIM)
    pad = ((0, 0), (BLOCK, BLOCK), (0, 0), (0, 0))
    kp = jnp.pad(k, pad).reshape(b, nb + 2, BLOCK, WIN_KV, HEAD_DIM)
    vp = jnp.pad(v, pad).reshape(b, nb + 2, BLOCK, WIN_KV, HEAD_DIM)
    kw = jnp.concatenate([kp[:, :-2], kp[:, 1:-1], kp[:, 2:]], axis=2)
    vw = jnp.concatenate([vp[:, :-2], vp[:, 1:-1], vp[:, 2:]], axis=2)
    qpos = jnp.arange(t).reshape(nb, BLOCK)
    kpos = jnp.arange(nb)[:, None] * BLOCK - BLOCK + jnp.arange(3 * BLOCK)[None, :]
    mask = ((jnp.abs(qpos[:, :, None] - kpos[:, None, :]) <= WINDOW)
            & (kpos[:, None, :] >= 0) & (kpos[:, None, :] < t))
    s_loc = jnp.einsum('bnqhgd,bnkhd->bnhgqk', qb, kw, preferred_element_type=jnp.float32) * ATTN_SCALE
    s_loc = jnp.where(mask[None, :, None, None], s_loc, -jnp.inf)
    s_ctx = jnp.einsum('bnqhgd,bshd->bnhgqs', qb, kc, preferred_element_type=jnp.float32) * ATTN_SCALE
    sink_col = jnp.broadcast_to(sink.astype(jnp.float32)[None, None, :, :, None, None], s_loc.shape[:-1] + (1,))
    p = jax.nn.softmax(jnp.concatenate([s_loc, s_ctx, sink_col], axis=-1), axis=-1)
    p_loc = p[..., :3 * BLOCK].astype(v.dtype)
    p_ctx = p[..., 3 * BLOCK:3 * BLOCK + n_ctx].astype(v.dtype)
    out = (jnp.einsum('bnhgqk,bnkhd->bnqhgd', p_loc, vw)
           + jnp.einsum('bnhgqs,bshd->bnqhgd', p_ctx, vc))
    return out.reshape(b, t, WIN_KV * WIN_G * HEAD_DIM)


def diff_dense(qb, k, v, lam):
    s = jnp.einsum('bqhjd,bkhjd->bhjqk', qb, k, preferred_element_type=jnp.float32) * ATTN_SCALE
    p = jax.nn.softmax(s, axis=-1)
    w = p[:, :, 0] - lam * p[:, :, 1]
    return jnp.einsum('bhqk,bkhe->bqhe', w.astype(v.dtype), v)


def lru_combine(left, right):
    a_l, b_l = left
    a_r, b_r = right
    return a_l * a_r, a_r * b_l + b_r


def linear_scan(a, b, h0, reverse):
    if h0 is not None:
        idx = -1 if reverse else 0
        b = b.at[:, idx].add(a[:, idx] * h0)
    _, h = lax.associative_scan(lru_combine, (a, b), reverse=reverse, axis=1)
    return h


def lru_branch(xa, ya, conv_w, conv_b, wr, br, wi, bi, lam, h0):
    b, t, _ = xa.shape
    u = lax.conv_general_dilated(xa, conv_w[:, None, :], window_strides=(1,), padding=[CONV_PAD],
                                 dimension_numbers=('NWC', 'WIO', 'NWC'),
                                 feature_group_count=LRU_W) + conv_b
    ub = u.reshape(b, t, LRU_BLOCKS, LRU_BW)
    r = jax.nn.sigmoid(jnp.einsum('btnc,kncd->btknd', ub, wr, preferred_element_type=jnp.float32)
                       .reshape(b, t, 2, LRU_W) + br)
    ig = jax.nn.sigmoid(jnp.einsum('btnc,kncd->btknd', ub, wi, preferred_element_type=jnp.float32)
                        .reshape(b, t, 2, LRU_W) + bi)
    log_a = -LRU_C * r * jax.nn.softplus(-lam.astype(jnp.float32))
    a = jnp.exp(log_a)
    inp = jnp.sqrt(-jnp.expm1(2.0 * log_a)) * ig * u.astype(jnp.float32)[:, :, None, :]
    h0f = None if h0 is None else h0[:, 0].astype(jnp.float32)
    h0b = None if h0 is None else h0[:, 1].astype(jnp.float32)
    hf = linear_scan(a[:, :, 0], inp[:, :, 0], h0f, False)
    hb = linear_scan(a[:, :, 1], inp[:, :, 1], h0b, True)
    out = (hf + hb).astype(xa.dtype) * jax.nn.gelu(ya)
    final = None if h0 is not None else jnp.stack([hf[:, -1], hb[:, 0]], axis=1).astype(xa.dtype)
    return out, final


def window_branch(q, k, v, qn, kn, sink, rope, ctx_kv):
    b, t, _ = q.shape
    q = rms_norm(q.reshape(b, t, WIN_HEADS, HEAD_DIM), qn)
    k = rms_norm(k.reshape(b, t, WIN_KV, HEAD_DIM), kn)
    v = v.reshape(b, t, WIN_KV, HEAD_DIM)
    sink = sink.reshape(WIN_KV, WIN_G)
    if ctx_kv is None:
        o = sweep_query_blocks(lambda qb: gqa_dense(qb, k, v, sink),
                               q.reshape(b, t, WIN_KV, WIN_G, HEAD_DIM))
    else:
        cos, sin = rope
        qr = apply_rope(q, cos, sin).reshape(b, t, WIN_KV, WIN_G, HEAD_DIM)
        o = banded_window_attention(qr, apply_rope(k, cos, sin), v, ctx_kv[0], ctx_kv[1], sink)
    return o.reshape(b, t, BRANCH_W), k, v


def grid_branch(q, k, v, qn, kn, rope, ctx_kv):
    b, t, _ = q.shape
    q = rms_norm(q.reshape(b, t, GRID_HEADS, HEAD_DIM), qn)
    k = rms_norm(k.reshape(b, t, GRID_KV, HEAD_DIM), kn)
    v = v.reshape(b, t, GRID_KV, HEAD_DIM)
    if ctx_kv is None:
        keys, vals = k, v
    else:
        cos, sin = rope
        q = apply_rope(q, cos, sin)
        keys = jnp.concatenate([apply_rope(k, cos, sin), ctx_kv[0]], axis=1)
        vals = jnp.concatenate([v, ctx_kv[1]], axis=1)
    o = sweep_query_blocks(lambda qb: gqa_dense(qb, keys, vals, None),
                           q.reshape(b, t, GRID_KV, GRID_G, HEAD_DIM))
    return o.reshape(b, t, BRANCH_W), k, v


def diff_branch(q, k, v, qn, kn, lq1, lk1, lq2, lk2, out_g, layer, rope, ctx_kv):
    b, t, _ = q.shape
    q = rms_norm(q.reshape(b, t, DIFF_HEADS, 2, HEAD_DIM), qn)
    k = rms_norm(k.reshape(b, t, DIFF_HEADS, 2, HEAD_DIM), kn)
    v = v.reshape(b, t, DIFF_HEADS, 2 * HEAD_DIM)
    lam_init = 0.8 - 0.6 * math.exp(-0.3 * layer)
    lam = (jnp.exp(jnp.sum(lq1.astype(jnp.float32) * lk1.astype(jnp.float32)))
           - jnp.exp(jnp.sum(lq2.astype(jnp.float32) * lk2.astype(jnp.float32))) + lam_init)
    if ctx_kv is None:
        keys, vals = k, v
    else:
        cos, sin = rope
        q = apply_rope(q, cos, sin)
        keys = jnp.concatenate([apply_rope(k, cos, sin), ctx_kv[0]], axis=1)
        vals = jnp.concatenate([v, ctx_kv[1]], axis=1)
    o = sweep_query_blocks(lambda qb: diff_dense(qb, keys, vals, lam), q)
    o = rms_norm(o, out_g) * (1.0 - lam_init)
    return o.reshape(b, t, BRANCH_W), k, v


def trunk_layer(x, mod, lp, layer, rope, ctx):
    b, t, _ = x.shape
    shift1, scale1, gate1, shift2, scale2, gate2 = (mod[..., i, :] for i in range(N_MOD))
    h = rms_norm(x, lp['norm1_g']) * (1 + scale1) + shift1
    z = h @ lp['w_in']
    points = [int(p) for p in np.cumsum(IN_SIZES)[:-1]]
    xa, ya, qw, kw, vw, qg, kg, vg, qd, kd, vd = jnp.split(z, points, axis=-1)
    if ctx is None:
        win_ctx = grid_ctx = diff_ctx = lru_h0 = None
    else:
        win_ctx, grid_ctx, diff_ctx, lru_h0 = (ctx[0], ctx[1]), (ctx[2], ctx[3]), (ctx[4], ctx[5]), ctx[6]
    a_out, lru_final = lru_branch(xa, ya, lp['conv_w'], lp['conv_b'], lp['lru_wr'], lp['lru_br'],
                                  lp['lru_wi'], lp['lru_bi'], lp['lru_lambda'], lru_h0)
    w_out, k_w, v_w = window_branch(qw, kw, vw, lp['win_qn'], lp['win_kn'], lp['win_sink'], rope, win_ctx)
    g_out, k_g, v_g = grid_branch(qg, kg, vg, lp['grid_qn'], lp['grid_kn'], rope, grid_ctx)
    d_out, k_d, v_d = diff_branch(qd, kd, vd, lp['diff_qn'], lp['diff_kn'], lp['diff_lq1'], lp['diff_lk1'],
                                  lp['diff_lq2'], lp['diff_lk2'], lp['diff_out_g'], layer, rope, diff_ctx)
    branches = jnp.stack([a_out, w_out, g_out, d_out], axis=2)
    proj = jnp.einsum('btnc,ncd->btnd', branches, lp['w_branch'])
    gates = jax.nn.sigmoid(h @ lp['w_gate'] + lp['b_gate']).reshape(b, t, N_BRANCH, D_MODEL)
    x = x + gate1 * (jnp.sum(gates * proj, axis=2) @ lp['w_o'])
    h2 = rms_norm(x, lp['norm2_g']) * (1 + scale2) + shift2
    ff = jnp.square(jax.nn.relu(h2 @ lp['w_ff1'] + lp['b_ff1'])) @ lp['w_ff2'] + lp['b_ff2']
    x = x + gate2 * ff
    if ctx is None:
        return x, (k_w, v_w, k_g, v_g, k_d, v_d, lru_final)
    return x, None


def setup_inputs(seed: int = 0) -> dict:
    key = jax.random.key(seed)
    ks = iter(jax.random.split(key, 48))

    def nrm(shape, scale):
        return jax.random.normal(next(ks), shape, jnp.float32) * scale

    def gain(shape):
        return 1.0 + nrm(shape, 0.02)

    a_base = jax.random.uniform(next(ks), (DEPTH, 2, LRU_W), jnp.float32, minval=0.9, maxval=0.999)
    s_base = a_base ** (1.0 / LRU_C)
    lru_lambda = jnp.log(s_base) - jnp.log1p(-s_base)
    return {
        'x_prompt': nrm((BATCH, SEQ, D_MODEL), 1.0),
        'x_sample': nrm((DEC_BATCH, DEC_SEQ, D_MODEL), 1.0),
        'cache_win_k': nrm((DEC_BATCH, DEPTH, PAST_LEN, WIN_KV, HEAD_DIM), 1.0),
        'cache_win_v': nrm((DEC_BATCH, DEPTH, PAST_LEN, WIN_KV, HEAD_DIM), 1.0),
        'cache_grid_k': nrm((DEC_BATCH, DEPTH, PAST_LEN, GRID_KV, HEAD_DIM), 1.0),
        'cache_grid_v': nrm((DEC_BATCH, DEPTH, PAST_LEN, GRID_KV, HEAD_DIM), 1.0),
        'cache_diff_k': nrm((DEC_BATCH, DEPTH, PAST_LEN, DIFF_HEADS, 2, HEAD_DIM), 1.0),
        'cache_diff_v': nrm((DEC_BATCH, DEPTH, PAST_LEN, DIFF_HEADS, 2 * HEAD_DIM), 1.0),
        'state_lru': nrm((DEC_BATCH, DEPTH, 2, LRU_W), 0.5),
        'c': nrm((DEC_BATCH, D_MODEL), 1.0),
        'c_ctx': nrm((D_MODEL,), 1.0),
        'w_ada': nrm((DEPTH, D_MODEL, N_MOD * D_MODEL), 0.5 * D_MODEL ** -0.5),
        'b_ada': nrm((DEPTH, N_MOD * D_MODEL), 0.02),
        'norm1_g': gain((DEPTH, D_MODEL)),
        'norm2_g': gain((DEPTH, D_MODEL)),
        'w_in': nrm((DEPTH, D_MODEL, D_IN), D_MODEL ** -0.5),
        'conv_w': nrm((DEPTH, CONV_W, LRU_W), CONV_W ** -0.5),
        'conv_b': nrm((DEPTH, LRU_W), 0.02),
        'lru_wr': nrm((DEPTH, 2, LRU_BLOCKS, LRU_BW, LRU_BW), LRU_BW ** -0.5),
        'lru_br': nrm((DEPTH, 2, LRU_W), 0.1),
        'lru_wi': nrm((DEPTH, 2, LRU_BLOCKS, LRU_BW, LRU_BW), LRU_BW ** -0.5),
        'lru_bi': nrm((DEPTH, 2, LRU_W), 0.1),
        'lru_lambda': lru_lambda,
        'win_qn': gain((DEPTH, HEAD_DIM)),
        'win_kn': gain((DEPTH, HEAD_DIM)),
        'win_sink': nrm((DEPTH, WIN_HEADS), 0.5),
        'grid_qn': gain((DEPTH, HEAD_DIM)),
        'grid_kn': gain((DEPTH, HEAD_DIM)),
        'diff_qn': gain((DEPTH, HEAD_DIM)),
        'diff_kn': gain((DEPTH, HEAD_DIM)),
        'diff_lq1': nrm((DEPTH, HEAD_DIM), 0.1),
        'diff_lk1': nrm((DEPTH, HEAD_DIM), 0.1),
        'diff_lq2': nrm((DEPTH, HEAD_DIM), 0.1),
        'diff_lk2': nrm((DEPTH, HEAD_DIM), 0.1),
        'diff_out_g': gain((DEPTH, 2 * HEAD_DIM)),
        'w_branch': nrm((DEPTH, N_BRANCH, BRANCH_W, D_MODEL), BRANCH_W ** -0.5),
        'w_gate': nrm((DEPTH, D_MODEL, N_BRANCH * D_MODEL), D_MODEL ** -0.5),
        'b_gate': nrm((DEPTH, N_BRANCH * D_MODEL), 0.02),
        'w_o': nrm((DEPTH, D_MODEL, D_MODEL), D_MODEL ** -0.5),
        'w_ff1': nrm((DEPTH, D_MODEL, D_FF), D_MODEL ** -0.5),
        'b_ff1': nrm((DEPTH, D_FF), 0.02),
        'w_ff2': nrm((DEPTH, D_FF, D_MODEL), D_FF ** -0.5),
        'b_ff2': nrm((DEPTH, D_MODEL), 0.02),
    }


def reference(x_prompt, x_sample, cache_win_k, cache_win_v, cache_grid_k, cache_grid_v, cache_diff_k,
              cache_diff_v, state_lru, c, c_ctx, w_ada, b_ada, norm1_g, norm2_g, w_in, conv_w, conv_b,
              lru_wr, lru_br, lru_wi, lru_bi, lru_lambda, win_qn, win_kn, win_sink, grid_qn, grid_kn,
              diff_qn, diff_kn, diff_lq1, diff_lk1, diff_lq2, diff_lk2, diff_out_g, w_branch, w_gate,
              b_gate, w_o, w_ff1, b_ff1, w_ff2, b_ff2):
    rope = grid_rope(x_sample.shape[1])
    y_p, y_s = x_prompt, x_sample
    wk, wv, gk, gv, dk, dv, ls = [], [], [], [], [], [], []
    for l in range(DEPTH):
        lp = {
            'norm1_g': norm1_g[l], 'norm2_g': norm2_g[l], 'w_in': w_in[l],
            'conv_w': conv_w[l], 'conv_b': conv_b[l],
            'lru_wr': lru_wr[l], 'lru_br': lru_br[l], 'lru_wi': lru_wi[l], 'lru_bi': lru_bi[l],
            'lru_lambda': lru_lambda[l],
            'win_qn': win_qn[l], 'win_kn': win_kn[l], 'win_sink': win_sink[l],
            'grid_qn': grid_qn[l], 'grid_kn': grid_kn[l],
            'diff_qn': diff_qn[l], 'diff_kn': diff_kn[l], 'diff_lq1': diff_lq1[l], 'diff_lk1': diff_lk1[l],
            'diff_lq2': diff_lq2[l], 'diff_lk2': diff_lk2[l], 'diff_out_g': diff_out_g[l],
            'w_branch': w_branch[l], 'w_gate': w_gate[l], 'b_gate': b_gate[l], 'w_o': w_o[l],
            'w_ff1': w_ff1[l], 'b_ff1': b_ff1[l], 'w_ff2': w_ff2[l], 'b_ff2': b_ff2[l],
        }
        y_p, ctx_l = trunk_layer(y_p, modulation(c_ctx, w_ada[l], b_ada[l]), lp, l, None, None)
        wk.append(ctx_l[0]); wv.append(ctx_l[1]); gk.append(ctx_l[2]); gv.append(ctx_l[3])
        dk.append(ctx_l[4]); dv.append(ctx_l[5]); ls.append(ctx_l[6])
        cached = (cache_win_k[:, l], cache_win_v[:, l], cache_grid_k[:, l], cache_grid_v[:, l],
                  cache_diff_k[:, l], cache_diff_v[:, l], state_lru[:, l])
        y_s, _ = trunk_layer(y_s, modulation(c, w_ada[l], b_ada[l])[:, None], lp, l, rope, cached)
    new_win_k = jnp.stack(wk, axis=1)
    new_win_v = jnp.stack(wv, axis=1)
    new_grid_k = jnp.stack(gk, axis=1)
    new_grid_v = jnp.stack(gv, axis=1)
    new_diff_k = jnp.stack(dk, axis=1)
    new_diff_v = jnp.stack(dv, axis=1)
    new_lru_state = jnp.stack(ls, axis=1)
    return (y_p, y_s, new_win_k, new_win_v, new_grid_k, new_grid_v, new_diff_k, new_diff_v, new_lru_state)
```

```cpp
#include <hip/hip_runtime.h>
#include <cstdio>
#include <cstdint>

__device__ __forceinline__ float shfl_xor_l(float v, int o, int lane) { return __int_as_float(__builtin_amdgcn_ds_bpermute((lane ^ o) << 2, __float_as_int(v))); }
__device__ __forceinline__ int opaque_tid(int wv) { unsigned m = ~0u; asm volatile("" : "+s"(m), "+s"(wv));
    int t = (wv << 6) | (int)__builtin_amdgcn_mbcnt_hi(m, __builtin_amdgcn_mbcnt_lo(m, 0u)); asm volatile("" : "+v"(t)); return t; }

__device__ __forceinline__ const float* inptr(int i) {
    const float* const __attribute__((address_space(4)))* ka = (const float* const __attribute__((address_space(4)))*)__builtin_amdgcn_kernarg_segment_ptr();
    asm volatile("" : "+s"(i)); return ka[i]; }

#ifndef MULTI
#define MULTI 0
#endif
#ifndef DBG
#define DBG 0
#endif

namespace pg8 {
#define PG8_LAS __attribute__((address_space(3)))
typedef unsigned short bf16_t;
typedef short bf16x8 __attribute__((ext_vector_type(8)));
typedef float f32x4 __attribute__((ext_vector_type(4)));
typedef unsigned u32x4 __attribute__((ext_vector_type(4)));
constexpr int BM = 256, BK = 64, HALF = 128, HTB = HALF * BK * 2  , STAGE_BYTES = 8 * HTB, NXCD = 8, WGM = 4;

__host__ __device__ __forceinline__ int lds_byte(int r, int c) { const int st = (r >> 4) * 2 + (c >> 5), rr = r & 15, cc = c & 31, ob = rr * 64 + cc * 2; return st * 1024 + (ob ^ (((ob >> 9) & 1) << 5)); }
__host__ __device__ __forceinline__ void stage_rc(int b, int& R, int& C) { const int st = b / 1024, sb = b % 1024, swz = sb ^ (((sb >> 9) & 1) << 5); R = (st >> 1) * 16 + swz / 64; C = (st & 1) * 32 + (swz % 64) / 2; }
__host__ __device__ __forceinline__ int perm64(int R) { return 64 * (R >> 5) + 16 * ((R >> 2) & 3) + 4 * ((R >> 4) & 1) + (R & 3); }
__host__ __device__ __forceinline__ int perm32(int rho) { const int n = rho >> 4, i = rho & 15; return 8 * (i >> 2) + 4 * n + (i & 3); }

struct Unit { int pm, pn, kb; };
struct Gemm { const bf16_t* A; const bf16_t* Bt; int M, N, K; size_t a_kb, b_kb; int wv; };

struct StaticOrder {
    int nM, nN, nwg, G, c;
    __host__ __device__ void init(int M, int N, int G_, int c_) { nM = M / BM; nN = N / BM; nwg = nM * nN; G = G_; c = c_; }
    __host__ __device__ bool next(int i, Unit& u) const {
        const long L = (long)i * G + c; if (L >= nwg) return false;
        int wgid = (int)L; { const int q = nwg / NXCD, r = nwg % NXCD, xcd = wgid % NXCD, off = wgid / NXCD; wgid = (xcd < r ? xcd * (q + 1) : r * (q + 1) + (xcd - r) * q) + off; }
        const int nig = WGM * nN, gid = wgid / nig, fm = gid * WGM, gsz = (nM - fm) < WGM ? (nM - fm) : WGM;
        u.pm = fm + ((wgid % nig) % gsz); u.pn = (wgid % nig) / gsz; u.kb = 0; return true;
    }
    __device__ __forceinline__ void a_ready(const Unit&) const {}
    __device__ __forceinline__ void done(const Unit&) const {}
};
struct BankOrder : StaticOrder {
    __host__ __device__ bool next(int i, Unit& u) const { if (!StaticOrder::next(i >> 2, u)) return false; u.kb = i & 3; return true; }
};

typedef float f32x2_t __attribute__((ext_vector_type(2))); typedef __bf16 bf16x2_t __attribute__((ext_vector_type(2)));
__device__ __forceinline__ unsigned cvt_pk_bf16(float lo, float hi) { f32x2_t v = {lo, hi}; bf16x2_t b = __builtin_convertvector(v, bf16x2_t); return __builtin_bit_cast(unsigned, b); }
__device__ __forceinline__ float bf_lo(unsigned u) { return __uint_as_float(u << 16); }
__device__ __forceinline__ float bf_hi(unsigned u) { return __uint_as_float(u & 0xffff0000u); }
__device__ __forceinline__ float sigmoidf_fast(float x) { return __builtin_amdgcn_rcpf(1.0f + __builtin_amdgcn_exp2f(-1.4426950408889634f * x)); }

template <int ACT, bool F8 = false> struct EpiBf16 {
    static constexpr bool PERM = true, AFTER_DRAIN = false, SEG = false, FP8 = F8;
    bf16_t* O; int ldc; const float* bias; int pm_off;
    __device__ __forceinline__ void operator()(const f32x4 (&acc)[2][2][4][2], const Unit& u, int wr, int wc, int fr, int fq) const {
        const int row0 = (u.pm + pm_off) * BM + wr * 64 + fr; const int col0 = u.pn * BM + wc * 32 + 8 * fq;
        f32x4 bv[2][2];
#pragma unroll
        for (int bj = 0; bj < 2; ++bj)
#pragma unroll
            for (int n = 0; n < 2; ++n) bv[bj][n] = (ACT != 0) ? *(const f32x4*)(bias + col0 + bj * HALF + 4 * n) : (f32x4){0.f, 0.f, 0.f, 0.f};
#pragma unroll
        for (int ai = 0; ai < 2; ++ai)
#pragma unroll
            for (int m = 0; m < 4; ++m) { bf16_t* rowp = O + (size_t)(row0 + ai * HALF + m * 16) * ldc + col0;
#pragma unroll
                for (int bj = 0; bj < 2; ++bj) { f32x4 v0 = (F8 ? acc[ai][bj][m][0] * 0.015625f : acc[ai][bj][m][0]) + bv[bj][0], v1 = (F8 ? acc[ai][bj][m][1] * 0.015625f : acc[ai][bj][m][1]) + bv[bj][1];
                    if (ACT == 1) {
#pragma unroll
                        for (int j = 0; j < 4; ++j) { v0[j] = sigmoidf_fast(v0[j]); v1[j] = sigmoidf_fast(v1[j]); } }
                    if (ACT == 2) {
#pragma unroll
                        for (int j = 0; j < 4; ++j) { const float a = fmaxf(v0[j], 0.f), b = fmaxf(v1[j], 0.f); v0[j] = a * a; v1[j] = b * b; } }
                    if (ACT == 3) {
#pragma unroll
                        for (int j = 0; j < 4; ++j) { v0[j] = 1.0f + __builtin_amdgcn_exp2f(-1.4426950408889634f * v0[j]); v1[j] = 1.0f + __builtin_amdgcn_exp2f(-1.4426950408889634f * v1[j]); } }
                    u32x4 w; w.x = cvt_pk_bf16(v0[0], v0[1]); w.y = cvt_pk_bf16(v0[2], v0[3]); w.z = cvt_pk_bf16(v1[0], v1[1]); w.w = cvt_pk_bf16(v1[2], v1[3]);
                    __builtin_nontemporal_store(w, (u32x4*)(rowp + bj * HALF)); } }
    }
};
struct EpiGateU8 {
    static constexpr int PERM = 2; static constexpr bool AFTER_DRAIN = false, SEG = false, FP8 = true;
    unsigned char* O; const float* bias; int pm_off;
    __device__ __forceinline__ void operator()(const f32x4 (&acc)[2][2][4][2], const Unit& u, int wr, int wc, int fr, int fq) const {
        const int row0 = (u.pm + pm_off) * BM + wr * 64 + fr; const int col0 = u.pn * BM + wc * 64 + 16 * fq;
        f32x4 bv[2][2];
#pragma unroll
        for (int bj = 0; bj < 2; ++bj)
#pragma unroll
            for (int n = 0; n < 2; ++n) bv[bj][n] = *(const f32x4*)(bias + col0 + 8 * bj + 4 * n);
#pragma unroll
        for (int ai = 0; ai < 2; ++ai)
#pragma unroll
            for (int m = 0; m < 4; ++m) { u32x4 w;
#pragma unroll
                for (int bj = 0; bj < 2; ++bj)
#pragma unroll
                    for (int n = 0; n < 2; ++n) { const f32x4 v = acc[ai][bj][m][n] * 0.015625f + bv[bj][n]; unsigned q = 0;
#pragma unroll
                        for (int j = 0; j < 4; ++j) {
                            const float t = __builtin_amdgcn_rcpf(0.00390640259f + __builtin_amdgcn_exp2f(-1.4426950408889634f * v[j] - 7.99994364f));
                            q |= (unsigned)(int)t << (8 * j); }
                        w[2 * bj + n] = q; }
                __builtin_nontemporal_store(w, (u32x4*)(O + (size_t)(row0 + ai * HALF + m * 16) * 8192 + col0)); }
    }
};
template <bool SRC_BF, bool DST_BF> struct EpiRes {
    static constexpr bool PERM = true, AFTER_DRAIN = false, SEG = false, FP8 = false;
    const void* b_ctx; const void* b_lat; void* out; const float* gate  ; const float* bias; int pm_off;
    __device__ __forceinline__ void operator()(const f32x4 (&acc)[2][2][4][2], const Unit& u, int wr, int wc, int fr, int fq) const {
        const int pmg = u.pm + pm_off;
        const int row0 = pmg * BM + wr * 64 + fr, col0 = u.pn * BM + wc * 32 + 8 * fq;
        const int cond = pmg < 32 ? 0 : 1 + ((pmg - 32) >> 4);
        const void* base = pmg < 32 ? b_ctx : b_lat; const float* gp = gate + (size_t)cond * (6 * 2048);
        f32x4 bv[2][2], gv[2][2];
#pragma unroll
        for (int bj = 0; bj < 2; ++bj)
#pragma unroll
            for (int n = 0; n < 2; ++n) { bv[bj][n] = bias ? *(const f32x4*)(bias + col0 + bj * HALF + 4 * n) : (f32x4){0.f, 0.f, 0.f, 0.f}; gv[bj][n] = *(const f32x4*)(gp + col0 + bj * HALF + 4 * n); }
        if constexpr (SRC_BF) {
#pragma unroll
            for (int ai = 0; ai < 2; ++ai) {
                u32x4 xr[4][2];
#pragma unroll
                for (int m = 0; m < 4; ++m)
#pragma unroll
                    for (int bj = 0; bj < 2; ++bj) xr[m][bj] = *(const u32x4*)((const bf16_t*)base + (size_t)(row0 + ai * HALF + m * 16) * 2048 + col0 + bj * HALF);
                asm volatile("" ::: "memory");
#pragma unroll
                for (int m = 0; m < 4; ++m) { const size_t off = (size_t)(row0 + ai * HALF + m * 16) * 2048 + col0;
#pragma unroll
                    for (int bj = 0; bj < 2; ++bj) { const u32x4 r = xr[m][bj];
                        const f32x4 x0 = (f32x4){bf_lo(r.x), bf_hi(r.x), bf_lo(r.y), bf_hi(r.y)}, x1 = (f32x4){bf_lo(r.z), bf_hi(r.z), bf_lo(r.w), bf_hi(r.w)};
                        const f32x4 y0 = x0 + gv[bj][0] * (acc[ai][bj][m][0] + bv[bj][0]), y1 = x1 + gv[bj][1] * (acc[ai][bj][m][1] + bv[bj][1]);
                        if (DST_BF) { u32x4 w; w.x = cvt_pk_bf16(y0[0], y0[1]); w.y = cvt_pk_bf16(y0[2], y0[3]); w.z = cvt_pk_bf16(y1[0], y1[1]); w.w = cvt_pk_bf16(y1[2], y1[3]); *(u32x4*)((bf16_t*)out + off + bj * HALF) = w; }
                        else { float* q = (float*)out + off + bj * HALF; *(f32x4*)q = y0; *(f32x4*)(q + 4) = y1; } } }
                asm volatile("" ::: "memory");
            }
        } else {
#pragma unroll
        for (int ai = 0; ai < 2; ++ai)
#pragma unroll
            for (int m = 0; m < 4; ++m) { const size_t off = (size_t)(row0 + ai * HALF + m * 16) * 2048 + col0;
#pragma unroll
                for (int bj = 0; bj < 2; ++bj) { const float* q0 = (const float*)base + off + bj * HALF; const f32x4 x0 = *(const f32x4*)q0, x1 = *(const f32x4*)(q0 + 4);
                    const f32x4 y0 = x0 + gv[bj][0] * (acc[ai][bj][m][0] + bv[bj][0]), y1 = x1 + gv[bj][1] * (acc[ai][bj][m][1] + bv[bj][1]);
                    if (DST_BF) { u32x4 w; w.x = cvt_pk_bf16(y0[0], y0[1]); w.y = cvt_pk_bf16(y0[2], y0[3]); w.z = cvt_pk_bf16(y1[0], y1[1]); w.w = cvt_pk_bf16(y1[2], y1[3]); *(u32x4*)((bf16_t*)out + off + bj * HALF) = w; }
                    else { float* q = (float*)out + off + bj * HALF; *(f32x4*)q = y0; *(f32x4*)(q + 4) = y1; } }
                if (m & 1) asm volatile("" ::: "memory"); }
        }
    }
};
struct EpiMerge {
    static constexpr int PERM = 2; static constexpr bool AFTER_DRAIN = false, SEG = true, FP8 = false;
    const unsigned char* E; bf16_t* O;
    static __device__ __forceinline__ float ub(unsigned w, int j) { return (float)((w >> (8 * j)) & 0xffu); }
    __device__ __forceinline__ void seg(f32x4 (&acc)[2][2][4][2], const Unit& u, int b, int wr, int wc, int fr, int fq) const {
        const unsigned char* ep = E + (size_t)(u.pm * BM + wr * 64 + fr) * 8192 + b * 2048 + u.pn * BM + wc * 64 + 16 * fq;
#pragma unroll
        for (int ai = 0; ai < 2; ++ai) {
            u32x4 e0[4], e1[4];
#pragma unroll
            for (int m = 0; m < 4; ++m) { const unsigned char* q = ep + (size_t)(ai * HALF + m * 16) * 8192; e0[m] = *(const u32x4*)q; e1[m] = *(const u32x4*)(q + 2048); }
#pragma unroll
            for (int m = 0; m < 4; ++m)
#pragma unroll
                for (int bj = 0; bj < 2; ++bj)
#pragma unroll
                    for (int n = 0; n < 2; ++n)
#pragma unroll
                        for (int j = 0; j < 4; ++j) acc[ai][bj][m][n][j] *= (ub(e0[m][2 * bj + n], j) + 0.5f) * __builtin_amdgcn_rcpf(ub(e1[m][2 * bj + n], j) + 0.5f);
            asm volatile("" ::: "memory");
        }
    }
    __device__ __forceinline__ void operator()(const f32x4 (&acc)[2][2][4][2], const Unit& u, int wr, int wc, int fr, int fq) const {
        const int row0 = u.pm * BM + wr * 64 + fr; const int col0 = u.pn * BM + wc * 64 + 16 * fq;
        u32x4 gr[2][4];
#pragma unroll
        for (int ai = 0; ai < 2; ++ai)
#pragma unroll
            for (int m = 0; m < 4; ++m) gr[ai][m] = *(const u32x4*)(E + (size_t)(row0 + ai * HALF + m * 16) * 8192 + 3 * 2048 + col0);
        asm volatile("" ::: "memory");
#pragma unroll
        for (int ai = 0; ai < 2; ++ai)
#pragma unroll
            for (int m = 0; m < 4; ++m) { const size_t row = (size_t)(row0 + ai * HALF + m * 16);
                const u32x4 g = gr[ai][m];
#pragma unroll
                for (int bj = 0; bj < 2; ++bj) { f32x4 v0 = acc[ai][bj][m][0], v1 = acc[ai][bj][m][1];
#pragma unroll
                    for (int j = 0; j < 4; ++j) { v0[j] *= ub(g[2 * bj], j) * 0.00390640259f + 0.001953201295f; v1[j] *= ub(g[2 * bj + 1], j) * 0.00390640259f + 0.001953201295f; }
                    u32x4 w; w.x = cvt_pk_bf16(v0[0], v0[1]); w.y = cvt_pk_bf16(v0[2], v0[3]); w.z = cvt_pk_bf16(v1[0], v1[1]); w.w = cvt_pk_bf16(v1[2], v1[3]);
                    *(u32x4*)(O + row * 2048 + col0 + 8 * bj) = w; } }
    }
};

template <class Epi, class Sched, bool ALIGN_EPI = false, bool SP2 = false>
__device__ __forceinline__ void gemm_phase(PG8_LAS unsigned char* lds, const Gemm g, const Sched& S, const Epi& E) {
    typedef int v4i_t __attribute__((ext_vector_type(4))); typedef int v8i_t __attribute__((ext_vector_type(8)));
    int sc8_ = 0x7F7F7F7F; asm volatile("" : "+v"(sc8_));
    int tid_ = opaque_tid(g.wv);
    const int tid = tid_, wid = __builtin_amdgcn_readfirstlane(tid >> 6), lane = tid & 63, wr = wid >> 2, wc = wid & 3, fr = lane & 15, fq = lane >> 4;
    const int K = g.K, nt = K / BK;
    unsigned voffA[2], voffB[2];
#pragma unroll
    for (int i = 0; i < 2; ++i) { int R, C; stage_rc(tid * 16 + i * 8192, R, C); const int Rb = Epi::PERM == 2 ? perm64(R) : Epi::PERM ? ((R & ~31) + perm32(R & 31)) : R;
        voffA[i] = (unsigned)(R * K + C) * 2u; voffB[i] = (unsigned)(Rb * K + C) * 2u; }
    const size_t kstep = (size_t)(BK * 2);
    const size_t hstep = (size_t)HALF * K * 2;
    const size_t hstepB = Epi::PERM == 2 ? (size_t)(8 * K * 2) : hstep;
    const size_t tstep = 2 * hstep;
    const unsigned ldsw = (unsigned)wid * 1024u; const unsigned ldsbase = (unsigned)__builtin_amdgcn_readfirstlane((int)((unsigned)(unsigned long long)(lds) + (unsigned)wid * 1024u));
    const int aoff = lds_byte(wr * 64 + fr, fq * 8), boff = lds_byte(wc * 32 + fr, fq * 8);
#define PG8_SA(b, h) (((b) * 2 + (h)) * HTB)
#define PG8_SB(b, h) ((4 + (b) * 2 + (h)) * HTB)
#define PG8_STAGE(bufoff, gbase, voff) do { _Pragma("unroll") for (int _i = 0; _i < 2; ++_i) { unsigned keep_; \
        asm volatile("s_mov_b32 %0, m0\n\ts_mov_b32 m0, %3\n\ts_nop 0\n\tglobal_load_lds_dwordx4 %1, %2\n\ts_mov_b32 m0, %0" : "=&s"(keep_) : "v"((voff)[_i]), "s"((const char*)(gbase)), "s"(ldsbase + (unsigned)((bufoff) + _i * 8192)) : "memory"); } } while (0)
#define PG8_LDA(dst, b, h) do { _Pragma("unroll") for (int m = 0; m < 4; ++m) _Pragma("unroll") for (int k = 0; k < 2; ++k) dst[m][k] = *(const PG8_LAS bf16x8*)(lds + PG8_SA(b, h) + aoff + m * 2048 + k * 1024); } while (0)
#define PG8_LDB(dst, b, h) do { _Pragma("unroll") for (int n = 0; n < 2; ++n) _Pragma("unroll") for (int k = 0; k < 2; ++k) dst[n][k] = *(const PG8_LAS bf16x8*)(lds + PG8_SB(b, h) + boff + n * 2048 + k * 1024); } while (0)
#define PG8_CAT8(x0, x1) __builtin_shufflevector(__builtin_bit_cast(v4i_t, x0), __builtin_bit_cast(v4i_t, x1), 0, 1, 2, 3, 4, 5, 6, 7)
#define PG8_MMA(ai, bj, At, Bt) do { __builtin_amdgcn_s_setprio(1); \
        if constexpr (Epi::FP8) { _Pragma("unroll") for (int m = 0; m < 4; ++m) _Pragma("unroll") for (int n = 0; n < 2; ++n) { \
            const v8i_t b8_ = PG8_CAT8(Bt[n][0], Bt[n][1]), a8_ = PG8_CAT8(At[m][0], At[m][1]); \
              \
            asm volatile("v_mfma_scale_f32_16x16x128_f8f6f4 %0, %1, %2, %0, %3, %3 op_sel_hi:[0,0,0]" : "+v"(acc[ai][bj][m][n]) : "v"(b8_), "v"(a8_), "v"(sc8_)); } } \
        else { _Pragma("unroll") for (int m = 0; m < 4; ++m) _Pragma("unroll") for (int n = 0; n < 2; ++n) _Pragma("unroll") for (int k = 0; k < 2; ++k) \
            acc[ai][bj][m][n] = __builtin_amdgcn_mfma_f32_16x16x32_bf16(Bt[n][k], At[m][k], acc[ai][bj][m][n], 0, 0, 0); } \
        __builtin_amdgcn_s_setprio(0); } while (0)
#define PG8_WAIT_V(n) asm volatile("s_waitcnt vmcnt(" #n ")" ::: "memory")
#define PG8_WAIT_L(n) asm volatile("s_waitcnt lgkmcnt(" #n ")" ::: "memory")
#define PG8_BAR __builtin_amdgcn_s_barrier()
#define PG8_SCHED __builtin_amdgcn_sched_barrier(0)
    float zacc_ = 0.f; asm volatile("" : "+v"(zacc_));
    Unit cur, nxt; int ui = 0;
    if (!S.next(0, cur)) return;
    f32x4 acc[2][2][4][2];
#pragma unroll
    for (int a = 0; a < 2; ++a)
#pragma unroll
        for (int b = 0; b < 2; ++b)
#pragma unroll
            for (int m = 0; m < 4; ++m)
#pragma unroll
                for (int n = 0; n < 2; ++n) acc[a][b][m][n] = (f32x4){zacc_, zacc_, zacc_, zacc_};
    bf16x8 At[4][2], B0[2][2], B1[2][2];
    const char* cA = (const char*)g.A + (size_t)cur.kb * g.a_kb + (size_t)cur.pm * tstep; const char* cB = (const char*)g.Bt + (size_t)cur.kb * g.b_kb + (size_t)cur.pn * tstep;
    S.a_ready(cur);
    if constexpr (SP2) {
        PG8_STAGE(PG8_SB(0, 0), cB, voffB); PG8_STAGE(PG8_SB(0, 1), cB + hstepB, voffB); PG8_STAGE(PG8_SA(0, 0), cA, voffA); PG8_STAGE(PG8_SA(0, 1), cA + hstep, voffA);
        if (wr == 1) PG8_BAR;
        PG8_WAIT_V(2); PG8_BAR;
        PG8_STAGE(PG8_SB(1, 0), cB + kstep, voffB); PG8_STAGE(PG8_SA(1, 0), cA + kstep, voffA); PG8_STAGE(PG8_SB(1, 1), cB + hstepB + kstep, voffB);
        PG8_WAIT_V(6); PG8_BAR;
    } else {
        PG8_STAGE(PG8_SB(0, 0), cB, voffB); PG8_STAGE(PG8_SA(0, 0), cA, voffA); PG8_STAGE(PG8_SB(0, 1), cB + hstepB, voffB); PG8_STAGE(PG8_SA(0, 1), cA + hstep, voffA);
        if (wr == 1) PG8_BAR;
        PG8_WAIT_V(4); PG8_BAR;
        PG8_STAGE(PG8_SB(1, 0), cB + kstep, voffB); PG8_STAGE(PG8_SA(1, 0), cA + kstep, voffA); PG8_STAGE(PG8_SB(1, 1), cB + hstepB + kstep, voffB);
        PG8_WAIT_V(6); PG8_BAR;
    }
    for (;;) {
        const bool has_next = S.next(ui + 1, nxt);
        const char* nA = has_next ? (const char*)g.A + (size_t)nxt.kb * g.a_kb + (size_t)nxt.pm * tstep : cA; const char* nB = has_next ? (const char*)g.Bt + (size_t)nxt.kb * g.b_kb + (size_t)nxt.pn * tstep : cB;
        for (int t = 0; t < nt; t += 2) {
            const bool last = (t == nt - 2);
            const char* a1 = cA + (size_t)(t + 1) * kstep;
            const char* a2 = last ? nA : cA + (size_t)(t + 2) * kstep; const char* b2 = last ? nB : cB + (size_t)(t + 2) * kstep;
            const char* a3 = a2 + kstep; const char* b3 = b2 + kstep;
            if (last && has_next) S.a_ready(nxt);
            if constexpr (SP2) {
            PG8_LDB(B0, 0, 0); PG8_LDB(B1, 0, 1); PG8_SCHED; PG8_LDA(At, 0, 0); PG8_STAGE(PG8_SA(1, 1), a1 + hstep, voffA);
            PG8_WAIT_V(8); PG8_WAIT_L(0); PG8_BAR; PG8_MMA(0, 0, At, B0); PG8_MMA(0, 1, At, B1); PG8_BAR; PG8_SCHED;
            PG8_LDA(At, 0, 1); PG8_STAGE(PG8_SB(0, 0), b2, voffB); PG8_STAGE(PG8_SB(0, 1), b2 + hstepB, voffB); PG8_STAGE(PG8_SA(0, 0), a2, voffA);
            PG8_WAIT_V(8); PG8_WAIT_L(0); PG8_BAR; PG8_MMA(1, 0, At, B0); PG8_MMA(1, 1, At, B1); PG8_BAR; PG8_SCHED;
            PG8_LDB(B0, 1, 0); PG8_LDB(B1, 1, 1); PG8_SCHED; PG8_LDA(At, 1, 0); PG8_STAGE(PG8_SA(0, 1), a2 + hstep, voffA);
            PG8_WAIT_V(8); PG8_WAIT_L(0); PG8_BAR; PG8_MMA(0, 0, At, B0); PG8_MMA(0, 1, At, B1); PG8_BAR; PG8_SCHED;
            PG8_LDA(At, 1, 1); PG8_STAGE(PG8_SB(1, 0), b3, voffB); PG8_STAGE(PG8_SB(1, 1), b3 + hstepB, voffB); PG8_STAGE(PG8_SA(1, 0), a3, voffA);
            PG8_WAIT_V(8); PG8_WAIT_L(0); PG8_BAR; PG8_MMA(1, 0, At, B0); PG8_MMA(1, 1, At, B1); PG8_BAR; PG8_SCHED;
            if constexpr (Epi::SEG) { if (((t + 2) & 7) == 0 && !last) { E.seg(acc, cur, ((t + 2) >> 3) - 1, wr, wc, fr, fq); PG8_SCHED; } }
            } else {
            PG8_LDB(B0, 0, 0); PG8_SCHED; PG8_LDA(At, 0, 0); PG8_STAGE(PG8_SA(1, 1), a1 + hstep, voffA);
            PG8_WAIT_L(8); PG8_BAR; PG8_WAIT_L(0); PG8_MMA(0, 0, At, B0); PG8_BAR; PG8_SCHED;
            PG8_LDB(B1, 0, 1); PG8_STAGE(PG8_SB(0, 0), b2, voffB);
            PG8_BAR; PG8_WAIT_L(0); PG8_MMA(0, 1, At, B1); PG8_BAR;
            PG8_LDA(At, 0, 1); PG8_STAGE(PG8_SA(0, 0), a2, voffA);
            PG8_BAR; PG8_WAIT_L(0); PG8_MMA(1, 0, At, B0); PG8_BAR; PG8_SCHED;
            PG8_STAGE(PG8_SB(0, 1), b2 + hstepB, voffB);
            PG8_WAIT_V(6); PG8_BAR; PG8_MMA(1, 1, At, B1); PG8_BAR;
            PG8_LDB(B0, 1, 0); PG8_SCHED; PG8_LDA(At, 1, 0); PG8_STAGE(PG8_SA(0, 1), a2 + hstep, voffA);
            PG8_WAIT_L(8); PG8_BAR; PG8_WAIT_L(0); PG8_MMA(0, 0, At, B0); PG8_BAR; PG8_SCHED;
            PG8_LDB(B1, 1, 1); PG8_STAGE(PG8_SB(1, 0), b3, voffB);
            PG8_BAR; PG8_WAIT_L(0); PG8_MMA(0, 1, At, B1); PG8_BAR;
            PG8_LDA(At, 1, 1); PG8_STAGE(PG8_SA(1, 0), a3, voffA);
            PG8_BAR; PG8_WAIT_L(0); PG8_MMA(1, 0, At, B0); PG8_BAR; PG8_SCHED;
            PG8_STAGE(PG8_SB(1, 1), b3 + hstepB, voffB);
            PG8_WAIT_V(6); PG8_BAR; PG8_MMA(1, 1, At, B1); PG8_BAR;
            }
        }
        if constexpr (ALIGN_EPI) { if (wr == 0) PG8_BAR; }
        if constexpr (Epi::FP8) asm volatile("s_nop 15\n\ts_nop 7" ::: "memory");
        if constexpr (!Epi::AFTER_DRAIN) { E(acc, cur, wr, wc, fr, fq); S.done(cur); }
        if (!has_next) break;
#pragma unroll
        for (int a = 0; a < 2; ++a)
#pragma unroll
            for (int b = 0; b < 2; ++b)
#pragma unroll
                for (int m = 0; m < 4; ++m)
#pragma unroll
                    for (int n = 0; n < 2; ++n) acc[a][b][m][n] = (f32x4){zacc_, zacc_, zacc_, zacc_};
        cur = nxt; cA = nA; cB = nB; ++ui;
        if constexpr (ALIGN_EPI) { if (wr == 1) PG8_BAR; }
    }
    PG8_WAIT_V(0);
    if constexpr (!ALIGN_EPI) { if (wr == 0) PG8_BAR; }
    PG8_BAR;
    if constexpr (Epi::AFTER_DRAIN) { E.fused(acc, cur, wr, wc, fr, fq, lds, wid, lane); S.done(cur); }
#undef PG8_SA
#undef PG8_SB
#undef PG8_STAGE
#undef PG8_LDA
#undef PG8_LDB
#undef PG8_MMA
#undef PG8_CAT8
#undef PG8_WAIT_V
#undef PG8_WAIT_L
#undef PG8_BAR
#undef PG8_SCHED
}
}

constexpr int DMODEL = 2048, DEPTH = 4, NSEQ_C = 32, T_C = 256, NSEQ_L = 4, T_L = 4096, PAST = 512;
constexpr int M_C = NSEQ_C * T_C, M_L = NSEQ_L * T_L, MROWS = M_C + M_L;
constexpr int DIN = 4096, DFF = 8192, BRW = 512, BRP = 2048;
constexpr int ZC_XA = 0, ZC_YA = 512, ZC_QW = 1024, ZC_KW = 1536, ZC_VW = 1664, ZC_QG = 1792, ZC_KG = 2304, ZC_VG = 2432, ZC_QD = 2560, ZC_KD = 3072, ZC_VD = 3584;
enum { I_XP = 0, I_XS, I_CWK, I_CWV, I_CGK, I_CGV, I_CDK, I_CDV, I_SLRU, I_C, I_CCTX, I_WADA, I_BADA, I_N1G, I_N2G, I_WIN, I_CONVW, I_CONVB, I_LWR, I_LBR, I_LWI, I_LBI, I_LLAM,
       I_WQN, I_WKN, I_WSINK, I_GQN, I_GKN, I_DQN, I_DKN, I_LQ1, I_LK1, I_LQ2, I_LK2, I_DOG, I_WBR, I_WGATE, I_BGATE, I_WO, I_WFF1, I_BFF1, I_WFF2, I_BFF2, N_IN };
static_assert(N_IN == 43, "input count");
constexpr size_t O_YP = 0, O_YS = 16777216, O_WK = 50331648, O_WV = 54525952, O_GK = 58720256, O_GV = 62914560, O_DK = 67108864, O_DV = 83886080, O_LS = 100663296, O_END = 100794368;
constexpr float RMS_EPS = 1e-6f;
constexpr float QSCALE = 0.125f * 1.4426950408889634f;

constexpr size_t MiB = 1u << 20;
constexpr size_t WS_CTL = 0;
constexpr size_t WS_MOD = 1 * MiB;
constexpr size_t ZERO_BYTES = 64 * 1024;
constexpr size_t WS_TAB = 2 * MiB;
constexpr int TAB_COS = 0, TAB_SIN = 1024, TAB_SPL = 2048, TAB_LAMD = 2048 + 4096, TAB_LAMI = TAB_LAMD + 4;
constexpr size_t WS_LRUW = 3 * MiB;
constexpr size_t WS_SUM = 4 * MiB;
constexpr size_t WS_CK = 5 * MiB;
constexpr size_t CK_WK = WS_CK, CK_WVT = CK_WK + 2 * MiB, CK_GK = CK_WVT + 2 * MiB, CK_GVT = CK_GK + 2 * MiB, CK_DK = CK_GVT + 2 * MiB, CK_DVT = CK_DK + 8 * MiB;
constexpr size_t WS_VT = 29 * MiB;
constexpr size_t VT_BL = WS_VT, VT_CL = VT_BL + 4 * MiB, VT_DL = VT_CL + 4 * MiB, VT_BC = VT_DL + 16 * MiB, VT_CC = VT_BC + 2 * MiB, VT_DC = VT_CC + 2 * MiB;
constexpr size_t WS_W = 65 * MiB;
constexpr size_t WL_ELEMS = 67108864;
constexpr size_t W_IN_T = 0, W_GATE_T = 8388608, W_BR_T = 25165824, W_O_T = 29360128, W_FF1_T = 33554432, W_FF2_T = 50331648;
constexpr size_t WS_H = 577 * MiB;
constexpr size_t WS_Z = 673 * MiB;
constexpr size_t WS_G = 865 * MiB;
constexpr size_t WS_BR = 1249 * MiB;
constexpr size_t WS_OD = 1345 * MiB;
constexpr size_t WS_W8 = 1393 * MiB;
constexpr size_t WS_H8 = 1457 * MiB;
constexpr size_t WS_LAB = WS_G + 192 * MiB;
constexpr size_t WS_XB = 1505 * MiB;
constexpr size_t WS_END = 1601 * MiB;
constexpr size_t WS_DBG = WS_END;

constexpr int RING_BYTES = 131072, LDSCTL_OFF = RING_BYTES, LDS_BYTES = 147456;

#define GAS __attribute__((address_space(1)))
#define LAS __attribute__((address_space(3)))
typedef unsigned short bf16;
typedef unsigned v4u __attribute__((ext_vector_type(4)));
typedef unsigned v2u __attribute__((ext_vector_type(2)));
typedef float f32x4 __attribute__((ext_vector_type(4)));
typedef float f32x16 __attribute__((ext_vector_type(16)));
typedef short bf16x8 __attribute__((ext_vector_type(8)));
__device__ __forceinline__ unsigned f2bf(float f) { unsigned u = __builtin_bit_cast(unsigned, f); return (u + 0x7fffu + ((u >> 16) & 1u)) >> 16; }
__device__ __forceinline__ unsigned pk2(float lo, float hi) { return f2bf(lo) | (f2bf(hi) << 16); }
__device__ __forceinline__ float bflo(unsigned u) { return __uint_as_float(u << 16); }
__device__ __forceinline__ float bfhi(unsigned u) { return __uint_as_float(u & 0xffff0000u); }
__device__ __forceinline__ float bf2f(bf16 b) { return __uint_as_float(((unsigned)b) << 16); }
__device__ __forceinline__ void unpack8(const v4u r, float (&x)[8]) { x[0] = bflo(r.x); x[1] = bfhi(r.x); x[2] = bflo(r.y); x[3] = bfhi(r.y); x[4] = bflo(r.z); x[5] = bfhi(r.z); x[6] = bflo(r.w); x[7] = bfhi(r.w); }
__device__ __forceinline__ v4u pack8(const float (&x)[8]) { v4u r; r.x = pk2(x[0], x[1]); r.y = pk2(x[2], x[3]); r.z = pk2(x[4], x[5]); r.w = pk2(x[6], x[7]); return r; }
__device__ __forceinline__ int crow(int r, int hi) { return (r & 3) + 8 * (r >> 2) + 4 * hi; }

#define XB_TMO      128
#define XB_XCNT(j)  (256  + 64 * (j))
#define XB_XSUB(j)  (1280 + 64 * (j))
#define XB_XGEN(j)  (2304 + 64 * (j))
#define XB_TOP      3328
#define XB_TOPGEN   3392
#define XCD_BAR_WORDS 3456
#define XB_SPIN_CAP (1u << 18)

__device__ __forceinline__ unsigned xb_ld(unsigned* p)              { return __hip_atomic_load(p, __ATOMIC_RELAXED, __HIP_MEMORY_SCOPE_AGENT); }
__device__ __forceinline__ unsigned xb_add(unsigned* p, unsigned v) { return __hip_atomic_fetch_add(p, v, __ATOMIC_RELAXED, __HIP_MEMORY_SCOPE_AGENT); }
__device__ __forceinline__ unsigned xb_xcc_id() { return (unsigned)__builtin_amdgcn_s_getreg((3 << 11) | 20) & 0xFu; }
#define XB_SPIN(cond, bar) do { unsigned _sp = 0; while (cond) { __builtin_amdgcn_s_sleep(1); \
    if ((++_sp & 255u) == 0u) { if (xb_ld(&(bar)[XB_TMO])) break; if (_sp > XB_SPIN_CAP) { atomicAdd(&(bar)[XB_TMO], 1u); break; } } } } while (0)

struct XcdBarrier {
    unsigned* bar; unsigned x; int wv;
    volatile LAS unsigned* st;
};
__device__ __forceinline__ XcdBarrier xcd_barrier_post(unsigned* bar, volatile LAS unsigned* st, int wv) {
    XcdBarrier b; b.bar = bar; b.x = xb_xcc_id(); b.st = st; b.wv = wv;
    if (opaque_tid(wv) == 0) (void)xb_add(&bar[XB_XCNT(b.x)], 1u);
    return b;
}
__device__ __forceinline__ void xcd_barrier_complete(unsigned* bar, unsigned x, unsigned& nloc, unsigned& nx) {
    const unsigned G = gridDim.x * gridDim.y * gridDim.z;
    unsigned sum, cnt, mine, sp = 0u;
    for (;;) {
        sum = 0u; cnt = 0u; mine = 0u;
#pragma unroll
        for (unsigned j = 0; j < 16; ++j) { const unsigned c = xb_ld(&bar[XB_XCNT(j)]); sum += c; cnt += (c > 0u) ? 1u : 0u; mine = (j == x) ? c : mine; }
        if (sum == G) break;
        __builtin_amdgcn_s_sleep(1);
        if ((++sp & 255u) == 0u) { if (xb_ld(&bar[XB_TMO])) break; if (sp > XB_SPIN_CAP) { atomicAdd(&bar[XB_TMO], 1u); break; } }
    }
    nloc = mine > 0u ? mine : 1u; nx = cnt > 0u ? cnt : 1u;
}
__device__ __forceinline__ void xcd_barrier(const XcdBarrier& b) {
    asm volatile("s_waitcnt vmcnt(0)" ::: "memory");
    __syncthreads();
    if (opaque_tid(b.wv) == 0) {
        unsigned* bar = b.bar;
        __builtin_amdgcn_s_waitcnt(0);
        unsigned nloc = b.st[0], nx = b.st[1];
        if (nloc == 0u) { xcd_barrier_complete(bar, b.x, nloc, nx); b.st[0] = nloc; b.st[1] = nx; }
        const unsigned old = xb_add(&bar[XB_XSUB(b.x)], 1u);
        const unsigned gen = old / nloc;
        if (old + 1u == (gen + 1u) * nloc) {
            __builtin_amdgcn_fence(__ATOMIC_RELEASE, "agent");
            asm volatile("s_waitcnt vmcnt(0)" ::: "memory");
            const unsigned og = xb_add(&bar[XB_TOP], 1u);
            const unsigned tg = og / nx;
            if (og + 1u == (tg + 1u) * nx) xb_add(&bar[XB_TOPGEN], 1u);
            else XB_SPIN(xb_ld(&bar[XB_TOPGEN]) == tg, bar);
            __builtin_amdgcn_fence(__ATOMIC_ACQUIRE, "agent");
            xb_add(&bar[XB_XGEN(b.x)], 1u);
            asm volatile("s_waitcnt vmcnt(0)" ::: "memory");
        } else {
            XB_SPIN(xb_ld(&bar[XB_XGEN(b.x)]) == gen, bar);
            __builtin_amdgcn_fence(__ATOMIC_ACQUIRE, "agent");
            asm volatile("s_waitcnt vmcnt(0)" ::: "memory");
        }
    }
    __syncthreads();
}

struct Params { const float* in[N_IN]; float* out; unsigned char* ws; int ph_lo, ph_hi; };
static_assert(sizeof(Params) == (N_IN + 2) * 8 + 8, "Params has no padding");

__device__ __forceinline__ unsigned char* wsbase(const Params& p) { unsigned long long w = (unsigned long long)p.ws; asm volatile("" : "+s"(w)); return (unsigned char*)w; }
__device__ __forceinline__ bf16* wsb(const Params& p, size_t off) { return (bf16*)(wsbase(p) + off); }
__device__ __forceinline__ float* wsf(const Params& p, size_t off) { return (float*)(wsbase(p) + off); }
__device__ __forceinline__ const float* xbase_ctx(const Params& p, int l) { return l == 0 ? inptr(I_XP) : p.out; }
__device__ __forceinline__ const float* xbase_lat(const Params& p, int l) { return l == 0 ? inptr(I_XS) - (size_t)M_C * DMODEL : p.out; }
__device__ __forceinline__ float wave_sum(float v, int lane) {
#pragma unroll
    for (int o = 1; o < 64; o <<= 1) v += shfl_xor_l(v, o, lane);
    return v;
}

__device__ __forceinline__ void transpose_item(const float* W, int K, int N, bf16* WT, LAS float* scr, int item, int lane, bool vswap = false) {
    const int nblk = N / 32, kb = item / nblk, nb = item % nblk, k0 = 64 * kb, n0 = 32 * nb;
#pragma unroll 8
    for (int i = 0; i < 32; ++i) { const int kk = 2 * i + (lane >> 5); scr[kk * 33 + (lane & 31)] = W[(size_t)(k0 + kk) * N + n0 + (lane & 31)]; }
    asm volatile("s_waitcnt lgkmcnt(0)" ::: "memory");
    const int c = lane & 7;
#pragma unroll
    for (int j = 0; j < 4; ++j) { const int n = (lane >> 3) + 8 * j; const LAS float* s = scr + (8 * c) * 33 + n;
        v4u o; o.x = pk2(s[0 * 33], s[1 * 33]); o.y = pk2(s[2 * 33], s[3 * 33]); o.z = pk2(s[4 * 33], s[5 * 33]); o.w = pk2(s[6 * 33], s[7 * 33]);
        if (vswap) { const LAS float* s2 = scr + (16 * (c >> 1) + 4 * (c & 1)) * 33 + n;
            o.x = pk2(s2[0 * 33], s2[1 * 33]); o.y = pk2(s2[2 * 33], s2[3 * 33]); o.z = pk2(s2[8 * 33], s2[9 * 33]); o.w = pk2(s2[10 * 33], s2[11 * 33]); }
        *(v4u*)(WT + (size_t)(n0 + n) * K + k0 + 8 * c) = o; }
    asm volatile("s_waitcnt lgkmcnt(0)" ::: "memory");
}
__device__ __forceinline__ void transpose_item8(const float* W, int K, int N, unsigned char* WT, LAS float* scr, int item, int lane) {
    const int nblk = N / 32, kb = item / nblk, nb = item % nblk, k0 = 64 * kb, n0 = 32 * nb;
#pragma unroll 8
    for (int i = 0; i < 32; ++i) { const int kk = 2 * i + (lane >> 5); scr[kk * 33 + (lane & 31)] = W[(size_t)(k0 + kk) * N + n0 + (lane & 31)]; }
    asm volatile("s_waitcnt lgkmcnt(0)" ::: "memory");
    const int c = lane & 7;
#pragma unroll
    for (int j = 0; j < 4; ++j) { const int n = (lane >> 3) + 8 * j; const LAS float* s = scr + (8 * c) * 33 + n;
        int lo = 0, hi = 0;
        lo = __builtin_amdgcn_cvt_pk_fp8_f32(s[0 * 33] * 64.f, s[1 * 33] * 64.f, lo, false); lo = __builtin_amdgcn_cvt_pk_fp8_f32(s[2 * 33] * 64.f, s[3 * 33] * 64.f, lo, true);
        hi = __builtin_amdgcn_cvt_pk_fp8_f32(s[4 * 33] * 64.f, s[5 * 33] * 64.f, hi, false); hi = __builtin_amdgcn_cvt_pk_fp8_f32(s[6 * 33] * 64.f, s[7 * 33] * 64.f, hi, true);
        *(v2u*)(WT + (size_t)(n0 + n) * K + k0 + 8 * c) = (v2u){(unsigned)lo, (unsigned)hi}; }
    asm volatile("s_waitcnt lgkmcnt(0)" ::: "memory");
}
constexpr int N_TR_W = 131072, N_TR_ALL = N_TR_W + 512 + 512 + 2048 + 256;
__device__ __forceinline__ void prologue_phase(const Params& p, LAS unsigned char* lds) {
    const int tid = opaque_tid(p.ph_hi), lane = tid & 63, wave = __builtin_amdgcn_readfirstlane(tid >> 6);
    const int G = gridDim.x, gw = blockIdx.x * 8 + wave, NGW = G * 8;
    LAS float* scr = (LAS float*)(lds + wave * 16384);
    for (int it = gw; it < N_TR_ALL; it += NGW) {
        if (it < N_TR_W) {
            const int l = it >> 15; int r = it & 32767; bf16* WL = wsb(p, WS_W) + (size_t)l * WL_ELEMS;
            if (r < 4096) { transpose_item(inptr(I_WIN) + (size_t)l * 2048 * 4096, 2048, 4096, WL + W_IN_T, scr, r, lane); continue; } r -= 4096;
            if (r < 8192) { transpose_item8(inptr(I_WGATE) + (size_t)l * 2048 * 8192, 2048, 8192, p.ws + WS_W8 + (size_t)l * 8192 * 2048, scr, r, lane); continue; } r -= 8192;
            if (r < 2048) { transpose_item(inptr(I_WBR) + (size_t)l * 2048 * 2048, 2048, 2048, WL + W_BR_T, scr, r, lane); continue; } r -= 2048;
            if (r < 2048) { transpose_item(inptr(I_WO) + (size_t)l * 2048 * 2048, 2048, 2048, WL + W_O_T, scr, r, lane); continue; } r -= 2048;
            if (r < 8192) { transpose_item(inptr(I_WFF1) + (size_t)l * 2048 * 8192, 2048, 8192, WL + W_FF1_T, scr, r, lane); continue; } r -= 8192;
            transpose_item(inptr(I_WFF2) + (size_t)l * 8192 * 2048, 8192, 2048, WL + W_FF2_T, scr, r, lane);
        } else {
            int r = it - N_TR_W;
            if (r < 512) { const int bl = r >> 5; transpose_item(inptr(I_CWV) + (size_t)bl * 512 * 128, 512, 128, wsb(p, CK_WVT) + (size_t)bl * 128 * 512, scr, r & 31, lane, true); continue; } r -= 512;
            if (r < 512) { const int bl = r >> 5; transpose_item(inptr(I_CGV) + (size_t)bl * 512 * 128, 512, 128, wsb(p, CK_GVT) + (size_t)bl * 128 * 512, scr, r & 31, lane, true); continue; } r -= 512;
            if (r < 2048) { const int bl = r >> 7; transpose_item(inptr(I_CDV) + (size_t)bl * 512 * 512, 512, 512, wsb(p, CK_DVT) + (size_t)bl * 512 * 512, scr, r & 127, lane, true); continue; } r -= 2048;
            { const int mtx = r >> 1, g = mtx >> 6, lkn = mtx & 63;
              transpose_item(inptr(g ? I_LWI : I_LWR) + (size_t)lkn * 4096, 64, 64, wsb(p, WS_LRUW) + (size_t)(g * 64 + lkn) * 4096, scr, r & 1, lane); }
        }
    }
    {
        const size_t gt = (size_t)blockIdx.x * 512 + tid, NT = (size_t)G * 512;
        for (size_t i = gt; i < 1048576 / 8; i += NT) {
            float x[8]; const f32x4 a = *(const f32x4*)(inptr(I_CWK) + i * 8), b = *(const f32x4*)(inptr(I_CWK) + i * 8 + 4);
            x[0] = a[0]; x[1] = a[1]; x[2] = a[2]; x[3] = a[3]; x[4] = b[0]; x[5] = b[1]; x[6] = b[2]; x[7] = b[3]; *(v4u*)(wsb(p, CK_WK) + i * 8) = pack8(x);
            const f32x4 c = *(const f32x4*)(inptr(I_CGK) + i * 8), d = *(const f32x4*)(inptr(I_CGK) + i * 8 + 4);
            x[0] = c[0]; x[1] = c[1]; x[2] = c[2]; x[3] = c[3]; x[4] = d[0]; x[5] = d[1]; x[6] = d[2]; x[7] = d[3]; *(v4u*)(wsb(p, CK_GK) + i * 8) = pack8(x); }
        for (size_t i = gt; i < 4194304 / 8; i += NT) {
            float x[8]; const f32x4 a = *(const f32x4*)(inptr(I_CDK) + i * 8), b = *(const f32x4*)(inptr(I_CDK) + i * 8 + 4);
            x[0] = a[0]; x[1] = a[1]; x[2] = a[2]; x[3] = a[3]; x[4] = b[0]; x[5] = b[1]; x[6] = b[2]; x[7] = b[3]; *(v4u*)(wsb(p, CK_DK) + i * 8) = pack8(x); }
    }
    if (blockIdx.x == 0) {
        float* tab = wsf(p, WS_TAB);
        if (tid < 16) {
            const double inv = tid == 0 ? 1.0 : tid == 1 ? 0.5623413251903491 : tid == 2 ? 0.31622776601683794 : tid == 3 ? 0.1778279410038923 : tid == 4 ? 0.1 : tid == 5 ? 0.05623413251903491 : tid == 6 ? 0.03162277660168379 :
                tid == 7 ? 0.01778279410038923 : tid == 8 ? 0.01 : tid == 9 ? 0.005623413251903491 : tid == 10 ? 0.0031622776601683794 : tid == 11 ? 0.0017782794100389228 : tid == 12 ? 0.001 : tid == 13 ? 0.0005623413251903491 :
                tid == 14 ? 0.00031622776601683794 : 0.00017782794100389227;
            double c1 = 1.0, s1 = inv, tc = 1.0, tsn = inv; const double x2 = inv * inv;
            for (int k = 1; k <= 14; ++k) { tc = -tc * x2 / (double)((2 * k - 1) * (2 * k)); tsn = -tsn * x2 / (double)((2 * k) * (2 * k + 1)); c1 += tc; s1 += tsn; }
            double c = 1.0, s = 0.0;
            for (int pos = 0; pos < 64; ++pos) { tab[TAB_COS + pos * 16 + tid] = (float)c; tab[TAB_SIN + pos * 16 + tid] = (float)s; const double cn = c * c1 - s * s1, sn = s * c1 + c * s1; c = cn; s = sn; }
        }
        for (int i = tid; i < 4096; i += 512) { const float lam = inptr(I_LLAM)[i]; tab[TAB_SPL + i] = lam > 15.f ? __expf(-lam) : log1pf(__expf(-lam)); }
        if (tid < 4) { float s1 = 0.f, s2 = 0.f; for (int d = 0; d < 64; ++d) { s1 += inptr(I_LQ1)[tid * 64 + d] * inptr(I_LK1)[tid * 64 + d]; s2 += inptr(I_LQ2)[tid * 64 + d] * inptr(I_LK2)[tid * 64 + d]; }
            const float li = 0.8f - 0.6f * expf(-0.3f * (float)tid); tab[TAB_LAMD + tid] = expf(s1) - expf(s2) + li; tab[TAB_LAMI + tid] = li; }
    }
    {
        LAS float* sv = (LAS float*)lds;
        LAS float* red = (LAS float*)(lds + 5 * 2048 * 4);
        float* mod = wsf(p, WS_MOD);
        __syncthreads();
        for (int i = tid; i < 5 * 2048; i += 512) { const int cond = i >> 11, k = i & 2047; const float c = cond == 0 ? inptr(I_CCTX)[k] : inptr(I_C)[(cond - 1) * 2048 + k]; sv[i] = c / (1.0f + __expf(-c)); }
        __syncthreads();
        const int q = tid >> 7, jl = tid & 127;
        for (int it = blockIdx.x; it < 4 * 96; it += G) {
            const int l = it / 96, j = (it % 96) * 128 + jl;
            float a0 = 0.f, a1 = 0.f, a2 = 0.f, a3 = 0.f, a4 = 0.f;
            const float* w = inptr(I_WADA) + ((size_t)l * 2048 + q * 512) * 12288 + j; const LAS float* s0 = sv + q * 512;
#pragma unroll 8
            for (int kk = 0; kk < 512; ++kk) { const float wv = w[(size_t)kk * 12288]; a0 += s0[kk] * wv; a1 += s0[2048 + kk] * wv; a2 += s0[4096 + kk] * wv; a3 += s0[6144 + kk] * wv; a4 += s0[8192 + kk] * wv; }
            red[(q * 5 + 0) * 128 + jl] = a0; red[(q * 5 + 1) * 128 + jl] = a1; red[(q * 5 + 2) * 128 + jl] = a2; red[(q * 5 + 3) * 128 + jl] = a3; red[(q * 5 + 4) * 128 + jl] = a4;
            __syncthreads();
            for (int i = tid; i < 5 * 128; i += 512) { const int cond = i >> 7, jj = i & 127; const int col = (it % 96) * 128 + jj;
                const float v = ((red[(0 * 5 + cond) * 128 + jj] + red[(1 * 5 + cond) * 128 + jj]) + (red[(2 * 5 + cond) * 128 + jj] + red[(3 * 5 + cond) * 128 + jj])) + inptr(I_BADA)[l * 12288 + col];
                mod[((size_t)l * 5 + cond) * 12288 + col] = v; }
            __syncthreads();
        }
    }
}

template <bool XBF  >
__device__ __forceinline__ void norm_phase(const Params& p, int l, int which  ) {
    const int tid = opaque_tid(p.ph_hi), lane = tid & 63, wave = __builtin_amdgcn_readfirstlane(tid >> 6);
    const int gw = blockIdx.x * 8 + wave, NGW = gridDim.x * 8;
    const float* g = inptr(which ? I_N2G : I_N1G) + l * 2048;
    const float* modl = wsf(p, WS_MOD) + (size_t)l * 5 * 12288;
    bf16* H = wsb(p, WS_H);
    for (int r = gw; r < MROWS; r += NGW) {
        const int cond = r < M_C ? 0 : 1 + ((r - M_C) >> 12);
        const float* sh = modl + (size_t)cond * 12288 + (which ? 3 : 0) * 2048, * sc = sh + 2048;
        float v[4][8]; float ss = 0.f;
#pragma unroll
        for (int j = 0; j < 4; ++j) { const int c = 8 * lane + 512 * j;
            if (XBF) { const v4u raw = *(const v4u*)(wsb(p, WS_XB) + (size_t)r * 2048 + c); unpack8(raw, v[j]); }
            else { const float* x = (r < M_C ? inptr(I_XP) : inptr(I_XS) - (size_t)M_C * DMODEL) + (size_t)r * 2048 + c; const f32x4 a = *(const f32x4*)x, b = *(const f32x4*)(x + 4);
#pragma unroll
                for (int k = 0; k < 4; ++k) { v[j][k] = a[k]; v[j][4 + k] = b[k]; } }
            ss += ((v[j][0] * v[j][0] + v[j][1] * v[j][1]) + (v[j][2] * v[j][2] + v[j][3] * v[j][3])) + ((v[j][4] * v[j][4] + v[j][5] * v[j][5]) + (v[j][6] * v[j][6] + v[j][7] * v[j][7])); }
        const float rstd = 1.0f / sqrtf(wave_sum(ss, lane) * (1.0f / 2048.0f) + RMS_EPS);
#pragma unroll
        for (int j = 0; j < 4; ++j) { const int c = 8 * lane + 512 * j; float y[8];
#pragma unroll
            for (int h = 0; h < 2; ++h) { const f32x4 gg = *(const f32x4*)(g + c + 4 * h), s1 = *(const f32x4*)(sc + c + 4 * h), s0 = *(const f32x4*)(sh + c + 4 * h);
#pragma unroll
                for (int k = 0; k < 4; ++k) y[4 * h + k] = (v[j][4 * h + k] * rstd) * gg[k] * (s1[k] + 1.0f) + s0[k]; }
            *(v4u*)(H + (size_t)r * 2048 + c) = pack8(y);
            if (!which) { int q0 = 0, q1 = 0; q0 = __builtin_amdgcn_cvt_pk_fp8_f32(y[0], y[1], q0, false); q0 = __builtin_amdgcn_cvt_pk_fp8_f32(y[2], y[3], q0, true);
                q1 = __builtin_amdgcn_cvt_pk_fp8_f32(y[4], y[5], q1, false); q1 = __builtin_amdgcn_cvt_pk_fp8_f32(y[6], y[7], q1, true);
                *(v2u*)(p.ws + WS_H8 + (size_t)r * 2048 + c) = (v2u){(unsigned)q0, (unsigned)q1}; } }
    }
}

__device__ __forceinline__ void prep_phase(const Params& p, int l, LAS unsigned char* lds) {
    const int tid = opaque_tid(p.ph_hi), lane = tid & 63, wave = __builtin_amdgcn_readfirstlane(tid >> 6);
    const int gw = blockIdx.x * 8 + wave, NGW = gridDim.x * 8;
    bf16* Z = wsb(p, WS_Z); const float* tab = wsf(p, WS_TAB);
    for (int r = gw; r < MROWS; r += NGW) {
        const bool isctx = r < M_C; const int seq = isctx ? (r >> 8) : ((r - M_C) >> 12), t = isctx ? (r & 255) : ((r - M_C) & 4095);
        bf16* zr = Z + (size_t)r * DIN; const int sub = lane & 7;
        v4u raws[2];
#pragma unroll
        for (int it = 0; it < 2; ++it) { int v = it * 8 + (lane >> 3); if (v > 11) v = 11;
            const int col = v < 2 ? ZC_KW + v * 64 : v < 4 ? ZC_KG + (v - 2) * 64 : ZC_KD + (v - 4) * 64;
            raws[it] = *(const v4u*)(zr + col + sub * 8); }
#pragma unroll
        for (int it = 0; it < 2; ++it) {
            int v = it * 8 + (lane >> 3); const bool live = v < 12; if (!live) v = 11;
            int col; const float* gain; size_t ko;
            if (v < 2)      { col = ZC_KW + v * 64; gain = inptr(I_WKN); ko = O_WK + ((size_t)(seq * 4 + l) * 256 + t) * 128 + v * 64; }
            else if (v < 4) { col = ZC_KG + (v - 2) * 64; gain = inptr(I_GKN); ko = O_GK + ((size_t)(seq * 4 + l) * 256 + t) * 128 + (v - 2) * 64; }
            else            { col = ZC_KD + (v - 4) * 64; gain = inptr(I_DKN); ko = O_DK + ((size_t)(seq * 4 + l) * 256 + t) * 512 + (v - 4) * 64; }
            gain += l * 64 + sub * 8;
            float x[8]; unpack8(raws[it], x);
            float ss = 0.f;
#pragma unroll
            for (int j = 0; j < 8; ++j) ss += x[j] * x[j];
            ss += shfl_xor_l(ss, 1, lane); ss += shfl_xor_l(ss, 2, lane); ss += shfl_xor_l(ss, 4, lane);
            const float rstd = 1.0f / sqrtf(ss * (1.0f / 64.0f) + RMS_EPS);
            const f32x4 g0 = *(const f32x4*)gain, g1 = *(const f32x4*)(gain + 4);
            float y[8];
#pragma unroll
            for (int j = 0; j < 4; ++j) { y[j] = x[j] * rstd * g0[j]; y[4 + j] = x[4 + j] * rstd * g1[j]; }
            if (isctx) {
                if (live) { *(f32x4*)(p.out + ko + sub * 8) = (f32x4){y[0], y[1], y[2], y[3]}; *(f32x4*)(p.out + ko + sub * 8 + 4) = (f32x4){y[4], y[5], y[6], y[7]}; }
            } else {
                const int axis = sub >> 2, pos = axis ? (t & 63) : (t >> 6), f0 = (sub & 1) * 8; const bool half = (sub >> 1) & 1;
                const f32x4 c0 = *(const f32x4*)(tab + TAB_COS + pos * 16 + f0), c1 = *(const f32x4*)(tab + TAB_COS + pos * 16 + f0 + 4);
                const f32x4 s0 = *(const f32x4*)(tab + TAB_SIN + pos * 16 + f0), s1 = *(const f32x4*)(tab + TAB_SIN + pos * 16 + f0 + 4);
#pragma unroll
                for (int j = 0; j < 8; ++j) { const float pr = shfl_xor_l(y[j], 2, lane); const float c = j < 4 ? c0[j & 3] : c1[j & 3], s = j < 4 ? s0[j & 3] : s1[j & 3];
                    y[j] = y[j] * c + (half ? pr : -pr) * s; }
            }
            if (live) *(v4u*)(zr + col + sub * 8) = pack8(y);
        }
        if (isctx) {
#pragma unroll 1
            for (int it = 0; it < 2; ++it) { const int g = it * 64 + lane; if (g < 96) {
                int col; size_t vo;
                if (g < 16)      { col = ZC_VW + g * 8; vo = O_WV + ((size_t)(seq * 4 + l) * 256 + t) * 128 + g * 8; }
                else if (g < 32) { col = ZC_VG + (g - 16) * 8; vo = O_GV + ((size_t)(seq * 4 + l) * 256 + t) * 128 + (g - 16) * 8; }
                else             { col = ZC_VD + (g - 32) * 8; vo = O_DV + ((size_t)(seq * 4 + l) * 256 + t) * 512 + (g - 32) * 8; }
                float x[8]; unpack8(*(const v4u*)(zr + col), x);
                *(f32x4*)(p.out + vo) = (f32x4){x[0], x[1], x[2], x[3]}; *(f32x4*)(p.out + vo + 4) = (f32x4){x[4], x[5], x[6], x[7]}; } }
        }
    }
    LAS unsigned short* tile = (LAS unsigned short*)(lds + wave * 16384);
    for (int it = gw; it < (MROWS / 64) * 12; it += NGW) {
        const int rb = it / 12, cb = it % 12, r0 = rb * 64; const bool isctx = r0 < M_C;
        const int seq = isctx ? (r0 >> 8) : ((r0 - M_C) >> 12), t0 = isctx ? (r0 & 255) : ((r0 - M_C) & 4095), T = isctx ? T_C : T_L;
        int col; bf16* dst;
        if (cb < 2)      { col = ZC_VW + cb * 64; dst = wsb(p, isctx ? VT_BC : VT_BL) + (size_t)((seq * 2 + cb) * 64) * T; }
        else if (cb < 4) { col = ZC_VG + (cb - 2) * 64; dst = wsb(p, isctx ? VT_CC : VT_CL) + (size_t)((seq * 2 + cb - 2) * 64) * T; }
        else             { col = ZC_VD + (cb - 4) * 64; dst = wsb(p, isctx ? VT_DC : VT_DL) + (size_t)((seq * 4 + ((cb - 4) >> 1)) * 128 + ((cb - 4) & 1) * 64) * T; }
#pragma unroll
        for (int i = 0; i < 8; ++i) { const int row = i * 8 + (lane >> 3), ch = lane & 7; const v4u raw = *(const v4u*)(Z + (size_t)(r0 + row) * DIN + col + ch * 8);
            LAS unsigned* d = (LAS unsigned*)(tile + row * 66 + ch * 8); d[0] = raw.x; d[1] = raw.y; d[2] = raw.z; d[3] = raw.w; }
        asm volatile("s_waitcnt lgkmcnt(0)" ::: "memory");
#pragma unroll
        for (int i = 0; i < 8; ++i) { const int drow = i * 8 + (lane >> 3), tch = lane & 7; unsigned short e[8];
#pragma unroll
            for (int j = 0; j < 8; ++j) e[j] = tile[(16 * (tch >> 1) + 4 * (tch & 1) + (j & 3) + 8 * (j >> 2)) * 66 + drow];
            v4u o; o.x = e[0] | ((unsigned)e[1] << 16); o.y = e[2] | ((unsigned)e[3] << 16); o.z = e[4] | ((unsigned)e[5] << 16); o.w = e[6] | ((unsigned)e[7] << 16);
            *(v4u*)(dst + (size_t)drow * T + t0 + tch * 8) = o; }
        asm volatile("s_waitcnt lgkmcnt(0)" ::: "memory");
    }
}

__device__ __forceinline__ void dcomb_phase(const Params& p, int l) {
    const int tid = opaque_tid(p.ph_hi), lane = tid & 63, wave = __builtin_amdgcn_readfirstlane(tid >> 6);
    const int gw = blockIdx.x * 8 + wave, NGW = gridDim.x * 8;
    const float* tab = wsf(p, WS_TAB); const float lam = tab[TAB_LAMD + l], omli = 1.0f - tab[TAB_LAMI + l];
    const bf16* OD = wsb(p, WS_OD); bf16* BR3 = wsb(p, WS_BR) + 3 * BRW;
    const int h = lane >> 4, sub = lane & 15;
    const float* og = inptr(I_DOG) + l * 128 + sub * 8; const f32x4 g0 = *(const f32x4*)og, g1 = *(const f32x4*)(og + 4);
    for (int r = gw; r < MROWS; r += NGW) {
        float a[8], b[8]; unpack8(*(const v4u*)(OD + (size_t)r * 1024 + (h * 2) * 128 + sub * 8), a); unpack8(*(const v4u*)(OD + (size_t)r * 1024 + (h * 2 + 1) * 128 + sub * 8), b);
        float ss = 0.f;
#pragma unroll
        for (int j = 0; j < 8; ++j) { a[j] -= lam * b[j]; ss += a[j] * a[j]; }
        ss += shfl_xor_l(ss, 1, lane); ss += shfl_xor_l(ss, 2, lane); ss += shfl_xor_l(ss, 4, lane); ss += shfl_xor_l(ss, 8, lane);
        const float rstd = 1.0f / sqrtf(ss * (1.0f / 128.0f) + RMS_EPS) * omli;
#pragma unroll
        for (int j = 0; j < 4; ++j) { a[j] *= rstd * g0[j]; a[4 + j] *= rstd * g1[j]; }
        *(v4u*)(BR3 + (size_t)r * BRP + h * 128 + sub * 8) = pack8(a);
    }
}

constexpr int LR_U16 = 0, LR_U32 = 9216, LR_PA = 25600, LR_PB = 41984, LR_HF = 58368;
template <int MODE, bool AB = false>
__device__ __forceinline__ void lru_sweep(const Params& p, int l, int dir, int n, int rowseq0  , int T, int tch0  ,
                                          float& h  , float& aprod, LAS unsigned char* lds, unsigned* ab = nullptr) {
    const int tid = opaque_tid(p.ph_hi), lane = tid & 63, wave = __builtin_amdgcn_readfirstlane(tid >> 6), r32 = lane & 31, hi = lane >> 5;
    const bf16* Z = wsb(p, WS_Z);
    LAS unsigned short* U16 = (LAS unsigned short*)(lds + LR_U16); LAS float* U32 = (LAS float*)(lds + LR_U32); LAS float* PA = (LAS float*)(lds + LR_PA); LAS float* PB = (LAS float*)(lds + LR_PB); LAS float* HF = (LAS float*)(lds + LR_HF);
    const int g = wave >> 2, mi = (wave >> 1) & 1, ni = wave & 1, dcol = ni * 32 + r32;
    bf16x8 wf[4];
    { const bf16* wp = wsb(p, WS_LRUW) + ((size_t)((g * 64 + (l * 2 + dir) * 8 + n) * 64 + dcol)) * 64 + hi * 8;
#pragma unroll
      for (int ks = 0; ks < 4; ++ks) wf[ks] = *(const bf16x8*)(wp + ks * 16); }
    const float gbias = inptr(g ? I_LBI : I_LBR)[(l * 2 + dir) * 512 + n * 64 + dcol];
    const int tt = tid >> 3, c8 = (tid & 7) * 8;
    float cw[4][8], cb[8], sp[8];
#pragma unroll
    for (int k = 0; k < 4; ++k) { const float* q = inptr(I_CONVW) + (l * 4 + k) * 512 + n * 64 + c8; const f32x4 a = *(const f32x4*)q, b = *(const f32x4*)(q + 4);
        cw[k][0] = a[0]; cw[k][1] = a[1]; cw[k][2] = a[2]; cw[k][3] = a[3]; cw[k][4] = b[0]; cw[k][5] = b[1]; cw[k][6] = b[2]; cw[k][7] = b[3]; }
    { const float* q = inptr(I_CONVB) + l * 512 + n * 64 + c8; const float* s = wsf(p, WS_TAB) + TAB_SPL + (l * 2 + dir) * 512 + n * 64 + c8;
#pragma unroll
      for (int j = 0; j < 8; ++j) { cb[j] = q[j]; sp[j] = s[j]; } }
    v4u xr[4], yr = {0u, 0u, 0u, 0u};
#define LRU_FETCH(j4_) do { const int t_ = tch0 + 64 * (j4_) + tt; if (!AB) { _Pragma("unroll") for (int k = 0; k < 4; ++k) { const int tk = t_ + k - 1; \
        xr[k] = (tk >= 0 && tk < T) ? *(const v4u*)(Z + (size_t)(rowseq0 + tk) * DIN + ZC_XA + n * 64 + c8) : (v4u){0u, 0u, 0u, 0u}; } } \
        if (MODE == 2) yr = *(const v4u*)(Z + (size_t)(rowseq0 + t_) * DIN + ZC_YA + n * 64 + c8); } while (0)
    unsigned wn[8] = {0u, 0u, 0u, 0u, 0u, 0u, 0u, 0u};
#define LRU_FETCH_AB(j4_) do { _Pragma("unroll") for (int k = 0; k < 8; ++k) { const int st_ = dir ? 63 - (8 * wave + k) : 8 * wave + k; wn[k] = ab[(size_t)(tch0 + 64 * (j4_) + st_) * 512 + lane]; } } while (0)
    LRU_FETCH(dir ? 3 : 0);
    if (AB) LRU_FETCH_AB(dir ? 3 : 0);
#pragma unroll 1
    for (int jj = 0; jj < 4; ++jj) {
        const int j4 = dir ? 3 - jj : jj, ts = tch0 + 64 * j4, t = ts + tt;
        float ya[8]; unsigned wc[8];
        if constexpr (!AB) {
        { float u[8];
#pragma unroll
          for (int j = 0; j < 8; ++j) u[j] = cb[j];
#pragma unroll
          for (int k = 0; k < 4; ++k) { float x[8]; unpack8(xr[k], x);
#pragma unroll
              for (int j = 0; j < 8; ++j) u[j] += cw[k][j] * x[j]; }
          if (MODE == 2) unpack8(yr, ya);
          *(LAS v4u*)(U16 + tt * 72 + c8) = pack8(u);
          *(LAS f32x4*)(U32 + tt * 64 + c8) = (f32x4){u[0], u[1], u[2], u[3]}; *(LAS f32x4*)(U32 + tt * 64 + c8 + 4) = (f32x4){u[4], u[5], u[6], u[7]}; }
        __syncthreads();
        if (jj < 3) LRU_FETCH(dir ? 2 - jj : jj + 1);
        { f32x16 acc = {};
#pragma unroll
          for (int ks = 0; ks < 4; ++ks) { const bf16x8 a = *(const LAS bf16x8*)(U16 + (mi * 32 + r32) * 72 + ks * 16 + hi * 8); acc = __builtin_amdgcn_mfma_f32_32x32x16_bf16(a, wf[ks], acc, 0, 0, 0); }
          LAS float* P = g ? PB : PA;
#pragma unroll
          for (int r = 0; r < 16; ++r) P[(mi * 32 + crow(r, hi)) * 64 + dcol] = acc[r] + gbias; }
        __syncthreads();
        { unsigned wab[8];
#pragma unroll
          for (int j = 0; j < 8; ++j) { const int idx = tt * 64 + c8 + j;
              const float rg = __builtin_amdgcn_rcpf(1.0f + __builtin_amdgcn_exp2f(-1.4426950408889634f * PA[idx])), ig = __builtin_amdgcn_rcpf(1.0f + __builtin_amdgcn_exp2f(-1.4426950408889634f * PB[idx]));
              const float la = -8.0f * rg * sp[j]; const float a = __builtin_amdgcn_exp2f(1.4426950408889634f * la);
              const float x = 2.0f * la; const float ser = -x * (1.0f + x * (0.5f + x * (0.16666667f + x * (0.041666668f + x * (0.0083333338f + x * 0.0013888889f)))));
              const float om = x > -0.25f ? ser : 1.0f - a * a;
              const float b = __builtin_amdgcn_sqrtf(om) * ig * U32[idx];
              if (MODE == 0) { const unsigned w = pk2(1.4426950408889634f * la, b); wab[j] = w; PA[idx] = __builtin_amdgcn_exp2f(bflo(w)); PB[idx] = bfhi(w); }
              else { PA[idx] = a; PB[idx] = b; } }
          if (MODE == 0) { unsigned* q = ab + (size_t)(ts + tt) * 512 + c8; *(v4u*)q = (v4u){wab[0], wab[1], wab[2], wab[3]}; *(v4u*)(q + 4) = (v4u){wab[4], wab[5], wab[6], wab[7]}; } }
        __syncthreads();
        } else {
            if (MODE == 2) unpack8(yr, ya);
#pragma unroll
            for (int k = 0; k < 8; ++k) wc[k] = wn[k];
            if (jj < 3) { LRU_FETCH(dir ? 2 - jj : jj + 1); LRU_FETCH_AB(dir ? 2 - jj : jj + 1); }
        }
        {
            LAS float* SC = (LAS float*)(lds + LR_U16);
            float av[8], bv[8];
#pragma unroll
            for (int k = 0; k < 8; ++k) { const int st = dir ? 63 - (8 * wave + k) : 8 * wave + k; if (AB) { av[k] = __builtin_amdgcn_exp2f(bflo(wc[k])); bv[k] = bfhi(wc[k]); } else { av[k] = PA[st * 64 + lane]; bv[k] = PB[st * 64 + lane]; } }
            float Al = av[0], Bl = bv[0];
#pragma unroll
            for (int k = 1; k < 8; ++k) { Bl = av[k] * Bl + bv[k]; Al *= av[k]; }
            SC[(wave * 2) * 64 + lane] = Al; SC[(wave * 2 + 1) * 64 + lane] = Bl;
            __syncthreads();
            float hv = h, hin = h;
#pragma unroll
            for (int v = 0; v < 8; ++v) { const float Av = SC[(2 * v) * 64 + lane], Bv = SC[(2 * v + 1) * 64 + lane]; if (v == wave) hin = hv; hv = Av * hv + Bv; if (MODE == 0) aprod *= Av; }
            h = hv;
#pragma unroll
            for (int k = 0; k < 8; ++k) { const int st = dir ? 63 - (8 * wave + k) : 8 * wave + k; hin = av[k] * hin + bv[k];
                if (MODE == 1) HF[(j4 * 64 + st) * 64 + lane] = hin;
                if (MODE == 2) PB[st * 64 + lane] = hin; }
        }
        __syncthreads();
        if (MODE == 2) {
            float o[8];
#pragma unroll
            for (int j = 0; j < 8; ++j) { const float hs = HF[(j4 * 64 + tt) * 64 + c8 + j] + PB[tt * 64 + c8 + j]; const float y = ya[j];
                const float ug = 0.7978845608028654f * (y + 0.044715f * y * y * y);
                const float gl = y * __builtin_amdgcn_rcpf(1.0f + __builtin_amdgcn_exp2f(-2.8853900817779268f * ug)); o[j] = hs * gl; }
            *(v4u*)(wsb(p, WS_BR) + (size_t)(rowseq0 + t) * BRP + n * 64 + c8) = pack8(o);
        }
    }
#undef LRU_FETCH
#undef LRU_FETCH_AB
}
__device__ __forceinline__ void lru_pass1(const Params& p, int l, LAS unsigned char* lds) {
    const int tid = opaque_tid(p.ph_hi), lane = tid & 63, wave = __builtin_amdgcn_readfirstlane(tid >> 6);
    float* SUM = wsf(p, WS_SUM);
#pragma unroll 1
    for (int it = blockIdx.x; it < NSEQ_L * 2 * 8 * 16; it += gridDim.x) {
        const int seq = it >> 8, dir = (it >> 7) & 1, n = (it >> 4) & 7, c = it & 15;
        float h = 0.f, ap = 1.f; asm volatile("" : "+v"(h), "+v"(ap));
        __syncthreads();
        lru_sweep<0>(p, l, dir, n, M_C + seq * T_L, T_L, c * 256, h, ap, lds, (unsigned*)(p.ws + WS_LAB) + ((size_t)(seq * 2 + dir) * T_L) * 512 + n * 64);
        if (wave == 0) { float* s = SUM + ((size_t)((seq * 2 + dir) * 16 + c) * 512 + n * 64 + lane) * 2; s[0] = ap; s[1] = h; }
    }
}
__device__ __forceinline__ void lru_pass2(const Params& p, int l, LAS unsigned char* lds) {
    const int tid = opaque_tid(p.ph_hi), lane = tid & 63, wave = __builtin_amdgcn_readfirstlane(tid >> 6);
    const float* SUM = wsf(p, WS_SUM);
#pragma unroll 1
    for (int it = blockIdx.x; it < NSEQ_L * 8 * 16 + NSEQ_C * 8; it += gridDim.x) {
        const bool lat = it < NSEQ_L * 8 * 16;
        int seq, n, c, rowseq0, T;
        if (lat) { seq = it >> 7; n = (it >> 4) & 7; c = it & 15; rowseq0 = M_C + seq * T_L; T = T_L; }
        else { const int i2 = it - NSEQ_L * 8 * 16; seq = i2 >> 3; n = i2 & 7; c = 0; rowseq0 = seq * T_C; T = T_C; }
        float hf = 0.f, hb = 0.f, dummy = 1.f; asm volatile("" : "+v"(hf), "+v"(hb), "+v"(dummy));
        if (lat) {
            const int ch = n * 64 + lane;
            hf = inptr(I_SLRU)[((size_t)(seq * 4 + l) * 2 + 0) * 512 + ch]; hb = inptr(I_SLRU)[((size_t)(seq * 4 + l) * 2 + 1) * 512 + ch];
            { pg8::f32x2_t sv[16];
#pragma unroll
              for (int cc = 0; cc < 16; ++cc) sv[cc] = *(const pg8::f32x2_t*)(SUM + ((size_t)((seq * 2 + 0) * 16 + cc) * 512 + ch) * 2);
#pragma unroll
              for (int cc = 0; cc < 16; ++cc) hf = cc < c ? sv[cc][0] * hf + sv[cc][1] : hf;
#pragma unroll
              for (int cc = 0; cc < 16; ++cc) sv[cc] = *(const pg8::f32x2_t*)(SUM + ((size_t)((seq * 2 + 1) * 16 + cc) * 512 + ch) * 2);
#pragma unroll
              for (int cc = 15; cc >= 0; --cc) hb = cc > c ? sv[cc][0] * hb + sv[cc][1] : hb; }
        }
        __syncthreads();
        if (lat) { unsigned* ab = (unsigned*)(p.ws + WS_LAB) + ((size_t)(seq * 2) * T_L) * 512 + n * 64;
            lru_sweep<1, true>(p, l, 0, n, rowseq0, T, c * 256, hf, dummy, lds, ab);
            lru_sweep<2, true>(p, l, 1, n, rowseq0, T, c * 256, hb, dummy, lds, ab + (size_t)T_L * 512); }
        else {
            lru_sweep<1>(p, l, 0, n, rowseq0, T, c * 256, hf, dummy, lds);
            lru_sweep<2>(p, l, 1, n, rowseq0, T, c * 256, hb, dummy, lds); }
        if (!lat && wave == 0) { float* o = p.out + O_LS + ((size_t)(seq * 4 + l) * 2) * 512 + n * 64 + lane; o[0] = hf; o[512] = hb; }
    }
}

struct AttnJob {
    const bf16* Q; const bf16* Ks; const bf16* VTs; const bf16* Kc; const bf16* VTc; bf16* O;
    int kspitch, vtspitch, kcpitch, opitch, s_t0, s_nt, c_nt, q0, window, wv, rope; float sink2; bool has_sink; const float* qg; const float* tab;
};
constexpr int AT_K = 0, AT_V = 32768;
#define GLDS16(gp, lp) __builtin_amdgcn_global_load_lds((const unsigned*)(gp), (LAS unsigned*)(lp), 16, 0, 0)
constexpr float ATT_THR = 8.0f;
template <int VW, int PROBE>
__device__ __forceinline__ void attn_unit(const AttnJob& J, LAS unsigned char* lds) {
    const int tid = opaque_tid(J.wv), lane = tid & 63, wid = __builtin_amdgcn_readfirstlane(tid >> 6), r32 = lane & 31, hi = lane >> 5;
    constexpr int NB = VW / 32;
    bf16x8 qf[4];
    { const bf16* qp = J.Q + (size_t)(wid * 32 + r32) * DIN + hi * 8;
      v4u raw[4];
#pragma unroll
      for (int ks = 0; ks < 4; ++ks) raw[ks] = *(const v4u*)(qp + ks * 16);
      float y[4][8]; float ss = 0.f;
#pragma unroll
      for (int ks = 0; ks < 4; ++ks) { unpack8(raw[ks], y[ks]);
#pragma unroll
          for (int j = 0; j < 8; ++j) ss += y[ks][j] * y[ks][j]; }
      { const auto rr_ = __builtin_amdgcn_permlane32_swap(__float_as_uint(ss), __float_as_uint(ss), false, false); ss = __uint_as_float(rr_[0]) + __uint_as_float(rr_[1]); }
      const float rstd = 1.0f / sqrtf(ss * (1.0f / 64.0f) + RMS_EPS);
#pragma unroll
      for (int ks = 0; ks < 4; ++ks) { const f32x4 g0 = *(const f32x4*)(J.qg + 16 * ks + 8 * hi), g1 = *(const f32x4*)(J.qg + 16 * ks + 8 * hi + 4);
#pragma unroll
          for (int j = 0; j < 4; ++j) { y[ks][j] = y[ks][j] * rstd * g0[j]; y[ks][4 + j] = y[ks][4 + j] * rstd * g1[j]; } }
      if (J.rope) { const int tq = J.q0 + wid * 32 + r32;
#pragma unroll
          for (int ax = 0; ax < 2; ++ax) { const int pos = ax ? (tq & 63) : (tq >> 6); const float* cp = J.tab + TAB_COS + pos * 16 + 8 * hi, * sp = J.tab + TAB_SIN + pos * 16 + 8 * hi;
              const f32x4 c0 = *(const f32x4*)cp, c1 = *(const f32x4*)(cp + 4), s0 = *(const f32x4*)sp, s1 = *(const f32x4*)(sp + 4);
#pragma unroll
              for (int j = 0; j < 8; ++j) { const float c = j < 4 ? c0[j & 3] : c1[j & 3], s = j < 4 ? s0[j & 3] : s1[j & 3]; const float a = y[2 * ax][j], b = y[2 * ax + 1][j];
                  y[2 * ax][j] = a * c - b * s; y[2 * ax + 1][j] = b * c + a * s; } } }
#pragma unroll
      for (int ks = 0; ks < 4; ++ks) {
#pragma unroll
          for (int j = 0; j < 8; ++j) y[ks][j] *= QSCALE;
          qf[ks] = __builtin_bit_cast(bf16x8, pack8(y[ks])); } }
    float mref = 0.f, lsum = 0.f; f32x16 o[NB]; f32x16 negm;
    { float zz = 0.f; asm volatile("" : "+v"(zz));
#pragma unroll
      for (int r = 0; r < 16; ++r) { negm[r] = zz;
#pragma unroll
          for (int b = 0; b < NB; ++b) o[b][r] = zz; } }
    const int NT = J.s_nt + J.c_nt, qw0 = J.q0 + wid * 32;
    const int krow = wid * 8 + (lane >> 3), kchunk = (lane & 7) ^ ((krow >> 1) & 7);
    const unsigned lk_s = (unsigned)krow * (unsigned)J.kspitch * 2u + kchunk * 16u, lk_c = (unsigned)krow * (unsigned)J.kcpitch * 2u + kchunk * 16u, lv_s = (unsigned)lane * (unsigned)J.vtspitch * 2u, lv_c = (unsigned)lane * (unsigned)(PAST * 2);
#define ATT_ISSUE_K(t_, slot_) do { const int t__ = (t_); \
        if (t__ < J.s_nt) GLDS16((const char*)J.Ks + (size_t)(J.s_t0 + t__ * 64) * J.kspitch * 2 + lk_s, lds + AT_K + (slot_) * 8192 + wid * 1024); \
        else GLDS16((const char*)J.Kc + (size_t)((t__ - J.s_nt) * 64) * J.kcpitch * 2 + lk_c, lds + AT_K + (slot_) * 8192 + wid * 1024); } while (0)
#define ATT_ISSUE_V(t_, slot_) do { const int t__ = (t_); \
        if (t__ < J.s_nt) { const char* vb_ = (const char*)J.VTs + (size_t)(J.s_t0 + t__ * 64 + wid * 8) * 2; GLDS16(vb_ + lv_s, lds + AT_V + (slot_) * 16384 + wid * 1024); \
            if (VW == 128) GLDS16(vb_ + (size_t)128 * J.vtspitch + lv_s, lds + AT_V + (slot_) * 16384 + 8192 + wid * 1024); } \
        else { const char* vb_ = (const char*)J.VTc + (size_t)((t__ - J.s_nt) * 64 + wid * 8) * 2; GLDS16(vb_ + lv_c, lds + AT_V + (slot_) * 16384 + wid * 1024); \
            if (VW == 128) GLDS16(vb_ + (size_t)128 * PAST + lv_c, lds + AT_V + (slot_) * 16384 + 8192 + wid * 1024); } } while (0)
#define ATT_NEED(t_) (!(J.window && (t_) < J.s_nt) || ((J.s_t0 + (t_) * 64 + 63 >= qw0 - 128) && (J.s_t0 + (t_) * 64 <= qw0 + 31 + 128)))
#define ATT_LDK(slot_) do { const LAS unsigned char* Kb = lds + AT_K + (slot_) * 8192 + (r32 >> 3) * 1024 + (r32 & 7) * 128; const int kx = ((r32 >> 1) & 7); \
        _Pragma("unroll") for (int ks = 0; ks < 4; ++ks) { kf[2 * ks] = *(const LAS bf16x8*)(Kb + (((2 * ks + hi) ^ kx) << 4)); kf[2 * ks + 1] = *(const LAS bf16x8*)(Kb + 4096 + (((2 * ks + hi) ^ kx) << 4)); } } while (0)
#define ATT_MMK(P0, P1) do { \
        P0 = __builtin_amdgcn_mfma_f32_32x32x16_bf16(kf[0], qf[0], negm, 0, 0, 0); P1 = __builtin_amdgcn_mfma_f32_32x32x16_bf16(kf[1], qf[0], negm, 0, 0, 0); \
        _Pragma("unroll") for (int ks = 1; ks < 4; ++ks) { P0 = __builtin_amdgcn_mfma_f32_32x32x16_bf16(kf[2 * ks], qf[ks], P0, 0, 0, 0); P1 = __builtin_amdgcn_mfma_f32_32x32x16_bf16(kf[2 * ks + 1], qf[ks], P1, 0, 0, 0); } } while (0)
#define ATT_LDV(VF, vslot_, b_) do { const LAS unsigned char* vb = lds + AT_V + (vslot_) * 16384 + ((b_) >> 1) * 8192 + (((b_) & 1) * 32 + r32) * 16 + hi * 1024; \
        _Pragma("unroll") for (int s_ = 0; s_ < 4; ++s_) VF[s_] = *(const LAS v4u*)(vb + (2 * s_) * 1024); } while (0)
#define ATT_MMV(VF, b_) do { _Pragma("unroll") for (int s_ = 0; s_ < 4; ++s_) o[b_] = __builtin_amdgcn_mfma_f32_32x32x16_bf16(__builtin_bit_cast(bf16x8, VF[s_]), __builtin_bit_cast(bf16x8, pw[s_]), o[b_], 0, 0, 0); } while (0)
#define ATT_SB __builtin_amdgcn_sched_barrier(0)
#define ATT_PVK(vslot_, kslot_, ldk_) do { ATT_LDV(vf0, vslot_, 0); ATT_LDV(vf1, vslot_, 1); ATT_SB; \
        if (VW == 128) { ATT_MMV(vf0, 0); ATT_SB; ATT_LDV(vf0, vslot_, 2 % NB); ATT_SB; ATT_MMV(vf1, 1); ATT_SB; ATT_LDV(vf1, vslot_, 3 % NB); ATT_SB; ATT_MMV(vf0, 2 % NB); ATT_SB; \
            ATT_MMV(vf1, 3 % NB); ATT_SB; if (ldk_) { ATT_LDK(kslot_); ATT_SB; } } \
        else { ATT_MMV(vf0, 0); ATT_MMV(vf1, 1); ATT_SB; if (ldk_) { ATT_LDK(kslot_); ATT_SB; } } } while (0)
#define ATT_MAX(PC0, PC1, t_) do { \
        if (J.window && (t_) < J.s_nt && !((J.s_t0 + (t_) * 64 >= qw0 + 31 - 128) && (J.s_t0 + (t_) * 64 + 63 <= qw0 + 128))) {     \
            int dbase = qw0 + r32 - (J.s_t0 + (t_) * 64) - 4 * hi; asm volatile("" : "+v"(dbase));     \
            _Pragma("unroll") for (int r = 0; r < 16; ++r) { int d0 = dbase - ((r & 3) + 8 * (r >> 2)); d0 = d0 < 0 ? -d0 : d0; int d1 = dbase - ((r & 3) + 8 * (r >> 2)) - 32; d1 = d1 < 0 ? -d1 : d1; \
                if (d0 > 128) PC0[r] = -INFINITY; if (d1 > 128) PC1[r] = -INFINITY; } } \
        float mx = fmaxf(fmaxf(PC0[0], PC1[0]), PC0[1]); \
        _Pragma("unroll") for (int r = 2; r < 16; r += 2) mx = fmaxf(fmaxf(mx, PC0[r]), PC0[r + 1]); \
        _Pragma("unroll") for (int r = 1; r < 15; r += 2) mx = fmaxf(fmaxf(mx, PC1[r]), PC1[r + 1]); \
        mx = fmaxf(mx, PC1[15]); { const auto rr_ = __builtin_amdgcn_permlane32_swap(__float_as_uint(mx), __float_as_uint(mx), false, false); mx = fmaxf(__uint_as_float(rr_[0]), __uint_as_float(rr_[1])); }     \
        if (__any(mx > ATT_THR)) { const float dl = fmaxf(mx, 0.f), f = __builtin_amdgcn_exp2f(-dl); mref += dl; lsum *= f; \
            _Pragma("unroll") for (int r = 0; r < 16; ++r) { PC0[r] -= dl; PC1[r] -= dl; negm[r] = -mref; } \
            _Pragma("unroll") for (int b = 0; b < NB; ++b) _Pragma("unroll") for (int r = 0; r < 16; ++r) o[b][r] *= f; } } while (0)
#define ATT_EXP(PC0, PC1) do { pg8::f32x2_t rs2 = {0.f, 0.f}; \
        _Pragma("unroll") for (int r = 0; r < 16; ++r) { PC0[r] = __builtin_amdgcn_exp2f(PC0[r]); PC1[r] = __builtin_amdgcn_exp2f(PC1[r]); } \
        _Pragma("unroll") for (int r = 0; r < 16; r += 2) { rs2 += (pg8::f32x2_t){PC0[r], PC0[r + 1]}; rs2 += (pg8::f32x2_t){PC1[r], PC1[r + 1]}; } \
        lsum += rs2[0] + rs2[1]; \
        _Pragma("unroll") for (int i = 0; i < 4; ++i) { pw[0][i] = pg8::cvt_pk_bf16(PC0[2 * i], PC0[2 * i + 1]); pw[1][i] = pg8::cvt_pk_bf16(PC0[8 + 2 * i], PC0[9 + 2 * i]); \
            pw[2][i] = pg8::cvt_pk_bf16(PC1[2 * i], PC1[2 * i + 1]); pw[3][i] = pg8::cvt_pk_bf16(PC1[8 + 2 * i], PC1[9 + 2 * i]); } } while (0)
#define ATT_WAITBAR(n_) asm volatile("s_waitcnt vmcnt(" #n_ ") lgkmcnt(0)\n\ts_barrier" ::: "memory")
#define ATT_TOP(t_) do { if (PROBE != 1) { if ((t_) + 3 < NT) ATT_ISSUE_K((t_) + 3, ((t_) + 3) & 3); if ((t_) + 2 < NT) ATT_ISSUE_V((t_) + 2, ((t_) + 2) & 3); } } while (0)
#define ATT_END(t_) do { if (PROBE == 1) ATT_WAITBAR(0); else if ((t_) + 3 < NT) { if (VW == 128) ATT_WAITBAR(3); else ATT_WAITBAR(2); } \
        else if ((t_) + 2 < NT) { if (VW == 128) ATT_WAITBAR(2); else ATT_WAITBAR(1); } else ATT_WAITBAR(0); } while (0)
    const bool grpA = wid < 4;
    __syncthreads();
    ATT_ISSUE_K(0, 0); ATT_ISSUE_V(0, 0); ATT_ISSUE_K(1, 1); ATT_ISSUE_V(1, 1); ATT_ISSUE_K(2, 2);
    if (VW == 128) ATT_WAITBAR(3); else ATT_WAITBAR(2);
    f32x16 p0, p1; v4u pw[4], vf0[4], vf1[4]; bf16x8 kf[8];
    constexpr bool PF = (VW == 64);
    if (grpA) {
        if (PF) ATT_LDK(0);
#pragma unroll 1
        for (int t = 0; t < NT; ++t) {
            ATT_TOP(t);
            ATT_SB;
            if (t > 0) ATT_PVK((t - 1) & 3, t & 3, !PF); else if (!PF) { ATT_LDK(t & 3); ATT_SB; }
            ATT_MMK(p0, p1);
            ATT_SB;
            if (PF) { ATT_LDK((t + 1) & 3); }
            ATT_SB;
            ATT_MAX(p0, p1, t); ATT_EXP(p0, p1);
            ATT_END(t);
        }
        ATT_PVK((NT - 1) & 3, 0, false);
    } else {
        ATT_LDK(0); ATT_SB; ATT_MMK(p0, p1);
#pragma unroll 1
        for (int t = 0; t < NT; ++t) {
            ATT_TOP(t);
            if (PF) { ATT_LDK((t + 1) & 3); }
            ATT_SB;
            ATT_MAX(p0, p1, t); ATT_EXP(p0, p1);
            ATT_SB;
            ATT_PVK(t & 3, (t + 1) & 3, !PF);
            if (t + 1 < NT) ATT_MMK(p0, p1);
            ATT_END(t);
        }
    }
#undef ATT_TOP
#undef ATT_END
#undef ATT_WAITBAR
#undef ATT_MAX
#undef ATT_EXP
#undef ATT_LDK
#undef ATT_MMK
#undef ATT_LDV
#undef ATT_MMV
#undef ATT_PVK
#undef ATT_SB
#undef ATT_ISSUE_K
#undef ATT_ISSUE_V
#undef ATT_NEED
    float lt = lsum + shfl_xor_l(lsum, 32, lane);
    if (J.has_sink) lt += __builtin_amdgcn_exp2f(J.sink2 - mref);
    const float inv = 1.0f / lt;
    bf16* op = J.O + (size_t)(wid * 32 + r32) * J.opitch + 8 * hi;
#pragma unroll
    for (int b = 0; b < NB; ++b)
#pragma unroll
        for (int e = 0; e < 4; e += 2) {
            const unsigned a0 = pk2(o[b][4 * e] * inv, o[b][4 * e + 1] * inv), a1 = pk2(o[b][4 * e + 2] * inv, o[b][4 * e + 3] * inv);
            const unsigned b0 = pk2(o[b][4 * e + 4] * inv, o[b][4 * e + 5] * inv), b1 = pk2(o[b][4 * e + 6] * inv, o[b][4 * e + 7] * inv);
            const auto s0 = __builtin_amdgcn_permlane32_swap(a0, b0, false, false), s1 = __builtin_amdgcn_permlane32_swap(a1, b1, false, false);
            *(v4u*)(op + b * 32 + 8 * e) = (v4u){s0[0], s1[0], s0[1], s1[1]}; }
}
constexpr int AU_DL = 512, AU_CL = 1024, AU_BL = 1536, AU_DC = 1792, AU_CC = 2048, AU_END = 2304;
template <int PROBE>
__device__ __forceinline__ void attn_phase(const Params& p, int l, LAS unsigned char* lds) {
    const bf16* Z = wsb(p, WS_Z);
#pragma unroll 1
    for (int u = blockIdx.x; u < AU_END; u += gridDim.x) {
        AttnJob J; bool is128 = false; J.wv = p.ph_hi; J.tab = wsf(p, WS_TAB); J.rope = u < AU_BL; J.window = 0; J.has_sink = false; J.sink2 = 0.f; J.kspitch = DIN;
        const bool xdeal = gridDim.x == 256; const int xcd = blockIdx.x & 7, slot = blockIdx.x >> 3;
        if (u < AU_BL) {
            int v = u & 511; if (xdeal) { const int k = ((v >> 8) << 5) + slot; v = ((xcd * 4 + (k >> 4)) << 4) + (k & 15); }
            const int seq = v >> 7, qb = v & 15; const size_t rs0 = (size_t)M_C + (size_t)seq * T_L, rq = rs0 + qb * 256;
            J.q0 = qb * 256; J.s_t0 = 0; J.s_nt = 64; J.c_nt = 8; J.vtspitch = T_L;
            if (u < AU_DL) { const int hj = (v >> 4) & 7, h = hj >> 1;
                J.Q = Z + rq * DIN + ZC_QD + hj * 64; J.Ks = Z + rs0 * DIN + ZC_KD + hj * 64; J.VTs = wsb(p, VT_DL) + (size_t)((seq * 4 + h) * 128) * T_L;
                J.Kc = wsb(p, CK_DK) + (size_t)((seq * 4 + l) * 512) * 512 + hj * 64; J.kcpitch = 512; J.VTc = wsb(p, CK_DVT) + (size_t)((seq * 4 + l) * 512 + h * 128) * 512;
                J.O = wsb(p, WS_OD) + rq * 1024 + hj * 128; J.opitch = 1024;
                is128 = true;
            } else { const int head = (v >> 4) & 7, kvh = head >> 2; const bool isB = u >= AU_CL;
                J.Q = Z + rq * DIN + (isB ? ZC_QW : ZC_QG) + head * 64; J.Ks = Z + rs0 * DIN + (isB ? ZC_KW : ZC_KG) + kvh * 64; J.VTs = wsb(p, isB ? VT_BL : VT_CL) + (size_t)((seq * 2 + kvh) * 64) * T_L;
                J.Kc = wsb(p, isB ? CK_WK : CK_GK) + (size_t)((seq * 4 + l) * 512) * 128 + kvh * 64; J.kcpitch = 128; J.VTc = wsb(p, isB ? CK_WVT : CK_GVT) + (size_t)((seq * 4 + l) * 128 + kvh * 64) * 512;
                J.O = wsb(p, WS_BR) + (isB ? 1 : 2) * BRW + rq * BRP + head * 64; J.opitch = BRP;
                if (isB) { J.window = 1; J.has_sink = true; J.sink2 = inptr(I_WSINK)[l * 8 + head] * 1.4426950408889634f;
                    const int klo = J.q0 - 128 < 0 ? 0 : J.q0 - 128, khi = J.q0 + 384 > T_L ? T_L : J.q0 + 384; J.s_t0 = klo; J.s_nt = (khi - klo) >> 6; }
            }
        } else {
            int v = (u - AU_BL) & 255; if (xdeal) v = xcd * 32 + slot;
            const int seq = v >> 3; const size_t rs0 = (size_t)seq * T_C;
            J.q0 = 0; J.s_t0 = 0; J.s_nt = 4; J.c_nt = 0; J.vtspitch = T_C; J.Kc = Z; J.VTc = Z; J.kcpitch = 0;
            if (u < AU_DC) { const int hj = v & 7, h = hj >> 1;
                J.Q = Z + rs0 * DIN + ZC_QD + hj * 64; J.Ks = Z + rs0 * DIN + ZC_KD + hj * 64; J.VTs = wsb(p, VT_DC) + (size_t)((seq * 4 + h) * 128) * T_C;
                J.O = wsb(p, WS_OD) + rs0 * 1024 + hj * 128; J.opitch = 1024;
                is128 = true;
            } else { const int head = v & 7, kvh = head >> 2; const bool isB = u >= AU_CC;
                J.Q = Z + rs0 * DIN + (isB ? ZC_QW : ZC_QG) + head * 64; J.Ks = Z + rs0 * DIN + (isB ? ZC_KW : ZC_KG) + kvh * 64; J.VTs = wsb(p, isB ? VT_BC : VT_CC) + (size_t)((seq * 2 + kvh) * 64) * T_C;
                J.O = wsb(p, WS_BR) + (isB ? 1 : 2) * BRW + rs0 * BRP + head * 64; J.opitch = BRP;
                if (isB) { J.has_sink = true; J.sink2 = inptr(I_WSINK)[l * 8 + head] * 1.4426950408889634f; }
            }
        }
        J.qg = inptr(is128 ? I_DQN : J.has_sink ? I_WQN : I_GQN) + l * 64;
        if (PROBE) { J.O = wsb(p, WS_H) + (J.O - (is128 ? wsb(p, WS_OD) : wsb(p, WS_BR))); }
        if (is128) attn_unit<128, PROBE>(J, lds); else attn_unit<64, PROBE>(J, lds);
    }
}

constexpr int NPL = 10;
constexpr int N_PHASES = 1 + DEPTH * NPL;
#ifndef PG8_SP2
#define PG8_SP2 true
#endif
#ifndef PG8_ALIGN
#define PG8_ALIGN true
#endif
__global__ void __launch_bounds__(512, 2) fwd_kernel(Params p_) {
    extern __shared__ __attribute__((aligned(16))) unsigned char lds_raw[];
    LAS unsigned char* lds = (LAS unsigned char*)lds_raw;
    const int tid = threadIdx.x, G = gridDim.x;
    const int lo = p_.ph_lo, hi = p_.ph_hi;
    Params p = p_; p.ph_hi = __builtin_amdgcn_readfirstlane(tid >> 6);
    for (int u = tid; u < (LDS_BYTES - LDSCTL_OFF) / 4; u += 512) ((LAS unsigned*)(lds + LDSCTL_OFF))[u] = 0u;
    __syncthreads();
    XcdBarrier bar = xcd_barrier_post((unsigned*)(p.ws + WS_CTL) + 1024, (volatile LAS unsigned*)(lds + LDSCTL_OFF + 64), p.ph_hi);
#ifndef PH_MASK
#define PH_MASK 0xFFFFFFFFu
#endif
#define IN(k) (lo <= (k) && (k) < hi)
#define EN(b) ((PH_MASK >> (b)) & 1u)
#ifndef ATT_PROBE
#define ATT_PROBE 0
#endif
#ifndef DUP_MASK
#define DUP_MASK 0u
#endif
#define DUP(b) (((DUP_MASK >> (b)) & 1u) ? 2 : 1)
#define SEAM(k) do { if (IN(k) && IN((k) + 1)) xcd_barrier(bar); } while (0)

    if (IN(0) && EN(10)) for (int rep_ = 0; rep_ < DUP(10); ++rep_) { prologue_phase(p, lds); __syncthreads(); }
    SEAM(0);
#pragma unroll 1
    for (int l = 0; l < DEPTH; ++l) {
        const int pb = 1 + l * NPL;
        const bf16* WL = wsb(p, WS_W) + (size_t)l * WL_ELEMS;
        const float* modl = wsf(p, WS_MOD) + (size_t)l * 5 * 12288;
        if (IN(pb + 0) && EN(0)) for (int rep_ = 0; rep_ < DUP(0); ++rep_) { if (l == 0) norm_phase<false>(p, l, 0); else norm_phase<true>(p, l, 0); }
        SEAM(pb + 0);
        if (IN(pb + 1) && EN(1)) for (int rep_ = 0; rep_ < DUP(1); ++rep_) {
            { pg8::Gemm g{wsb(p, WS_H), WL + W_IN_T, MROWS, DIN, DMODEL, 0, 0, p.ph_hi}; pg8::StaticOrder S; S.init(MROWS, DIN, G, (int)blockIdx.x);
              pg8::EpiBf16<0> E{wsb(p, WS_Z), DIN, nullptr, 0};
              pg8::gemm_phase<pg8::EpiBf16<0>, pg8::StaticOrder, PG8_ALIGN, PG8_SP2>(lds, g, S, E); }
            { pg8::Gemm g{(const bf16*)(p.ws + WS_H8), (const bf16*)(p.ws + WS_W8 + (size_t)l * 8192 * 2048), MROWS, 4 * DMODEL, DMODEL / 2, 0, 0, p.ph_hi}; pg8::StaticOrder S; S.init(MROWS, 4 * DMODEL, G, (int)blockIdx.x);
              pg8::EpiGateU8 E{p.ws + WS_G, inptr(I_BGATE) + (size_t)l * 4 * DMODEL, 0};
              pg8::gemm_phase<pg8::EpiGateU8, pg8::StaticOrder, false, PG8_SP2>(lds, g, S, E); }
        }
        SEAM(pb + 1);
        if (IN(pb + 2) && EN(2)) { prep_phase(p, l, lds); __syncthreads(); for (int rep_ = 0; rep_ < DUP(2); ++rep_) lru_pass1(p, l, lds); }
        SEAM(pb + 2);
        if (IN(pb + 3) && EN(3)) {
#if ATT_PROBE
            attn_phase<ATT_PROBE>(p, l, lds); __syncthreads();
#endif
            for (int rep_ = 0; rep_ < DUP(3); ++rep_) { attn_phase<0>(p, l, lds); __syncthreads(); } for (int rep_ = 0; rep_ < DUP(11); ++rep_) lru_pass2(p, l, lds); }
        SEAM(pb + 3);
        if (IN(pb + 4) && EN(4)) for (int rep_ = 0; rep_ < DUP(4); ++rep_) dcomb_phase(p, l);
        SEAM(pb + 4);
        if (IN(pb + 5) && EN(5)) for (int rep_ = 0; rep_ < DUP(5); ++rep_) {
            pg8::Gemm g{wsb(p, WS_BR), WL + W_BR_T, MROWS, DMODEL, DMODEL, 0, 0, p.ph_hi}; pg8::StaticOrder S; S.init(MROWS, DMODEL, G, (int)blockIdx.x);
            pg8::EpiMerge E{p.ws + WS_G, wsb(p, WS_H)};
            pg8::gemm_phase<pg8::EpiMerge, pg8::StaticOrder, PG8_ALIGN, PG8_SP2>(lds, g, S, E);
        }
        SEAM(pb + 5);
        if (IN(pb + 6) && EN(6)) {
            pg8::Gemm g{wsb(p, WS_H), WL + W_O_T, MROWS, DMODEL, DMODEL, 0, 0, p.ph_hi}; pg8::StaticOrder S; S.init(MROWS, DMODEL, G, (int)blockIdx.x);
            if (l == 0) { pg8::EpiRes<false, true> E{inptr(I_XP), inptr(I_XS) - (size_t)M_C * DMODEL, p.ws + WS_XB, modl + 2 * 2048, nullptr, 0};
                pg8::gemm_phase<pg8::EpiRes<false, true>, pg8::StaticOrder, PG8_ALIGN, PG8_SP2>(lds, g, S, E); }
            else { pg8::EpiRes<true, true> E{p.ws + WS_XB, p.ws + WS_XB, p.ws + WS_XB, modl + 2 * 2048, nullptr, 0};
                pg8::gemm_phase<pg8::EpiRes<true, true>, pg8::StaticOrder, PG8_ALIGN, PG8_SP2>(lds, g, S, E); }
        }
        SEAM(pb + 6);
        if (IN(pb + 7) && EN(7)) norm_phase<true>(p, l, 1);
        SEAM(pb + 7);
        if (IN(pb + 8) && EN(8)) for (int rep_ = 0; rep_ < DUP(8); ++rep_) {
            pg8::Gemm g{wsb(p, WS_H), WL + W_FF1_T, MROWS, DFF, DMODEL, 0, 0, p.ph_hi}; pg8::StaticOrder S; S.init(MROWS, DFF, G, (int)blockIdx.x);
            pg8::EpiBf16<2> E{wsb(p, WS_G), DFF, inptr(I_BFF1) + (size_t)l * DFF, 0};
            pg8::gemm_phase<pg8::EpiBf16<2>, pg8::StaticOrder, PG8_ALIGN, PG8_SP2>(lds, g, S, E);
        }
        SEAM(pb + 8);
        if (IN(pb + 9) && EN(9)) {
            pg8::Gemm g{wsb(p, WS_G), WL + W_FF2_T, MROWS, DMODEL, DFF, 0, 0, p.ph_hi}; pg8::StaticOrder S; S.init(MROWS, DMODEL, G, (int)blockIdx.x);
            if (l == DEPTH - 1) { pg8::EpiRes<true, false> E{p.ws + WS_XB, p.ws + WS_XB, p.out, modl + 5 * 2048, inptr(I_BFF2) + (size_t)l * DMODEL, 0};
                pg8::gemm_phase<pg8::EpiRes<true, false>, pg8::StaticOrder, PG8_ALIGN, PG8_SP2>(lds, g, S, E); }
            else { pg8::EpiRes<true, true> E{p.ws + WS_XB, p.ws + WS_XB, p.ws + WS_XB, modl + 5 * 2048, inptr(I_BFF2) + (size_t)l * DMODEL, 0};
                pg8::gemm_phase<pg8::EpiRes<true, true>, pg8::StaticOrder, PG8_ALIGN, PG8_SP2>(lds, g, S, E); }
        }
        SEAM(pb + 9);
    }
#undef IN
#undef SEAM
}

#if DBG
#ifndef CHECK_L
#define CHECK_L 0
#endif
constexpr size_t DBG_ERR = WS_DBG;
constexpr size_t DBG_ZS = WS_DBG + 1 * MiB;
constexpr size_t DBG_XS = WS_DBG + 2 * MiB;
constexpr size_t DBG_XS2 = WS_DBG + 3 * MiB;
constexpr size_t DBG_SC = WS_DBG + 4 * MiB;
constexpr size_t DBG_END = WS_DBG + 16 * MiB;
__device__ __forceinline__ unsigned dh(unsigned x) { x ^= x >> 16; x *= 0x7feb352du; x ^= x >> 15; x *= 0x846ca68bu; x ^= x >> 16; return x; }
__device__ __forceinline__ int srow(int i) {
    switch (i) { case 0: return 0; case 1: return 1; case 2: return 255; case 3: return 256; case 4: return 511; case 5: return 8191; case 6: return 8192; case 7: return 8193; case 8: return 8192 + 127; case 9: return 8192 + 128;
        case 10: return 8192 + 4095; case 11: return 8192 + 4096; case 12: return 8192 + 8191; case 13: return 24575; case 14: return 24575 - 4096; case 15: return 4000; default: break; }
    return (int)(dh(i * 7919u + 13u) % (unsigned)MROWS);
}
__device__ __forceinline__ void rep(const Params& p, int stage, float got, float ref, float atol) {
    float e = fabsf(got - ref) / (fabsf(ref) + atol); if (!(e == e) || !(got == got)) e = 1e6f;
    atomicMax((unsigned*)(p.ws + DBG_ERR) + stage, __float_as_uint(e));
}
__device__ __forceinline__ float f8d(unsigned char b) { const int e = (b >> 3) & 15, m = b & 7; const float v = e ? ldexpf(1.0f + m * 0.125f, e - 7) : ldexpf(m * 0.125f, -6); return (b & 128) ? -v : v; }
__device__ __forceinline__ float bfr(float x) { return __uint_as_float(f2bf(x) << 16); }
__device__ __forceinline__ const float* xrow(const Params& p, int l, int r) { return (r < M_C ? xbase_ctx(p, l) : xbase_lat(p, l)) + (size_t)r * 2048; }
__device__ __forceinline__ int rcond(int r) { return r < M_C ? 0 : 1 + ((r - M_C) >> 12); }

__global__ void ck_prologue(Params p, int l) {
    const int gt = blockIdx.x * blockDim.x + threadIdx.x;
    const bf16* WL = wsb(p, WS_W) + (size_t)l * WL_ELEMS;
    {
        const unsigned h0 = dh(gt * 2654435761u + 1u), h1 = dh(h0 + 77u);
        { const int k = h0 % 2048, n = h1 % 4096; rep(p, 0, bf2f(WL[W_IN_T + (size_t)n * 2048 + k]), bfr(p.in[I_WIN][((size_t)l * 2048 + k) * 4096 + n]), 1e-6f); }
        { const int k = h0 % 2048, n = h1 % 8192; rep(p, 0, f8d(p.ws[WS_W8 + ((size_t)l * 8192 + n) * 2048 + k]) * 0.015625f * 0.5f, p.in[I_WGATE][((size_t)l * 2048 + k) * 8192 + n] * 0.5f, 0.02f); }
        { const int b = h0 & 3, k = (h0 >> 2) % 512, n = h1 % 2048; rep(p, 0, bf2f(WL[W_BR_T + (size_t)n * 2048 + b * 512 + k]), bfr(p.in[I_WBR][(((size_t)l * 4 + b) * 512 + k) * 2048 + n]), 1e-6f); }
        { const int k = h0 % 2048, n = h1 % 2048; rep(p, 0, bf2f(WL[W_O_T + (size_t)n * 2048 + k]), bfr(p.in[I_WO][((size_t)l * 2048 + k) * 2048 + n]), 1e-6f); }
        { const int k = h0 % 2048, n = h1 % 8192; rep(p, 0, bf2f(WL[W_FF1_T + (size_t)n * 2048 + k]), bfr(p.in[I_WFF1][((size_t)l * 2048 + k) * 8192 + n]), 1e-6f); }
        { const int k = h0 % 8192, n = h1 % 2048; rep(p, 0, bf2f(WL[W_FF2_T + (size_t)n * 8192 + k]), bfr(p.in[I_WFF2][((size_t)l * 8192 + k) * 2048 + n]), 1e-6f); }
        { const int bl = h0 & 15, s = (h0 >> 4) % 512, c = h1 % 128;
          rep(p, 2, bf2f(wsb(p, CK_WK)[((size_t)bl * 512 + s) * 128 + c]), bfr(p.in[I_CWK][((size_t)bl * 512 + s) * 128 + c]), 1e-6f);
          rep(p, 2, bf2f(wsb(p, CK_GK)[((size_t)bl * 512 + s) * 128 + c]), bfr(p.in[I_CGK][((size_t)bl * 512 + s) * 128 + c]), 1e-6f);
          rep(p, 2, bf2f(wsb(p, CK_WVT)[((size_t)bl * 128 + c) * 512 + (s ^ ((c & 16) >> 2))]), bfr(p.in[I_CWV][((size_t)bl * 512 + s) * 128 + c]), 1e-6f);
          rep(p, 2, bf2f(wsb(p, CK_GVT)[((size_t)bl * 128 + c) * 512 + (s ^ ((c & 16) >> 2))]), bfr(p.in[I_CGV][((size_t)bl * 512 + s) * 128 + c]), 1e-6f);
          const int c5 = h1 % 512;
          rep(p, 2, bf2f(wsb(p, CK_DK)[((size_t)bl * 512 + s) * 512 + c5]), bfr(p.in[I_CDK][((size_t)bl * 512 + s) * 512 + c5]), 1e-6f);
          rep(p, 2, bf2f(wsb(p, CK_DVT)[((size_t)bl * 512 + c5) * 512 + (s ^ ((c5 & 16) >> 2))]), bfr(p.in[I_CDV][((size_t)bl * 512 + s) * 512 + c5]), 1e-6f);
          const int g = h0 & 1, lkn = (h0 >> 1) & 63, c6 = (h0 >> 8) & 63, d6 = h1 & 63;
          rep(p, 2, bf2f(wsb(p, WS_LRUW)[((size_t)(g * 64 + lkn) * 64 + d6) * 64 + c6]), bfr(p.in[g ? I_LWI : I_LWR][((size_t)lkn * 64 + c6) * 64 + d6]), 1e-6f);
          const int pos = h0 & 63, f = h1 & 15; const float ang = (float)pos * powf(10000.f, -(float)f / 16.f);
          rep(p, 2, wsf(p, WS_TAB)[TAB_COS + pos * 16 + f], cosf(ang), 1e-3f); rep(p, 2, wsf(p, WS_TAB)[TAB_SIN + pos * 16 + f], sinf(ang), 1e-3f); }
    }
    if (gt < 1024) { const int cond = gt % 5, j = dh(gt) % 12288; float s = 0.f;
        for (int k = 0; k < 2048; ++k) { const float c = cond == 0 ? p.in[I_CCTX][k] : p.in[I_C][(cond - 1) * 2048 + k]; s += (c / (1.f + expf(-c))) * p.in[I_WADA][((size_t)l * 2048 + k) * 12288 + j]; }
        rep(p, 1, wsf(p, WS_MOD)[((size_t)l * 5 + cond) * 12288 + j], s + p.in[I_BADA][l * 12288 + j], 1e-2f); }
}
__global__ void ck_norm(Params p, int l, int which, int stage) {
    const int r = srow(blockIdx.x); const float* x = xrow(p, l + which, r); __shared__ float red[256];
    float ss = 0.f; for (int c = threadIdx.x; c < 2048; c += 256) ss += x[c] * x[c];
    red[threadIdx.x] = ss; __syncthreads(); for (int o = 128; o > 0; o >>= 1) { if (threadIdx.x < o) red[threadIdx.x] += red[threadIdx.x + o]; __syncthreads(); }
    const float rstd = 1.f / sqrtf(red[0] / 2048.f + 1e-6f); const float* modl = wsf(p, WS_MOD) + ((size_t)l * 5 + rcond(r)) * 12288 + (which ? 3 : 0) * 2048;
    const float* g = p.in[which ? I_N2G : I_N1G] + l * 2048;
    for (int c = threadIdx.x; c < 2048; c += 256) rep(p, stage, bf2f(wsb(p, WS_H)[(size_t)r * 2048 + c]), x[c] * rstd * g[c] * (1.f + modl[2048 + c]) + modl[c], 0.05f);
}
__global__ void ck_gemm(Params p, int l, int mode, int stage) {
    const int r = srow(blockIdx.x); const bf16* WL = wsb(p, WS_W) + (size_t)l * WL_ELEMS;
    const bf16* A; const bf16* Bt; int N, K;
    if (mode == 0) { A = wsb(p, WS_H); Bt = WL + W_IN_T; N = 4096; K = 2048; } else if (mode == 1) { A = wsb(p, WS_H); Bt = WL + W_GATE_T; N = 8192; K = 2048; }
    else if (mode == 2) { A = wsb(p, WS_H); Bt = WL + W_FF1_T; N = 8192; K = 2048; } else if (mode == 3) { A = wsb(p, WS_H); Bt = WL + W_O_T; N = 2048; K = 2048; }
    else { A = wsb(p, WS_G); Bt = WL + W_FF2_T; N = 2048; K = 8192; }
    const int n = dh(blockIdx.x * 1000u + threadIdx.x * 31u + mode) % N;
    float s = 0.f;
    if (mode == 1) { const unsigned char* a8 = p.ws + WS_H8 + (size_t)r * 2048; const unsigned char* b8 = p.ws + WS_W8 + ((size_t)l * 8192 + n) * 2048; for (int k = 0; k < 2048; ++k) s += f8d(a8[k]) * f8d(b8[k]); s *= 0.015625f; }
    else for (int k = 0; k < K; ++k) s += bf2f(A[(size_t)r * K + k]) * bf2f(Bt[(size_t)n * K + k]);
    const float* modl = wsf(p, WS_MOD) + ((size_t)l * 5 + rcond(r)) * 12288;
    if (mode == 0) rep(p, stage, bf2f(wsb(p, WS_Z)[(size_t)r * 4096 + n]), s, 0.05f);
    if (mode == 1) rep(p, stage, bf2f(wsb(p, WS_G)[(size_t)r * 8192 + n]), 1.f + expf(-(s + p.in[I_BGATE][l * 8192 + n])), 0.05f);
    if (mode == 2) { const float a = fmaxf(s + p.in[I_BFF1][l * 8192 + n], 0.f); rep(p, stage, bf2f(wsb(p, WS_G)[(size_t)r * 8192 + n]), a * a, 0.05f); }
    if (mode == 3) rep(p, stage, p.out[(size_t)r * 2048 + n], wsf(p, DBG_XS)[(size_t)blockIdx.x * 2048 + n] + modl[2 * 2048 + n] * s, 0.05f);
    if (mode == 4) rep(p, stage, p.out[(size_t)r * 2048 + n], wsf(p, DBG_XS2)[(size_t)blockIdx.x * 2048 + n] + modl[5 * 2048 + n] * (s + p.in[I_BFF2][l * 2048 + n]), 0.05f);
}
__global__ void ck_save_z(Params p) { const int r = srow(blockIdx.x); for (int c = threadIdx.x; c < 4096; c += blockDim.x) wsb(p, DBG_ZS)[(size_t)blockIdx.x * 4096 + c] = wsb(p, WS_Z)[(size_t)r * 4096 + c]; }
__global__ void ck_save_x(Params p, int l, size_t dst) { const int r = srow(blockIdx.x); const float* x = xrow(p, l, r); for (int c = threadIdx.x; c < 2048; c += blockDim.x) wsf(p, dst)[(size_t)blockIdx.x * 2048 + c] = x[c]; }
__global__ void ck_prep(Params p, int l, int st) {
    const int r = srow(blockIdx.x); const bf16* zs = wsb(p, DBG_ZS) + (size_t)blockIdx.x * 4096; const bf16* z = wsb(p, WS_Z) + (size_t)r * 4096;
    const bool isctx = r < M_C; const int seq = isctx ? r >> 8 : (r - M_C) >> 12, t = isctx ? r & 255 : (r - M_C) & 4095;
    for (int idx = threadIdx.x; idx < 36 * 64; idx += blockDim.x) {
        const int v = idx >> 6, d = idx & 63;
        int col; const float* gain; bool isq; size_t ko = 0;
        if (v < 8) { col = ZC_QW + v * 64; gain = p.in[I_WQN]; isq = true; } else if (v < 10) { col = ZC_KW + (v - 8) * 64; gain = p.in[I_WKN]; isq = false; ko = O_WK + ((size_t)(seq * 4 + l) * 256 + t) * 128 + (v - 8) * 64; }
        else if (v < 18) { col = ZC_QG + (v - 10) * 64; gain = p.in[I_GQN]; isq = true; } else if (v < 20) { col = ZC_KG + (v - 18) * 64; gain = p.in[I_GKN]; isq = false; ko = O_GK + ((size_t)(seq * 4 + l) * 256 + t) * 128 + (v - 18) * 64; }
        else if (v < 28) { col = ZC_QD + (v - 20) * 64; gain = p.in[I_DQN]; isq = true; } else { col = ZC_KD + (v - 28) * 64; gain = p.in[I_DKN]; isq = false; ko = O_DK + ((size_t)(seq * 4 + l) * 256 + t) * 512 + (v - 28) * 64; }
        float ss = 0.f; for (int e = 0; e < 64; ++e) { const float xe = bf2f(zs[col + e]); ss += xe * xe; }
        const float rstd = 1.f / sqrtf(ss / 64.f + 1e-6f);
        float y = bf2f(zs[col + d]) * rstd * gain[l * 64 + d];
        if (isctx && !isq) rep(p, st + 1, p.out[ko + d], y, 0.02f);
        if (!isctx) { const int axis = d >> 5, half = (d >> 4) & 1, f = d & 15; const float pos = axis ? (float)(t & 63) : (float)(t >> 6); const float ang = pos * powf(10000.f, -(float)f / 16.f), c = cosf(ang), sn = sinf(ang);
            const float x1 = bf2f(zs[col + axis * 32 + f]) * rstd * gain[l * 64 + axis * 32 + f], x2 = bf2f(zs[col + axis * 32 + 16 + f]) * rstd * gain[l * 64 + axis * 32 + 16 + f]; y = half ? x2 * c + x1 * sn : x1 * c - x2 * sn; }
        if (isq) y *= 0.125f * 1.4426950408889634f;
        rep(p, st, bf2f(z[col + d]), y, 0.03f);
    }
    for (int idx = threadIdx.x; idx < 96 * 8; idx += blockDim.x) {
        const int g = idx >> 3, j = idx & 7; int col; size_t vo; const bf16* vt; const int T = isctx ? T_C : T_L;
        if (g < 16) { col = ZC_VW + g * 8; vo = O_WV + ((size_t)(seq * 4 + l) * 256 + t) * 128 + g * 8; vt = wsb(p, isctx ? VT_BC : VT_BL) + (size_t)(seq * 128 + g * 8) * T; }
        else if (g < 32) { col = ZC_VG + (g - 16) * 8; vo = O_GV + ((size_t)(seq * 4 + l) * 256 + t) * 128 + (g - 16) * 8; vt = wsb(p, isctx ? VT_CC : VT_CL) + (size_t)(seq * 128 + (g - 16) * 8) * T; }
        else { col = ZC_VD + (g - 32) * 8; vo = O_DV + ((size_t)(seq * 4 + l) * 256 + t) * 512 + (g - 32) * 8; vt = wsb(p, isctx ? VT_DC : VT_DL) + (size_t)(seq * 512 + (g - 32) * 8) * T; }
        const float zv = bf2f(zs[col + j]); if (isctx) rep(p, st + 1, p.out[vo + j], zv, 1e-3f); rep(p, st + 2, bf2f(vt[(size_t)j * T + (t ^ ((((g < 16 ? g : g < 32 ? g - 16 : g - 32) * 8 + j) & 16) >> 2))]), zv, 1e-6f); rep(p, st + 2, bf2f(z[col + j]), zv, 1e-6f);
    }
}
__global__ void ck_lru(Params p, int l, int stage) {
    const int i = blockIdx.x * blockDim.x + threadIdx.x; if (i >= 48) return;
    const bool lat = i < 16; const int seq = lat ? (i & 3) : (int)(dh(i) % 32u), ch = lat ? (int)(dh(i * 3u + 5u) % 512u) : (int)(dh(i * 5u + 1u) % 512u), n = ch >> 6, cl = ch & 63;
    const int T = lat ? T_L : T_C, row0 = lat ? M_C + seq * T_L : seq * T_C; const bf16* Z = wsb(p, WS_Z); float* HF = wsf(p, DBG_SC) + (size_t)i * 4096;
    for (int dir = 0; dir < 2; ++dir) {
        float h = lat ? p.in[I_SLRU][((size_t)(seq * 4 + l) * 2 + dir) * 512 + ch] : 0.f;
        const float spl = log1pf(expf(-p.in[I_LLAM][(l * 2 + dir) * 512 + ch]));
        for (int s = 0; s < T; ++s) { const int t = dir ? T - 1 - s : s;
            float pr = p.in[I_LBR][(l * 2 + dir) * 512 + ch], pi = p.in[I_LBI][(l * 2 + dir) * 512 + ch], umine = 0.f;
            for (int c = 0; c < 64; ++c) { float u = p.in[I_CONVB][l * 512 + n * 64 + c];
                for (int k = 0; k < 4; ++k) { const int tk = t + k - 1; if (tk >= 0 && tk < T) u += p.in[I_CONVW][(l * 4 + k) * 512 + n * 64 + c] * bf2f(Z[(size_t)(row0 + tk) * 4096 + n * 64 + c]); }
                if (c == cl) umine = u;
                const float ub = bfr(u);
                pr += ub * bfr(p.in[I_LWR][((size_t)((l * 2 + dir) * 8 + n) * 64 + c) * 64 + cl]); pi += ub * bfr(p.in[I_LWI][((size_t)((l * 2 + dir) * 8 + n) * 64 + c) * 64 + cl]); }
            const float rg = 1.f / (1.f + expf(-pr)), ig = 1.f / (1.f + expf(-pi)), la = -8.f * rg * spl, a = expf(la), b = sqrtf(-expm1f(2.f * la)) * ig * umine;
            h = a * h + b;
            if (dir == 0) HF[t] = h;
            else { const float y = bf2f(Z[(size_t)(row0 + t) * 4096 + 512 + ch]); const float gl = 0.5f * y * (1.f + tanhf(0.7978845608028654f * (y + 0.044715f * y * y * y)));
                rep(p, stage, bf2f(wsb(p, WS_BR)[(size_t)(row0 + t) * BRP + ch]), (HF[t] + h) * gl, 0.02f); }
        }
        if (!lat) rep(p, stage + 1, p.out[O_LS + ((size_t)(seq * 4 + l) * 2 + dir) * 512 + ch], h, 0.02f);
    }
}
__global__ void ck_attn(Params p, int l, int stage) {
    const int i = blockIdx.x, lane = threadIdx.x; const unsigned h0 = dh(i * 97u + 3u), h1 = dh(h0 + 11u);
    const int type = i % 3; const bool lat = (i / 3) & 1; const int seq = lat ? (h0 & 3) : (h0 & 31), head = (h0 >> 5) & 7;
    int t = lat ? (int)(h1 % 4096u) : (int)(h1 % 256u); if (i < 12) t = (i & 1) ? (lat ? 4095 : 255) : 0; if (i >= 12 && i < 24 && lat) t = 128 + (i & 1);
    const int T = lat ? T_L : T_C, row0 = lat ? M_C + seq * T_L : seq * T_C, r = row0 + t; const bf16* Z = wsb(p, WS_Z); __shared__ float SC[4608];
    int qcol, kcol, vcol, vw, kvh; const float* ck; const float* cv; int cpitch, ckoff, cvoff;
    if (type == 0) { kvh = head >> 2; qcol = ZC_QW + head * 64; kcol = ZC_KW + kvh * 64; vcol = ZC_VW + kvh * 64; vw = 64; ck = p.in[I_CWK]; cv = p.in[I_CWV]; cpitch = 128; ckoff = kvh * 64; cvoff = kvh * 64; }
    else if (type == 1) { kvh = head >> 2; qcol = ZC_QG + head * 64; kcol = ZC_KG + kvh * 64; vcol = ZC_VG + kvh * 64; vw = 64; ck = p.in[I_CGK]; cv = p.in[I_CGV]; cpitch = 128; ckoff = kvh * 64; cvoff = kvh * 64; }
    else { qcol = ZC_QD + head * 64; kcol = ZC_KD + head * 64; vcol = ZC_VD + (head >> 1) * 128; vw = 128; ck = p.in[I_CDK]; cv = p.in[I_CDV]; cpitch = 512; ckoff = head * 64; cvoff = (head >> 1) * 128; }
    const int nk = lat ? T_L + PAST : T_C; float q[64];
#pragma unroll
    for (int d = 0; d < 64; ++d) q[d] = bf2f(Z[(size_t)r * 4096 + qcol + d]);
    float mx = -1e30f;
    for (int k = lane; k < nk; k += 64) { float s = 0.f; bool ok = true;
        if (k < T) {
#pragma unroll
            for (int d = 0; d < 64; ++d) s += q[d] * bf2f(Z[(size_t)(row0 + k) * 4096 + kcol + d]); if (type == 0 && lat) { int dd = t - k; dd = dd < 0 ? -dd : dd; ok = dd <= 128; } }
        else { const float* kp = ck + ((size_t)(seq * 4 + l) * 512 + (k - T)) * cpitch + ckoff;
#pragma unroll
            for (int d = 0; d < 64; ++d) s += q[d] * kp[d]; }
        s = ok ? s : -INFINITY; SC[k] = s; mx = fmaxf(mx, s); }
    for (int o = 32; o > 0; o >>= 1) mx = fmaxf(mx, __shfl_xor(mx, o));
    float sum = 0.f; for (int k = lane; k < nk; k += 64) { const float e = exp2f(SC[k] - mx); SC[k] = e; sum += e; }
    for (int o = 32; o > 0; o >>= 1) sum += __shfl_xor(sum, o);
    __syncthreads();
    if (type == 0) sum += exp2f(p.in[I_WSINK][l * 8 + head] * 1.4426950408889634f - mx);
    __syncthreads();
    for (int d = lane; d < vw; d += 64) { float o = 0.f;
        for (int k = 0; k < nk; ++k) { const float v = k < T ? bf2f(Z[(size_t)(row0 + k) * 4096 + vcol + d]) : cv[((size_t)(seq * 4 + l) * 512 + (k - T)) * cpitch + cvoff + d]; o += SC[k] * v; }
        o /= sum;
        const float got = type == 0 ? bf2f(wsb(p, WS_BR)[(size_t)r * BRP + 512 + head * 64 + d]) : type == 1 ? bf2f(wsb(p, WS_BR)[(size_t)r * BRP + 1024 + head * 64 + d]) : bf2f(wsb(p, WS_OD)[(size_t)r * 1024 + head * 128 + d]);
        rep(p, stage + type, got, o, 0.02f); }
}
__global__ void ck_dcomb(Params p, int l, int stage) {
    const int r = srow(blockIdx.x), h = threadIdx.x >> 7, e = threadIdx.x & 127; __shared__ float red[512];
    float s1 = 0.f, s2 = 0.f; for (int d = 0; d < 64; ++d) { s1 += p.in[I_LQ1][l * 64 + d] * p.in[I_LK1][l * 64 + d]; s2 += p.in[I_LQ2][l * 64 + d] * p.in[I_LK2][l * 64 + d]; }
    const float li = 0.8f - 0.6f * expf(-0.3f * l), lam = expf(s1) - expf(s2) + li;
    const float o = bf2f(wsb(p, WS_OD)[(size_t)r * 1024 + (h * 2) * 128 + e]) - lam * bf2f(wsb(p, WS_OD)[(size_t)r * 1024 + (h * 2 + 1) * 128 + e]);
    red[threadIdx.x] = o * o; __syncthreads(); for (int st = 64; st > 0; st >>= 1) { if (e < st) red[threadIdx.x] += red[threadIdx.x + st]; __syncthreads(); }
    rep(p, stage, bf2f(wsb(p, WS_BR)[(size_t)r * BRP + 1536 + h * 128 + e]), o / sqrtf(red[h * 128] / 128.f + 1e-6f) * p.in[I_DOG][l * 128 + e] * (1.f - li), 0.02f);
}
__global__ void ck_merge(Params p, int l, int stage) {
    const int r = srow(blockIdx.x), n = dh(blockIdx.x * 777u + threadIdx.x) % 2048; const bf16* WL = wsb(p, WS_W) + (size_t)l * WL_ELEMS; float tot = 0.f;
    for (int b = 0; b < 4; ++b) { float s = 0.f; for (int c = 0; c < 512; ++c) s += bf2f(wsb(p, WS_BR)[(size_t)r * BRP + b * 512 + c]) * bf2f(WL[W_BR_T + (size_t)n * 2048 + b * 512 + c]);
        tot += s / bf2f(wsb(p, WS_G)[(size_t)r * 8192 + b * 2048 + n]); }
    rep(p, stage, bf2f(wsb(p, WS_H)[(size_t)r * 2048 + n]), tot, 0.05f);
}
__global__ void ck_encode(Params p) {
    if (threadIdx.x || blockIdx.x) return; const float* e = wsf(p, DBG_ERR);
    for (int s = 0; s < 64; ++s) if (e[s] > 0.06f) { int q = (int)floorf(log10f(e[s])); q = q < -6 ? -6 : q > 3 ? 3 : q; p.out[0] = (float)(10 + s) * powf(10.f, (float)(12 + q)); return; }
}
static void dbg_run(Params p, int grid, hipStream_t stream) {
    (void)hipMemsetAsync(p.ws + DBG_ERR, 0, 256, stream);
    auto ph = [&](int k) { p.ph_lo = k; p.ph_hi = k + 1; hipLaunchKernelGGL(fwd_kernel, dim3(grid), dim3(512), LDS_BYTES, stream, p); };
    ph(0);
    hipLaunchKernelGGL(ck_prologue, dim3(64), dim3(256), 0, stream, p, CHECK_L);
    for (int l = 0; l < DEPTH; ++l) {
        const int pb = 1 + l * NPL; const bool c = (l == CHECK_L);
        ph(pb + 0); if (c) hipLaunchKernelGGL(ck_norm, dim3(64), dim3(256), 0, stream, p, l, 0, 3);
        ph(pb + 1); if (c) { hipLaunchKernelGGL(ck_gemm, dim3(64), dim3(128), 0, stream, p, l, 0, 4); hipLaunchKernelGGL(ck_gemm, dim3(64), dim3(128), 0, stream, p, l, 1, 5); hipLaunchKernelGGL(ck_save_z, dim3(64), dim3(256), 0, stream, p); }
        ph(pb + 2); if (c) hipLaunchKernelGGL(ck_prep, dim3(64), dim3(256), 0, stream, p, l, 6);
        ph(pb + 3); if (c) { hipLaunchKernelGGL(ck_lru, dim3(1), dim3(64), 0, stream, p, l, 9); hipLaunchKernelGGL(ck_attn, dim3(240), dim3(64), 0, stream, p, l, 11); }
        ph(pb + 4); if (c) hipLaunchKernelGGL(ck_dcomb, dim3(64), dim3(512), 0, stream, p, l, 14);
        ph(pb + 5); if (c) { hipLaunchKernelGGL(ck_merge, dim3(64), dim3(128), 0, stream, p, l, 15); hipLaunchKernelGGL(ck_save_x, dim3(64), dim3(256), 0, stream, p, l, DBG_XS); }
        ph(pb + 6); if (c) { hipLaunchKernelGGL(ck_gemm, dim3(64), dim3(128), 0, stream, p, l, 3, 16); hipLaunchKernelGGL(ck_save_x, dim3(64), dim3(256), 0, stream, p, l + 1, DBG_XS2); }
        ph(pb + 7); if (c) hipLaunchKernelGGL(ck_norm, dim3(64), dim3(256), 0, stream, p, l, 1, 17);
        ph(pb + 8); if (c) hipLaunchKernelGGL(ck_gemm, dim3(64), dim3(128), 0, stream, p, l, 2, 18);
        ph(pb + 9); if (c) hipLaunchKernelGGL(ck_gemm, dim3(64), dim3(128), 0, stream, p, l, 4, 19);
    }
    hipLaunchKernelGGL(ck_encode, dim3(1), dim3(64), 0, stream, p);
}
#endif

extern "C" void kernel_launch(void* const* d_in, const int* in_sizes, int n_in, void* d_out, int out_size, void* d_ws, size_t ws_size, hipStream_t stream) {
    static int grid = 0;
    if (grid == 0) {
        size_t need = WS_END;
#if DBG
        need = DBG_END;
#endif
        if (n_in != N_IN || (size_t)out_size != O_END || ws_size < need) { fprintf(stderr, "kernel_launch: unexpected sizes: n_in %d out %d ws %zu (need %zu); nothing launched\n", n_in, out_size, ws_size, need); grid = -1; return; }
        int dev = 0, cus = 0, per_cu = 0;
        if (hipGetDevice(&dev) != hipSuccess || hipDeviceGetAttribute(&cus, hipDeviceAttributeMultiprocessorCount, dev) != hipSuccess) { grid = -1; return; }
        if (hipFuncSetAttribute((const void*)fwd_kernel, hipFuncAttributeMaxDynamicSharedMemorySize, LDS_BYTES) != hipSuccess) { fprintf(stderr, "kernel_launch: hipFuncSetAttribute failed\n"); grid = -1; return; }
        if (hipOccupancyMaxActiveBlocksPerMultiprocessor(&per_cu, (const void*)fwd_kernel, 512, LDS_BYTES) != hipSuccess || per_cu < 1) { fprintf(stderr, "kernel_launch: occupancy query says %d\n", per_cu); grid = -1; (void)hipGetLastError(); return; }
        grid = cus;
    }
    if (grid < 0) return;
    (void)hipMemsetAsync(d_ws, 0, ZERO_BYTES, stream);
    Params p{};
    for (int i = 0; i < N_IN; ++i) p.in[i] = (const float*)d_in[i];
    p.out = (float*)d_out; p.ws = (unsigned char*)d_ws;
#if DBG
    dbg_run(p, grid, stream);
#else
#if MULTI
    for (int ph = 0; ph < N_PHASES; ++ph) { p.ph_lo = ph; p.ph_hi = ph + 1; hipLaunchKernelGGL(fwd_kernel, dim3(grid), dim3(512), LDS_BYTES, stream, p); }
#else
    p.ph_lo = 0; p.ph_hi = N_PHASES;
    hipLaunchKernelGGL(fwd_kernel, dim3(grid), dim3(512), LDS_BYTES, stream, p);
#endif
#endif
}
```

```cpp
#include <hip/hip_runtime.h>
#include <cstdio>
#include <cstdint>

__device__ __forceinline__ float shfl_xor_l(float v, int o, int lane) { return __int_as_float(__builtin_amdgcn_ds_bpermute((lane ^ o) << 2, __float_as_int(v))); }
__device__ __forceinline__ int opaque_tid(int wv) { unsigned m = ~0u; asm volatile("" : "+s"(m), "+s"(wv));
    int t = (wv << 6) | (int)__builtin_amdgcn_mbcnt_hi(m, __builtin_amdgcn_mbcnt_lo(m, 0u)); asm volatile("" : "+v"(t)); return t; }

__device__ __forceinline__ const float* inptr(int i) {
    const float* const __attribute__((address_space(4)))* ka = (const float* const __attribute__((address_space(4)))*)__builtin_amdgcn_kernarg_segment_ptr();
    asm volatile("" : "+s"(i)); return ka[i]; }

#ifndef MULTI
#define MULTI 0
#endif
#ifndef DBG
#define DBG 0
#endif

namespace pg8 {
#define PG8_LAS __attribute__((address_space(3)))
typedef unsigned short bf16_t;
typedef short bf16x8 __attribute__((ext_vector_type(8)));
typedef float f32x4 __attribute__((ext_vector_type(4)));
typedef unsigned u32x4 __attribute__((ext_vector_type(4)));
constexpr int BM = 256, BK = 64, HALF = 128, HTB = HALF * BK * 2  , STAGE_BYTES = 8 * HTB, NXCD = 8, WGM = 4;

__host__ __device__ __forceinline__ int lds_byte(int r, int c) { const int st = (r >> 4) * 2 + (c >> 5), rr = r & 15, cc = c & 31, ob = rr * 64 + cc * 2; return st * 1024 + (ob ^ (((ob >> 9) & 1) << 5)); }
__host__ __device__ __forceinline__ void stage_rc(int b, int& R, int& C) { const int st = b / 1024, sb = b % 1024, swz = sb ^ (((sb >> 9) & 1) << 5); R = (st >> 1) * 16 + swz / 64; C = (st & 1) * 32 + (swz % 64) / 2; }
__host__ __device__ __forceinline__ int perm64(int R) { return 64 * (R >> 5) + 16 * ((R >> 2) & 3) + 4 * ((R >> 4) & 1) + (R & 3); }
__host__ __device__ __forceinline__ int perm32(int rho) { const int n = rho >> 4, i = rho & 15; return 8 * (i >> 2) + 4 * n + (i & 3); }

struct Unit { int pm, pn, kb; };
struct Gemm { const bf16_t* A; const bf16_t* Bt; int M, N, K; size_t a_kb, b_kb; int wv; };

struct StaticOrder {
    int nM, nN, nwg, G, c;
    __host__ __device__ void init(int M, int N, int G_, int c_) { nM = M / BM; nN = N / BM; nwg = nM * nN; G = G_; c = c_; }
    __host__ __device__ bool next(int i, Unit& u) const {
        const long L = (long)i * G + c; if (L >= nwg) return false;
        int wgid = (int)L; { const int q = nwg / NXCD, r = nwg % NXCD, xcd = wgid % NXCD, off = wgid / NXCD; wgid = (xcd < r ? xcd * (q + 1) : r * (q + 1) + (xcd - r) * q) + off; }
        const int nig = WGM * nN, gid = wgid / nig, fm = gid * WGM, gsz = (nM - fm) < WGM ? (nM - fm) : WGM;
        u.pm = fm + ((wgid % nig) % gsz); u.pn = (wgid % nig) / gsz; u.kb = 0; return true;
    }
    __device__ __forceinline__ void a_ready(const Unit&) const {}
    __device__ __forceinline__ void done(const Unit&) const {}
};
struct BankOrder : StaticOrder {
    __host__ __device__ bool next(int i, Unit& u) const { if (!StaticOrder::next(i >> 2, u)) return false; u.kb = i & 3; return true; }
};

typedef float f32x2_t __attribute__((ext_vector_type(2))); typedef __bf16 bf16x2_t __attribute__((ext_vector_type(2)));
__device__ __forceinline__ unsigned cvt_pk_bf16(float lo, float hi) { f32x2_t v = {lo, hi}; bf16x2_t b = __builtin_convertvector(v, bf16x2_t); return __builtin_bit_cast(unsigned, b); }
__device__ __forceinline__ float bf_lo(unsigned u) { return __uint_as_float(u << 16); }
__device__ __forceinline__ float bf_hi(unsigned u) { return __uint_as_float(u & 0xffff0000u); }
__device__ __forceinline__ float sigmoidf_fast(float x) { return __builtin_amdgcn_rcpf(1.0f + __builtin_amdgcn_exp2f(-1.4426950408889634f * x)); }

template <int ACT, bool F8 = false> struct EpiBf16 {
    static constexpr bool PERM = true, AFTER_DRAIN = false, SEG = false, FP8 = F8;
    bf16_t* O; int ldc; const float* bias; int pm_off;
    __device__ __forceinline__ void operator()(const f32x4 (&acc)[2][2][4][2], const Unit& u, int wr, int wc, int fr, int fq) const {
        const int row0 = (u.pm + pm_off) * BM + wr * 64 + fr; const int col0 = u.pn * BM + wc * 32 + 8 * fq;
        f32x4 bv[2][2];
#pragma unroll
        for (int bj = 0; bj < 2; ++bj)
#pragma unroll
            for (int n = 0; n < 2; ++n) bv[bj][n] = (ACT != 0) ? *(const f32x4*)(bias + col0 + bj * HALF + 4 * n) : (f32x4){0.f, 0.f, 0.f, 0.f};
#pragma unroll
        for (int ai = 0; ai < 2; ++ai)
#pragma unroll
            for (int m = 0; m < 4; ++m) { bf16_t* rowp = O + (size_t)(row0 + ai * HALF + m * 16) * ldc + col0;
#pragma unroll
                for (int bj = 0; bj < 2; ++bj) { f32x4 v0 = (F8 ? acc[ai][bj][m][0] * 0.015625f : acc[ai][bj][m][0]) + bv[bj][0], v1 = (F8 ? acc[ai][bj][m][1] * 0.015625f : acc[ai][bj][m][1]) + bv[bj][1];
                    if (ACT == 1) {
#pragma unroll
                        for (int j = 0; j < 4; ++j) { v0[j] = sigmoidf_fast(v0[j]); v1[j] = sigmoidf_fast(v1[j]); } }
                    if (ACT == 2) {
#pragma unroll
                        for (int j = 0; j < 4; ++j) { const float a = fmaxf(v0[j], 0.f), b = fmaxf(v1[j], 0.f); v0[j] = a * a; v1[j] = b * b; } }
                    if (ACT == 3) {
#pragma unroll
                        for (int j = 0; j < 4; ++j) { v0[j] = 1.0f + __builtin_amdgcn_exp2f(-1.4426950408889634f * v0[j]); v1[j] = 1.0f + __builtin_amdgcn_exp2f(-1.4426950408889634f * v1[j]); } }
                    u32x4 w; w.x = cvt_pk_bf16(v0[0], v0[1]); w.y = cvt_pk_bf16(v0[2], v0[3]); w.z = cvt_pk_bf16(v1[0], v1[1]); w.w = cvt_pk_bf16(v1[2], v1[3]);
                    __builtin_nontemporal_store(w, (u32x4*)(rowp + bj * HALF)); } }
    }
};
struct EpiGateU8 {
    static constexpr int PERM = 2; static constexpr bool AFTER_DRAIN = false, SEG = false, FP8 = true;
    unsigned char* O; const float* bias; int pm_off;
    __device__ __forceinline__ void operator()(const f32x4 (&acc)[2][2][4][2], const Unit& u, int wr, int wc, int fr, int fq) const {
        const int row0 = (u.pm + pm_off) * BM + wr * 64 + fr; const int col0 = u.pn * BM + wc * 64 + 16 * fq;
        f32x4 bv[2][2];
#pragma unroll
        for (int bj = 0; bj < 2; ++bj)
#pragma unroll
            for (int n = 0; n < 2; ++n) bv[bj][n] = *(const f32x4*)(bias + col0 + 8 * bj + 4 * n);
#pragma unroll
        for (int ai = 0; ai < 2; ++ai)
#pragma unroll
            for (int m = 0; m < 4; ++m) { u32x4 w;
#pragma unroll
                for (int bj = 0; bj < 2; ++bj)
#pragma unroll
                    for (int n = 0; n < 2; ++n) { const f32x4 v = acc[ai][bj][m][n] * 0.015625f + bv[bj][n]; unsigned q = 0;
#pragma unroll
                        for (int j = 0; j < 4; ++j) {
                            const float t = __builtin_amdgcn_rcpf(0.00390640259f + __builtin_amdgcn_exp2f(-1.4426950408889634f * v[j] - 7.99994364f));
                            q |= (unsigned)(int)t << (8 * j); }
                        w[2 * bj + n] = q; }
                __builtin_nontemporal_store(w, (u32x4*)(O + (size_t)(row0 + ai * HALF + m * 16) * 8192 + col0)); }
    }
};
template <bool SRC_BF, bool DST_BF> struct EpiRes {
    static constexpr bool PERM = true, AFTER_DRAIN = false, SEG = false, FP8 = false;
    const void* b_ctx; const void* b_lat; void* out; const float* gate  ; const float* bias; int pm_off;
    __device__ __forceinline__ void operator()(const f32x4 (&acc)[2][2][4][2], const Unit& u, int wr, int wc, int fr, int fq) const {
        const int pmg = u.pm + pm_off;
        const int row0 = pmg * BM + wr * 64 + fr, col0 = u.pn * BM + wc * 32 + 8 * fq;
        const int cond = pmg < 32 ? 0 : 1 + ((pmg - 32) >> 4);
        const void* base = pmg < 32 ? b_ctx : b_lat; const float* gp = gate + (size_t)cond * (6 * 2048);
        f32x4 bv[2][2], gv[2][2];
#pragma unroll
        for (int bj = 0; bj < 2; ++bj)
#pragma unroll
            for (int n = 0; n < 2; ++n) { bv[bj][n] = bias ? *(const f32x4*)(bias + col0 + bj * HALF + 4 * n) : (f32x4){0.f, 0.f, 0.f, 0.f}; gv[bj][n] = *(const f32x4*)(gp + col0 + bj * HALF + 4 * n); }
        if constexpr (SRC_BF) {
#pragma unroll
            for (int ai = 0; ai < 2; ++ai) {
                u32x4 xr[4][2];
#pragma unroll
                for (int m = 0; m < 4; ++m)
#pragma unroll
                    for (int bj = 0; bj < 2; ++bj) xr[m][bj] = *(const u32x4*)((const bf16_t*)base + (size_t)(row0 + ai * HALF + m * 16) * 2048 + col0 + bj * HALF);
                asm volatile("" ::: "memory");
#pragma unroll
                for (int m = 0; m < 4; ++m) { const size_t off = (size_t)(row0 + ai * HALF + m * 16) * 2048 + col0;
#pragma unroll
                    for (int bj = 0; bj < 2; ++bj) { const u32x4 r = xr[m][bj];
                        const f32x4 x0 = (f32x4){bf_lo(r.x), bf_hi(r.x), bf_lo(r.y), bf_hi(r.y)}, x1 = (f32x4){bf_lo(r.z), bf_hi(r.z), bf_lo(r.w), bf_hi(r.w)};
                        const f32x4 y0 = x0 + gv[bj][0] * (acc[ai][bj][m][0] + bv[bj][0]), y1 = x1 + gv[bj][1] * (acc[ai][bj][m][1] + bv[bj][1]);
                        if (DST_BF) { u32x4 w; w.x = cvt_pk_bf16(y0[0], y0[1]); w.y = cvt_pk_bf16(y0[2], y0[3]); w.z = cvt_pk_bf16(y1[0], y1[1]); w.w = cvt_pk_bf16(y1[2], y1[3]); *(u32x4*)((bf16_t*)out + off + bj * HALF) = w; }
                        else { float* q = (float*)out + off + bj * HALF; *(f32x4*)q = y0; *(f32x4*)(q + 4) = y1; } } }
                asm volatile("" ::: "memory");
            }
        } else {
#pragma unroll
        for (int ai = 0; ai < 2; ++ai)
#pragma unroll
            for (int m = 0; m < 4; ++m) { const size_t off = (size_t)(row0 + ai * HALF + m * 16) * 2048 + col0;
#pragma unroll
                for (int bj = 0; bj < 2; ++bj) { const float* q0 = (const float*)base + off + bj * HALF; const f32x4 x0 = *(const f32x4*)q0, x1 = *(const f32x4*)(q0 + 4);
                    const f32x4 y0 = x0 + gv[bj][0] * (acc[ai][bj][m][0] + bv[bj][0]), y1 = x1 + gv[bj][1] * (acc[ai][bj][m][1] + bv[bj][1]);
                    if (DST_BF) { u32x4 w; w.x = cvt_pk_bf16(y0[0], y0[1]); w.y = cvt_pk_bf16(y0[2], y0[3]); w.z = cvt_pk_bf16(y1[0], y1[1]); w.w = cvt_pk_bf16(y1[2], y1[3]); *(u32x4*)((bf16_t*)out + off + bj * HALF) = w; }
                    else { float* q = (float*)out + off + bj * HALF; *(f32x4*)q = y0; *(f32x4*)(q + 4) = y1; } }
                if (m & 1) asm volatile("" ::: "memory"); }
        }
    }
};
struct EpiMerge {
    static constexpr int PERM = 2; static constexpr bool AFTER_DRAIN = false, SEG = true, FP8 = false;
    const unsigned char* E; bf16_t* O;
    static __device__ __forceinline__ float ub(unsigned w, int j) { return (float)((w >> (8 * j)) & 0xffu); }
    __device__ __forceinline__ void seg(f32x4 (&acc)[2][2][4][2], const Unit& u, int b, int wr, int wc, int fr, int fq) const {
        const unsigned char* ep = E + (size_t)(u.pm * BM + wr * 64 + fr) * 8192 + b * 2048 + u.pn * BM + wc * 64 + 16 * fq;
#pragma unroll
        for (int ai = 0; ai < 2; ++ai) {
            u32x4 e0[4], e1[4];
#pragma unroll
            for (int m = 0; m < 4; ++m) { const unsigned char* q = ep + (size_t)(ai * HALF + m * 16) * 8192; e0[m] = *(const u32x4*)q; e1[m] = *(const u32x4*)(q + 2048); }
#pragma unroll
            for (int m = 0; m < 4; ++m)
#pragma unroll
                for (int bj = 0; bj < 2; ++bj)
#pragma unroll
                    for (int n = 0; n < 2; ++n)
#pragma unroll
                        for (int j = 0; j < 4; ++j) acc[ai][bj][m][n][j] *= (ub(e0[m][2 * bj + n], j) + 0.5f) * __builtin_amdgcn_rcpf(ub(e1[m][2 * bj + n], j) + 0.5f);
            asm volatile("" ::: "memory");
        }
    }
    __device__ __forceinline__ void operator()(const f32x4 (&acc)[2][2][4][2], const Unit& u, int wr, int wc, int fr, int fq) const {
        const int row0 = u.pm * BM + wr * 64 + fr; const int col0 = u.pn * BM + wc * 64 + 16 * fq;
        u32x4 gr[2][4];
#pragma unroll
        for (int ai = 0; ai < 2; ++ai)
#pragma unroll
            for (int m = 0; m < 4; ++m) gr[ai][m] = *(const u32x4*)(E + (size_t)(row0 + ai * HALF + m * 16) * 8192 + 3 * 2048 + col0);
        asm volatile("" ::: "memory");
#pragma unroll
        for (int ai = 0; ai < 2; ++ai)
#pragma unroll
            for (int m = 0; m < 4; ++m) { const size_t row = (size_t)(row0 + ai * HALF + m * 16);
                const u32x4 g = gr[ai][m];
#pragma unroll
                for (int bj = 0; bj < 2; ++bj) { f32x4 v0 = acc[ai][bj][m][0], v1 = acc[ai][bj][m][1];
#pragma unroll
                    for (int j = 0; j < 4; ++j) { v0[j] *= ub(g[2 * bj], j) * 0.00390640259f + 0.001953201295f; v1[j] *= ub(g[2 * bj + 1], j) * 0.00390640259f + 0.001953201295f; }
                    u32x4 w; w.x = cvt_pk_bf16(v0[0], v0[1]); w.y = cvt_pk_bf16(v0[2], v0[3]); w.z = cvt_pk_bf16(v1[0], v1[1]); w.w = cvt_pk_bf16(v1[2], v1[3]);
                    *(u32x4*)(O + row * 2048 + col0 + 8 * bj) = w; } }
    }
};

template <class Epi, class Sched, bool ALIGN_EPI = false, bool SP2 = false>
__device__ __forceinline__ void gemm_phase(PG8_LAS unsigned char* lds, const Gemm g, const Sched& S, const Epi& E) {
    typedef int v4i_t __attribute__((ext_vector_type(4))); typedef int v8i_t __attribute__((ext_vector_type(8)));
    int sc8_ = 0x7F7F7F7F; asm volatile("" : "+v"(sc8_));
    int tid_ = opaque_tid(g.wv);
    const int tid = tid_, wid = __builtin_amdgcn_readfirstlane(tid >> 6), lane = tid & 63, wr = wid >> 2, wc = wid & 3, fr = lane & 15, fq = lane >> 4;
    const int K = g.K, nt = K / BK;
    unsigned voffA[2], voffB[2];
#pragma unroll
    for (int i = 0; i < 2; ++i) { int R, C; stage_rc(tid * 16 + i * 8192, R, C); const int Rb = Epi::PERM == 2 ? perm64(R) : Epi::PERM ? ((R & ~31) + perm32(R & 31)) : R;
        voffA[i] = (unsigned)(R * K + C) * 2u; voffB[i] = (unsigned)(Rb * K + C) * 2u; }
    const size_t kstep = (size_t)(BK * 2);
    const size_t hstep = (size_t)HALF * K * 2;
    const size_t hstepB = Epi::PERM == 2 ? (size_t)(8 * K * 2) : hstep;
    const size_t tstep = 2 * hstep;
    const unsigned ldsw = (unsigned)wid * 1024u; const unsigned ldsbase = (unsigned)__builtin_amdgcn_readfirstlane((int)((unsigned)(unsigned long long)(lds) + (unsigned)wid * 1024u));
    const int aoff = lds_byte(wr * 64 + fr, fq * 8), boff = lds_byte(wc * 32 + fr, fq * 8);
#define PG8_SA(b, h) (((b) * 2 + (h)) * HTB)
#define PG8_SB(b, h) ((4 + (b) * 2 + (h)) * HTB)
#define PG8_STAGE(bufoff, gbase, voff) do { _Pragma("unroll") for (int _i = 0; _i < 2; ++_i) { unsigned keep_; \
        asm volatile("s_mov_b32 %0, m0\n\ts_mov_b32 m0, %3\n\ts_nop 0\n\tglobal_load_lds_dwordx4 %1, %2\n\ts_mov_b32 m0, %0" : "=&s"(keep_) : "v"((voff)[_i]), "s"((const char*)(gbase)), "s"(ldsbase + (unsigned)((bufoff) + _i * 8192)) : "memory"); } } while (0)
#define PG8_LDA(dst, b, h) do { _Pragma("unroll") for (int m = 0; m < 4; ++m) _Pragma("unroll") for (int k = 0; k < 2; ++k) dst[m][k] = *(const PG8_LAS bf16x8*)(lds + PG8_SA(b, h) + aoff + m * 2048 + k * 1024); } while (0)
#define PG8_LDB(dst, b, h) do { _Pragma("unroll") for (int n = 0; n < 2; ++n) _Pragma("unroll") for (int k = 0; k < 2; ++k) dst[n][k] = *(const PG8_LAS bf16x8*)(lds + PG8_SB(b, h) + boff + n * 2048 + k * 1024); } while (0)
#define PG8_CAT8(x0, x1) __builtin_shufflevector(__builtin_bit_cast(v4i_t, x0), __builtin_bit_cast(v4i_t, x1), 0, 1, 2, 3, 4, 5, 6, 7)
#define PG8_MMA(ai, bj, At, Bt) do { __builtin_amdgcn_s_setprio(1); \
        if constexpr (Epi::FP8) { _Pragma("unroll") for (int m = 0; m < 4; ++m) _Pragma("unroll") for (int n = 0; n < 2; ++n) { \
            const v8i_t b8_ = PG8_CAT8(Bt[n][0], Bt[n][1]), a8_ = PG8_CAT8(At[m][0], At[m][1]); \
              \
            asm volatile("v_mfma_scale_f32_16x16x128_f8f6f4 %0, %1, %2, %0, %3, %3 op_sel_hi:[0,0,0]" : "+v"(acc[ai][bj][m][n]) : "v"(b8_), "v"(a8_), "v"(sc8_)); } } \
        else { _Pragma("unroll") for (int m = 0; m < 4; ++m) _Pragma("unroll") for (int n = 0; n < 2; ++n) _Pragma("unroll") for (int k = 0; k < 2; ++k) \
            acc[ai][bj][m][n] = __builtin_amdgcn_mfma_f32_16x16x32_bf16(Bt[n][k], At[m][k], acc[ai][bj][m][n], 0, 0, 0); } \
        __builtin_amdgcn_s_setprio(0); } while (0)
#define PG8_WAIT_V(n) asm volatile("s_waitcnt vmcnt(" #n ")" ::: "memory")
#define PG8_WAIT_L(n) asm volatile("s_waitcnt lgkmcnt(" #n ")" ::: "memory")
#define PG8_BAR __builtin_amdgcn_s_barrier()
#define PG8_SCHED __builtin_amdgcn_sched_barrier(0)
    float zacc_ = 0.f; asm volatile("" : "+v"(zacc_));
    Unit cur, nxt; int ui = 0;
    if (!S.next(0, cur)) return;
    f32x4 acc[2][2][4][2];
#pragma unroll
    for (int a = 0; a < 2; ++a)
#pragma unroll
        for (int b = 0; b < 2; ++b)
#pragma unroll
            for (int m = 0; m < 4; ++m)
#pragma unroll
                for (int n = 0; n < 2; ++n) acc[a][b][m][n] = (f32x4){zacc_, zacc_, zacc_, zacc_};
    bf16x8 At[4][2], B0[2][2], B1[2][2];
    const char* cA = (const char*)g.A + (size_t)cur.kb * g.a_kb + (size_t)cur.pm * tstep; const char* cB = (const char*)g.Bt + (size_t)cur.kb * g.b_kb + (size_t)cur.pn * tstep;
    S.a_ready(cur);
    if constexpr (SP2) {
        PG8_STAGE(PG8_SB(0, 0), cB, voffB); PG8_STAGE(PG8_SB(0, 1), cB + hstepB, voffB); PG8_STAGE(PG8_SA(0, 0), cA, voffA); PG8_STAGE(PG8_SA(0, 1), cA + hstep, voffA);
        if (wr == 1) PG8_BAR;
        PG8_WAIT_V(2); PG8_BAR;
        PG8_STAGE(PG8_SB(1, 0), cB + kstep, voffB); PG8_STAGE(PG8_SA(1, 0), cA + kstep, voffA); PG8_STAGE(PG8_SB(1, 1), cB + hstepB + kstep, voffB);
        PG8_WAIT_V(6); PG8_BAR;
    } else {
        PG8_STAGE(PG8_SB(0, 0), cB, voffB); PG8_STAGE(PG8_SA(0, 0), cA, voffA); PG8_STAGE(PG8_SB(0, 1), cB + hstepB, voffB); PG8_STAGE(PG8_SA(0, 1), cA + hstep, voffA);
        if (wr == 1) PG8_BAR;
        PG8_WAIT_V(4); PG8_BAR;
        PG8_STAGE(PG8_SB(1, 0), cB + kstep, voffB); PG8_STAGE(PG8_SA(1, 0), cA + kstep, voffA); PG8_STAGE(PG8_SB(1, 1), cB + hstepB + kstep, voffB);
        PG8_WAIT_V(6); PG8_BAR;
    }
    for (;;) {
        const bool has_next = S.next(ui + 1, nxt);
        const char* nA = has_next ? (const char*)g.A + (size_t)nxt.kb * g.a_kb + (size_t)nxt.pm * tstep : cA; const char* nB = has_next ? (const char*)g.Bt + (size_t)nxt.kb * g.b_kb + (size_t)nxt.pn * tstep : cB;
        for (int t = 0; t < nt; t += 2) {
            const bool last = (t == nt - 2);
            const char* a1 = cA + (size_t)(t + 1) * kstep;
            const char* a2 = last ? nA : cA + (size_t)(t + 2) * kstep; const char* b2 = last ? nB : cB + (size_t)(t + 2) * kstep;
            const char* a3 = a2 + kstep; const char* b3 = b2 + kstep;
            if (last && has_next) S.a_ready(nxt);
            if constexpr (SP2) {
            PG8_LDB(B0, 0, 0); PG8_LDB(B1, 0, 1); PG8_SCHED; PG8_LDA(At, 0, 0); PG8_STAGE(PG8_SA(1, 1), a1 + hstep, voffA);
            PG8_WAIT_V(8); PG8_WAIT_L(0); PG8_BAR; PG8_MMA(0, 0, At, B0); PG8_MMA(0, 1, At, B1); PG8_BAR; PG8_SCHED;
            PG8_LDA(At, 0, 1); PG8_STAGE(PG8_SB(0, 0), b2, voffB); PG8_STAGE(PG8_SB(0, 1), b2 + hstepB, voffB); PG8_STAGE(PG8_SA(0, 0), a2, voffA);
            PG8_WAIT_V(8); PG8_WAIT_L(0); PG8_BAR; PG8_MMA(1, 0, At, B0); PG8_MMA(1, 1, At, B1); PG8_BAR; PG8_SCHED;
            PG8_LDB(B0, 1, 0); PG8_LDB(B1, 1, 1); PG8_SCHED; PG8_LDA(At, 1, 0); PG8_STAGE(PG8_SA(0, 1), a2 + hstep, voffA);
            PG8_WAIT_V(8); PG8_WAIT_L(0); PG8_BAR; PG8_MMA(0, 0, At, B0); PG8_MMA(0, 1, At, B1); PG8_BAR; PG8_SCHED;
            PG8_LDA(At, 1, 1); PG8_STAGE(PG8_SB(1, 0), b3, voffB); PG8_STAGE(PG8_SB(1, 1), b3 + hstepB, voffB); PG8_STAGE(PG8_SA(1, 0), a3, voffA);
            PG8_WAIT_V(8); PG8_WAIT_L(0); PG8_BAR; PG8_MMA(1, 0, At, B0); PG8_MMA(1, 1, At, B1); PG8_BAR; PG8_SCHED;
            if constexpr (Epi::SEG) { if (((t + 2) & 7) == 0 && !last) { E.seg(acc, cur, ((t + 2) >> 3) - 1, wr, wc, fr, fq); PG8_SCHED; } }
            } else {
            PG8_LDB(B0, 0, 0); PG8_SCHED; PG8_LDA(At, 0, 0); PG8_STAGE(PG8_SA(1, 1), a1 + hstep, voffA);
            PG8_WAIT_L(8); PG8_BAR; PG8_WAIT_L(0); PG8_MMA(0, 0, At, B0); PG8_BAR; PG8_SCHED;
            PG8_LDB(B1, 0, 1); PG8_STAGE(PG8_SB(0, 0), b2, voffB);
            PG8_BAR; PG8_WAIT_L(0); PG8_MMA(0, 1, At, B1); PG8_BAR;
            PG8_LDA(At, 0, 1); PG8_STAGE(PG8_SA(0, 0), a2, voffA);
            PG8_BAR; PG8_WAIT_L(0); PG8_MMA(1, 0, At, B0); PG8_BAR; PG8_SCHED;
            PG8_STAGE(PG8_SB(0, 1), b2 + hstepB, voffB);
            PG8_WAIT_V(6); PG8_BAR; PG8_MMA(1, 1, At, B1); PG8_BAR;
            PG8_LDB(B0, 1, 0); PG8_SCHED; PG8_LDA(At, 1, 0); PG8_STAGE(PG8_SA(0, 1), a2 + hstep, voffA);
            PG8_WAIT_L(8); PG8_BAR; PG8_WAIT_L(0); PG8_MMA(0, 0, At, B0); PG8_BAR; PG8_SCHED;
            PG8_LDB(B1, 1, 1); PG8_STAGE(PG8_SB(1, 0), b3, voffB);
            PG8_BAR; PG8_WAIT_L(0); PG8_MMA(0, 1, At, B1); PG8_BAR;
            PG8_LDA(At, 1, 1); PG8_STAGE(PG8_SA(1, 0), a3, voffA);
            PG8_BAR; PG8_WAIT_L(0); PG8_MMA(1, 0, At, B0); PG8_BAR; PG8_SCHED;
            PG8_STAGE(PG8_SB(1, 1), b3 + hstepB, voffB);
            PG8_WAIT_V(6); PG8_BAR; PG8_MMA(1, 1, At, B1); PG8_BAR;
            }
        }
        if constexpr (ALIGN_EPI) { if (wr == 0) PG8_BAR; }
        if constexpr (Epi::FP8) asm volatile("s_nop 15\n\ts_nop 7" ::: "memory");
        if constexpr (!Epi::AFTER_DRAIN) { E(acc, cur, wr, wc, fr, fq); S.done(cur); }
        if (!has_next) break;
#pragma unroll
        for (int a = 0; a < 2; ++a)
#pragma unroll
            for (int b = 0; b < 2; ++b)
#pragma unroll
                for (int m = 0; m < 4; ++m)
#pragma unroll
                    for (int n = 0; n < 2; ++n) acc[a][b][m][n] = (f32x4){zacc_, zacc_, zacc_, zacc_};
        cur = nxt; cA = nA; cB = nB; ++ui;
        if constexpr (ALIGN_EPI) { if (wr == 1) PG8_BAR; }
    }
    PG8_WAIT_V(0);
    if constexpr (!ALIGN_EPI) { if (wr == 0) PG8_BAR; }
    PG8_BAR;
    if constexpr (Epi::AFTER_DRAIN) { E.fused(acc, cur, wr, wc, fr, fq, lds, wid, lane); S.done(cur); }
#undef PG8_SA
#undef PG8_SB
#undef PG8_STAGE
#undef PG8_LDA
#undef PG8_LDB
#undef PG8_MMA
#undef PG8_CAT8
#undef PG8_WAIT_V
#undef PG8_WAIT_L
#undef PG8_BAR
#undef PG8_SCHED
}
}

constexpr int DMODEL = 2048, DEPTH = 4, NSEQ_C = 32, T_C = 256, NSEQ_L = 4, T_L = 4096, PAST = 512;
constexpr int M_C = NSEQ_C * T_C, M_L = NSEQ_L * T_L, MROWS = M_C + M_L;
constexpr int DIN = 4096, DFF = 8192, BRW = 512, BRP = 2048;
constexpr int ZC_XA = 0, ZC_YA = 512, ZC_QW = 1024, ZC_KW = 1536, ZC_VW = 1664, ZC_QG = 1792, ZC_KG = 2304, ZC_VG = 2432, ZC_QD = 2560, ZC_KD = 3072, ZC_VD = 3584;
enum { I_XP = 0, I_XS, I_CWK, I_CWV, I_CGK, I_CGV, I_CDK, I_CDV, I_SLRU, I_C, I_CCTX, I_WADA, I_BADA, I_N1G, I_N2G, I_WIN, I_CONVW, I_CONVB, I_LWR, I_LBR, I_LWI, I_LBI, I_LLAM,
       I_WQN, I_WKN, I_WSINK, I_GQN, I_GKN, I_DQN, I_DKN, I_LQ1, I_LK1, I_LQ2, I_LK2, I_DOG, I_WBR, I_WGATE, I_BGATE, I_WO, I_WFF1, I_BFF1, I_WFF2, I_BFF2, N_IN };
static_assert(N_IN == 43, "input count");
constexpr size_t O_YP = 0, O_YS = 16777216, O_WK = 50331648, O_WV = 54525952, O_GK = 58720256, O_GV = 62914560, O_DK = 67108864, O_DV = 83886080, O_LS = 100663296, O_END = 100794368;
constexpr float RMS_EPS = 1e-6f;
constexpr float QSCALE = 0.125f * 1.4426950408889634f;

constexpr size_t MiB = 1u << 20;
constexpr size_t WS_CTL = 0;
constexpr size_t WS_MOD = 1 * MiB;
constexpr size_t ZERO_BYTES = 64 * 1024;
constexpr size_t WS_TAB = 2 * MiB;
constexpr int TAB_COS = 0, TAB_SIN = 1024, TAB_SPL = 2048, TAB_LAMD = 2048 + 4096, TAB_LAMI = TAB_LAMD + 4;
constexpr size_t WS_LRUW = 3 * MiB;
constexpr size_t WS_SUM = 4 * MiB;
constexpr size_t WS_CK = 5 * MiB;
constexpr size_t CK_WK = WS_CK, CK_WVT = CK_WK + 2 * MiB, CK_GK = CK_WVT + 2 * MiB, CK_GVT = CK_GK + 2 * MiB, CK_DK = CK_GVT + 2 * MiB, CK_DVT = CK_DK + 8 * MiB;
constexpr size_t WS_VT = 29 * MiB;
constexpr size_t VT_BL = WS_VT, VT_CL = VT_BL + 4 * MiB, VT_DL = VT_CL + 4 * MiB, VT_BC = VT_DL + 16 * MiB, VT_CC = VT_BC + 2 * MiB, VT_DC = VT_CC + 2 * MiB;
constexpr size_t WS_W = 65 * MiB;
constexpr size_t WL_ELEMS = 67108864;
constexpr size_t W_IN_T = 0, W_GATE_T = 8388608, W_BR_T = 25165824, W_O_T = 29360128, W_FF1_T = 33554432, W_FF2_T = 50331648;
constexpr size_t WS_H = 577 * MiB;
constexpr size_t WS_Z = 673 * MiB;
constexpr size_t WS_G = 865 * MiB;
constexpr size_t WS_BR = 1249 * MiB;
constexpr size_t WS_OD = 1345 * MiB;
constexpr size_t WS_W8 = 1393 * MiB;
constexpr size_t WS_H8 = 1457 * MiB;
constexpr size_t WS_LAB = WS_G + 192 * MiB;
constexpr size_t WS_XB = 1505 * MiB;
constexpr size_t WS_END = 1601 * MiB;
constexpr size_t WS_DBG = WS_END;

constexpr int RING_BYTES = 131072, LDSCTL_OFF = RING_BYTES, LDS_BYTES = 147456;

#define GAS __attribute__((address_space(1)))
#define LAS __attribute__((address_space(3)))
typedef unsigned short bf16;
typedef unsigned v4u __attribute__((ext_vector_type(4)));
typedef unsigned v2u __attribute__((ext_vector_type(2)));
typedef float f32x4 __attribute__((ext_vector_type(4)));
typedef float f32x16 __attribute__((ext_vector_type(16)));
typedef short bf16x8 __attribute__((ext_vector_type(8)));
__device__ __forceinline__ unsigned f2bf(float f) { unsigned u = __builtin_bit_cast(unsigned, f); return (u + 0x7fffu + ((u >> 16) & 1u)) >> 16; }
__device__ __forceinline__ unsigned pk2(float lo, float hi) { return f2bf(lo) | (f2bf(hi) << 16); }
__device__ __forceinline__ float bflo(unsigned u) { return __uint_as_float(u << 16); }
__device__ __forceinline__ float bfhi(unsigned u) { return __uint_as_float(u & 0xffff0000u); }
__device__ __forceinline__ float bf2f(bf16 b) { return __uint_as_float(((unsigned)b) << 16); }
__device__ __forceinline__ void unpack8(const v4u r, float (&x)[8]) { x[0] = bflo(r.x); x[1] = bfhi(r.x); x[2] = bflo(r.y); x[3] = bfhi(r.y); x[4] = bflo(r.z); x[5] = bfhi(r.z); x[6] = bflo(r.w); x[7] = bfhi(r.w); }
__device__ __forceinline__ v4u pack8(const float (&x)[8]) { v4u r; r.x = pk2(x[0], x[1]); r.y = pk2(x[2], x[3]); r.z = pk2(x[4], x[5]); r.w = pk2(x[6], x[7]); return r; }
__device__ __forceinline__ int crow(int r, int hi) { return (r & 3) + 8 * (r >> 2) + 4 * hi; }

#define XB_TMO      128
#define XB_XCNT(j)  (256  + 64 * (j))
#define XB_XSUB(j)  (1280 + 64 * (j))
#define XB_XGEN(j)  (2304 + 64 * (j))
#define XB_TOP      3328
#define XB_TOPGEN   3392
#define XCD_BAR_WORDS 3456
#define XB_SPIN_CAP (1u << 18)

__device__ __forceinline__ unsigned xb_ld(unsigned* p)              { return __hip_atomic_load(p, __ATOMIC_RELAXED, __HIP_MEMORY_SCOPE_AGENT); }
__device__ __forceinline__ unsigned xb_add(unsigned* p, unsigned v) { return __hip_atomic_fetch_add(p, v, __ATOMIC_RELAXED, __HIP_MEMORY_SCOPE_AGENT); }
__device__ __forceinline__ unsigned xb_xcc_id() { return (unsigned)__builtin_amdgcn_s_getreg((3 << 11) | 20) & 0xFu; }
#define XB_SPIN(cond, bar) do { unsigned _sp = 0; while (cond) { __builtin_amdgcn_s_sleep(1); \
    if ((++_sp & 255u) == 0u) { if (xb_ld(&(bar)[XB_TMO])) break; if (_sp > XB_SPIN_CAP) { atomicAdd(&(bar)[XB_TMO], 1u); break; } } } } while (0)

struct XcdBarrier {
    unsigned* bar; unsigned x; int wv;
    volatile LAS unsigned* st;
};
__device__ __forceinline__ XcdBarrier xcd_barrier_post(unsigned* bar, volatile LAS unsigned* st, int wv) {
    XcdBarrier b; b.bar = bar; b.x = xb_xcc_id(); b.st = st; b.wv = wv;
    if (opaque_tid(wv) == 0) (void)xb_add(&bar[XB_XCNT(b.x)], 1u);
    return b;
}
__device__ __forceinline__ void xcd_barrier_complete(unsigned* bar, unsigned x, unsigned& nloc, unsigned& nx) {
    const unsigned G = gridDim.x * gridDim.y * gridDim.z;
    unsigned sum, cnt, mine, sp = 0u;
    for (;;) {
        sum = 0u; cnt = 0u; mine = 0u;
#pragma unroll
        for (unsigned j = 0; j < 16; ++j) { const unsigned c = xb_ld(&bar[XB_XCNT(j)]); sum += c; cnt += (c > 0u) ? 1u : 0u; mine = (j == x) ? c : mine; }
        if (sum == G) break;
        __builtin_amdgcn_s_sleep(1);
        if ((++sp & 255u) == 0u) { if (xb_ld(&bar[XB_TMO])) break; if (sp > XB_SPIN_CAP) { atomicAdd(&bar[XB_TMO], 1u); break; } }
    }
    nloc = mine > 0u ? mine : 1u; nx = cnt > 0u ? cnt : 1u;
}
__device__ __forceinline__ void xcd_barrier(const XcdBarrier& b) {
    asm volatile("s_waitcnt vmcnt(0)" ::: "memory");
    __syncthreads();
    if (opaque_tid(b.wv) == 0) {
        unsigned* bar = b.bar;
        __builtin_amdgcn_s_waitcnt(0);
        unsigned nloc = b.st[0], nx = b.st[1];
        if (nloc == 0u) { xcd_barrier_complete(bar, b.x, nloc, nx); b.st[0] = nloc; b.st[1] = nx; }
        const unsigned old = xb_add(&bar[XB_XSUB(b.x)], 1u);
        const unsigned gen = old / nloc;
        if (old + 1u == (gen + 1u) * nloc) {
            __builtin_amdgcn_fence(__ATOMIC_RELEASE, "agent");
            asm volatile("s_waitcnt vmcnt(0)" ::: "memory");
            const unsigned og = xb_add(&bar[XB_TOP], 1u);
            const unsigned tg = og / nx;
            if (og + 1u == (tg + 1u) * nx) xb_add(&bar[XB_TOPGEN], 1u);
            else XB_SPIN(xb_ld(&bar[XB_TOPGEN]) == tg, bar);
            __builtin_amdgcn_fence(__ATOMIC_ACQUIRE, "agent");
            xb_add(&bar[XB_XGEN(b.x)], 1u);
            asm volatile("s_waitcnt vmcnt(0)" ::: "memory");
        } else {
            XB_SPIN(xb_ld(&bar[XB_XGEN(b.x)]) == gen, bar);
            __builtin_amdgcn_fence(__ATOMIC_ACQUIRE, "agent");
            asm volatile("s_waitcnt vmcnt(0)" ::: "memory");
        }
    }
    __syncthreads();
}

struct Params { const float* in[N_IN]; float* out; unsigned char* ws; int ph_lo, ph_hi; };
static_assert(sizeof(Params) == (N_IN + 2) * 8 + 8, "Params has no padding");

__device__ __forceinline__ unsigned char* wsbase(const Params& p) { unsigned long long w = (unsigned long long)p.ws; asm volatile("" : "+s"(w)); return (unsigned char*)w; }
__device__ __forceinline__ bf16* wsb(const Params& p, size_t off) { return (bf16*)(wsbase(p) + off); }
__device__ __forceinline__ float* wsf(const Params& p, size_t off) { return (float*)(wsbase(p) + off); }
__device__ __forceinline__ const float* xbase_ctx(const Params& p, int l) { return l == 0 ? inptr(I_XP) : p.out; }
__device__ __forceinline__ const float* xbase_lat(const Params& p, int l) { return l == 0 ? inptr(I_XS) - (size_t)M_C * DMODEL : p.out; }
__device__ __forceinline__ float wave_sum(float v, int lane) {
#pragma unroll
    for (int o = 1; o < 64; o <<= 1) v += shfl_xor_l(v, o, lane);
    return v;
}

__device__ __forceinline__ void transpose_item(const float* W, int K, int N, bf16* WT, LAS float* scr, int item, int lane, bool vswap = false) {
    const int nblk = N / 32, kb = item / nblk, nb = item % nblk, k0 = 64 * kb, n0 = 32 * nb;
#pragma unroll 8
    for (int i = 0; i < 32; ++i) { const int kk = 2 * i + (lane >> 5); scr[kk * 33 + (lane & 31)] = W[(size_t)(k0 + kk) * N + n0 + (lane & 31)]; }
    asm volatile("s_waitcnt lgkmcnt(0)" ::: "memory");
    const int c = lane & 7;
#pragma unroll
    for (int j = 0; j < 4; ++j) { const int n = (lane >> 3) + 8 * j; const LAS float* s = scr + (8 * c) * 33 + n;
        v4u o; o.x = pk2(s[0 * 33], s[1 * 33]); o.y = pk2(s[2 * 33], s[3 * 33]); o.z = pk2(s[4 * 33], s[5 * 33]); o.w = pk2(s[6 * 33], s[7 * 33]);
        if (vswap) { const LAS float* s2 = scr + (16 * (c >> 1) + 4 * (c & 1)) * 33 + n;
            o.x = pk2(s2[0 * 33], s2[1 * 33]); o.y = pk2(s2[2 * 33], s2[3 * 33]); o.z = pk2(s2[8 * 33], s2[9 * 33]); o.w = pk2(s2[10 * 33], s2[11 * 33]); }
        *(v4u*)(WT + (size_t)(n0 + n) * K + k0 + 8 * c) = o; }
    asm volatile("s_waitcnt lgkmcnt(0)" ::: "memory");
}
__device__ __forceinline__ void transpose_item8(const float* W, int K, int N, unsigned char* WT, LAS float* scr, int item, int lane) {
    const int nblk = N / 32, kb = item / nblk, nb = item % nblk, k0 = 64 * kb, n0 = 32 * nb;
#pragma unroll 8
    for (int i = 0; i < 32; ++i) { const int kk = 2 * i + (lane >> 5); scr[kk * 33 + (lane & 31)] = W[(size_t)(k0 + kk) * N + n0 + (lane & 31)]; }
    asm volatile("s_waitcnt lgkmcnt(0)" ::: "memory");
    const int c = lane & 7;
#pragma unroll
    for (int j = 0; j < 4; ++j) { const int n = (lane >> 3) + 8 * j; const LAS float* s = scr + (8 * c) * 33 + n;
        int lo = 0, hi = 0;
        lo = __builtin_amdgcn_cvt_pk_fp8_f32(s[0 * 33] * 64.f, s[1 * 33] * 64.f, lo, false); lo = __builtin_amdgcn_cvt_pk_fp8_f32(s[2 * 33] * 64.f, s[3 * 33] * 64.f, lo, true);
        hi = __builtin_amdgcn_cvt_pk_fp8_f32(s[4 * 33] * 64.f, s[5 * 33] * 64.f, hi, false); hi = __builtin_amdgcn_cvt_pk_fp8_f32(s[6 * 33] * 64.f, s[7 * 33] * 64.f, hi, true);
        *(v2u*)(WT + (size_t)(n0 + n) * K + k0 + 8 * c) = (v2u){(unsigned)lo, (unsigned)hi}; }
    asm volatile("s_waitcnt lgkmcnt(0)" ::: "memory");
}
constexpr int N_TR_W = 131072, N_TR_ALL = N_TR_W + 512 + 512 + 2048 + 256;
__device__ __forceinline__ void prologue_phase(const Params& p, LAS unsigned char* lds) {
    const int tid = opaque_tid(p.ph_hi), lane = tid & 63, wave = __builtin_amdgcn_readfirstlane(tid >> 6);
    const int G = gridDim.x, gw = blockIdx.x * 8 + wave, NGW = G * 8;
    LAS float* scr = (LAS float*)(lds + wave * 16384);
    for (int it = gw; it < N_TR_ALL; it += NGW) {
        if (it < N_TR_W) {
            const int l = it >> 15; int r = it & 32767; bf16* WL = wsb(p, WS_W) + (size_t)l * WL_ELEMS;
            if (r < 4096) { transpose_item(inptr(I_WIN) + (size_t)l * 2048 * 4096, 2048, 4096, WL + W_IN_T, scr, r, lane); continue; } r -= 4096;
            if (r < 8192) { transpose_item8(inptr(I_WGATE) + (size_t)l * 2048 * 8192, 2048, 8192, p.ws + WS_W8 + (size_t)l * 8192 * 2048, scr, r, lane); continue; } r -= 8192;
            if (r < 2048) { transpose_item(inptr(I_WBR) + (size_t)l * 2048 * 2048, 2048, 2048, WL + W_BR_T, scr, r, lane); continue; } r -= 2048;
            if (r < 2048) { transpose_item(inptr(I_WO) + (size_t)l * 2048 * 2048, 2048, 2048, WL + W_O_T, scr, r, lane); continue; } r -= 2048;
            if (r < 8192) { transpose_item(inptr(I_WFF1) + (size_t)l * 2048 * 8192, 2048, 8192, WL + W_FF1_T, scr, r, lane); continue; } r -= 8192;
            transpose_item(inptr(I_WFF2) + (size_t)l * 8192 * 2048, 8192, 2048, WL + W_FF2_T, scr, r, lane);
        } else {
            int r = it - N_TR_W;
            if (r < 512) { const int bl = r >> 5; transpose_item(inptr(I_CWV) + (size_t)bl * 512 * 128, 512, 128, wsb(p, CK_WVT) + (size_t)bl * 128 * 512, scr, r & 31, lane, true); continue; } r -= 512;
            if (r < 512) { const int bl = r >> 5; transpose_item(inptr(I_CGV) + (size_t)bl * 512 * 128, 512, 128, wsb(p, CK_GVT) + (size_t)bl * 128 * 512, scr, r & 31, lane, true); continue; } r -= 512;
            if (r < 2048) { const int bl = r >> 7; transpose_item(inptr(I_CDV) + (size_t)bl * 512 * 512, 512, 512, wsb(p, CK_DVT) + (size_t)bl * 512 * 512, scr, r & 127, lane, true); continue; } r -= 2048;
            { const int mtx = r >> 1, g = mtx >> 6, lkn = mtx & 63;
              transpose_item(inptr(g ? I_LWI : I_LWR) + (size_t)lkn * 4096, 64, 64, wsb(p, WS_LRUW) + (size_t)(g * 64 + lkn) * 4096, scr, r & 1, lane); }
        }
    }
    {
        const size_t gt = (size_t)blockIdx.x * 512 + tid, NT = (size_t)G * 512;
        for (size_t i = gt; i < 1048576 / 8; i += NT) {
            float x[8]; const f32x4 a = *(const f32x4*)(inptr(I_CWK) + i * 8), b = *(const f32x4*)(inptr(I_CWK) + i * 8 + 4);
            x[0] = a[0]; x[1] = a[1]; x[2] = a[2]; x[3] = a[3]; x[4] = b[0]; x[5] = b[1]; x[6] = b[2]; x[7] = b[3]; *(v4u*)(wsb(p, CK_WK) + i * 8) = pack8(x);
            const f32x4 c = *(const f32x4*)(inptr(I_CGK) + i * 8), d = *(const f32x4*)(inptr(I_CGK) + i * 8 + 4);
            x[0] = c[0]; x[1] = c[1]; x[2] = c[2]; x[3] = c[3]; x[4] = d[0]; x[5] = d[1]; x[6] = d[2]; x[7] = d[3]; *(v4u*)(wsb(p, CK_GK) + i * 8) = pack8(x); }
        for (size_t i = gt; i < 4194304 / 8; i += NT) {
            float x[8]; const f32x4 a = *(const f32x4*)(inptr(I_CDK) + i * 8), b = *(const f32x4*)(inptr(I_CDK) + i * 8 + 4);
            x[0] = a[0]; x[1] = a[1]; x[2] = a[2]; x[3] = a[3]; x[4] = b[0]; x[5] = b[1]; x[6] = b[2]; x[7] = b[3]; *(v4u*)(wsb(p, CK_DK) + i * 8) = pack8(x); }
    }
    if (blockIdx.x == 0) {
        float* tab = wsf(p, WS_TAB);
        if (tid < 16) {
            const double inv = tid == 0 ? 1.0 : tid == 1 ? 0.5623413251903491 : tid == 2 ? 0.31622776601683794 : tid == 3 ? 0.1778279410038923 : tid == 4 ? 0.1 : tid == 5 ? 0.05623413251903491 : tid == 6 ? 0.03162277660168379 :
                tid == 7 ? 0.01778279410038923 : tid == 8 ? 0.01 : tid == 9 ? 0.005623413251903491 : tid == 10 ? 0.0031622776601683794 : tid == 11 ? 0.0017782794100389228 : tid == 12 ? 0.001 : tid == 13 ? 0.0005623413251903491 :
                tid == 14 ? 0.00031622776601683794 : 0.00017782794100389227;
            double c1 = 1.0, s1 = inv, tc = 1.0, tsn = inv; const double x2 = inv * inv;
            for (int k = 1; k <= 14; ++k) { tc = -tc * x2 / (double)((2 * k - 1) * (2 * k)); tsn = -tsn * x2 / (double)((2 * k) * (2 * k + 1)); c1 += tc; s1 += tsn; }
            double c = 1.0, s = 0.0;
            for (int pos = 0; pos < 64; ++pos) { tab[TAB_COS + pos * 16 + tid] = (float)c; tab[TAB_SIN + pos * 16 + tid] = (float)s; const double cn = c * c1 - s * s1, sn = s * c1 + c * s1; c = cn; s = sn; }
        }
        for (int i = tid; i < 4096; i += 512) { const float lam = inptr(I_LLAM)[i]; tab[TAB_SPL + i] = lam > 15.f ? __expf(-lam) : log1pf(__expf(-lam)); }
        if (tid < 4) { float s1 = 0.f, s2 = 0.f; for (int d = 0; d < 64; ++d) { s1 += inptr(I_LQ1)[tid * 64 + d] * inptr(I_LK1)[tid * 64 + d]; s2 += inptr(I_LQ2)[tid * 64 + d] * inptr(I_LK2)[tid * 64 + d]; }
            const float li = 0.8f - 0.6f * expf(-0.3f * (float)tid); tab[TAB_LAMD + tid] = expf(s1) - expf(s2) + li; tab[TAB_LAMI + tid] = li; }
    }
    {
        LAS float* sv = (LAS float*)lds;
        LAS float* red = (LAS float*)(lds + 5 * 2048 * 4);
        float* mod = wsf(p, WS_MOD);
        __syncthreads();
        for (int i = tid; i < 5 * 2048; i += 512) { const int cond = i >> 11, k = i & 2047; const float c = cond == 0 ? inptr(I_CCTX)[k] : inptr(I_C)[(cond - 1) * 2048 + k]; sv[i] = c / (1.0f + __expf(-c)); }
        __syncthreads();
        const int q = tid >> 7, jl = tid & 127;
        for (int it = blockIdx.x; it < 4 * 96; it += G) {
            const int l = it / 96, j = (it % 96) * 128 + jl;
            float a0 = 0.f, a1 = 0.f, a2 = 0.f, a3 = 0.f, a4 = 0.f;
            const float* w = inptr(I_WADA) + ((size_t)l * 2048 + q * 512) * 12288 + j; const LAS float* s0 = sv + q * 512;
#pragma unroll 8
            for (int kk = 0; kk < 512; ++kk) { const float wv = w[(size_t)kk * 12288]; a0 += s0[kk] * wv; a1 += s0[2048 + kk] * wv; a2 += s0[4096 + kk] * wv; a3 += s0[6144 + kk] * wv; a4 += s0[8192 + kk] * wv; }
            red[(q * 5 + 0) * 128 + jl] = a0; red[(q * 5 + 1) * 128 + jl] = a1; red[(q * 5 + 2) * 128 + jl] = a2; red[(q * 5 + 3) * 128 + jl] = a3; red[(q * 5 + 4) * 128 + jl] = a4;
            __syncthreads();
            for (int i = tid; i < 5 * 128; i += 512) { const int cond = i >> 7, jj = i & 127; const int col = (it % 96) * 128 + jj;
                const float v = ((red[(0 * 5 + cond) * 128 + jj] + red[(1 * 5 + cond) * 128 + jj]) + (red[(2 * 5 + cond) * 128 + jj] + red[(3 * 5 + cond) * 128 + jj])) + inptr(I_BADA)[l * 12288 + col];
                mod[((size_t)l * 5 + cond) * 12288 + col] = v; }
            __syncthreads();
        }
    }
}

template <bool XBF  >
__device__ __forceinline__ void norm_phase(const Params& p, int l, int which  ) {
    const int tid = opaque_tid(p.ph_hi), lane = tid & 63, wave = __builtin_amdgcn_readfirstlane(tid >> 6);
    const int gw = blockIdx.x * 8 + wave, NGW = gridDim.x * 8;
    const float* g = inptr(which ? I_N2G : I_N1G) + l * 2048;
    const float* modl = wsf(p, WS_MOD) + (size_t)l * 5 * 12288;
    bf16* H = wsb(p, WS_H);
    for (int r = gw; r < MROWS; r += NGW) {
        const int cond = r < M_C ? 0 : 1 + ((r - M_C) >> 12);
        const float* sh = modl + (size_t)cond * 12288 + (which ? 3 : 0) * 2048, * sc = sh + 2048;
        float v[4][8]; float ss = 0.f;
#pragma unroll
        for (int j = 0; j < 4; ++j) { const int c = 8 * lane + 512 * j;
            if (XBF) { const v4u raw = *(const v4u*)(wsb(p, WS_XB) + (size_t)r * 2048 + c); unpack8(raw, v[j]); }
            else { const float* x = (r < M_C ? inptr(I_XP) : inptr(I_XS) - (size_t)M_C * DMODEL) + (size_t)r * 2048 + c; const f32x4 a = *(const f32x4*)x, b = *(const f32x4*)(x + 4);
#pragma unroll
                for (int k = 0; k < 4; ++k) { v[j][k] = a[k]; v[j][4 + k] = b[k]; } }
            ss += ((v[j][0] * v[j][0] + v[j][1] * v[j][1]) + (v[j][2] * v[j][2] + v[j][3] * v[j][3])) + ((v[j][4] * v[j][4] + v[j][5] * v[j][5]) + (v[j][6] * v[j][6] + v[j][7] * v[j][7])); }
        const float rstd = 1.0f / sqrtf(wave_sum(ss, lane) * (1.0f / 2048.0f) + RMS_EPS);
#pragma unroll
        for (int j = 0; j < 4; ++j) { const int c = 8 * lane + 512 * j; float y[8];
#pragma unroll
            for (int h = 0; h < 2; ++h) { const f32x4 gg = *(const f32x4*)(g + c + 4 * h), s1 = *(const f32x4*)(sc + c + 4 * h), s0 = *(const f32x4*)(sh + c + 4 * h);
#pragma unroll
                for (int k = 0; k < 4; ++k) y[4 * h + k] = (v[j][4 * h + k] * rstd) * gg[k] * (s1[k] + 1.0f) + s0[k]; }
            *(v4u*)(H + (size_t)r * 2048 + c) = pack8(y);
            if (!which) { int q0 = 0, q1 = 0; q0 = __builtin_amdgcn_cvt_pk_fp8_f32(y[0], y[1], q0, false); q0 = __builtin_amdgcn_cvt_pk_fp8_f32(y[2], y[3], q0, true);
                q1 = __builtin_amdgcn_cvt_pk_fp8_f32(y[4], y[5], q1, false); q1 = __builtin_amdgcn_cvt_pk_fp8_f32(y[6], y[7], q1, true);
                *(v2u*)(p.ws + WS_H8 + (size_t)r * 2048 + c) = (v2u){(unsigned)q0, (unsigned)q1}; } }
    }
}

__device__ __forceinline__ void prep_phase(const Params& p, int l, LAS unsigned char* lds) {
    const int tid = opaque_tid(p.ph_hi), lane = tid & 63, wave = __builtin_amdgcn_readfirstlane(tid >> 6);
    const int gw = blockIdx.x * 8 + wave, NGW = gridDim.x * 8;
    bf16* Z = wsb(p, WS_Z); const float* tab = wsf(p, WS_TAB);
    v4u nraw[2] = {{0u, 0u, 0u, 0u}, {0u, 0u, 0u, 0u}};
#define PREP_LOAD(r_) do { const bf16* zq_ = Z + (size_t)(r_) * DIN + (lane & 7) * 8; _Pragma("unroll") for (int it = 0; it < 2; ++it) { int v = it * 8 + (lane >> 3); if (v > 11) v = 11; \
        const int col = v < 2 ? ZC_KW + v * 64 : v < 4 ? ZC_KG + (v - 2) * 64 : ZC_KD + (v - 4) * 64; nraw[it] = *(const v4u*)(zq_ + col); } } while (0)
    if (gw < MROWS) PREP_LOAD(gw);
    for (int r = gw; r < MROWS; r += NGW) {
        const bool isctx = r < M_C; const int seq = isctx ? (r >> 8) : ((r - M_C) >> 12), t = isctx ? (r & 255) : ((r - M_C) & 4095);
        bf16* zr = Z + (size_t)r * DIN; const int sub = lane & 7;
        v4u raws[2] = {nraw[0], nraw[1]};
        { const int rn = r + NGW < MROWS ? r + NGW : r; PREP_LOAD(rn); asm volatile("" ::: "memory"); }
#pragma unroll
        for (int it = 0; it < 2; ++it) {
            int v = it * 8 + (lane >> 3); const bool live = v < 12; if (!live) v = 11;
            int col; const float* gain; size_t ko;
            if (v < 2)      { col = ZC_KW + v * 64; gain = inptr(I_WKN); ko = O_WK + ((size_t)(seq * 4 + l) * 256 + t) * 128 + v * 64; }
            else if (v < 4) { col = ZC_KG + (v - 2) * 64; gain = inptr(I_GKN); ko = O_GK + ((size_t)(seq * 4 + l) * 256 + t) * 128 + (v - 2) * 64; }
            else            { col = ZC_KD + (v - 4) * 64; gain = inptr(I_DKN); ko = O_DK + ((size_t)(seq * 4 + l) * 256 + t) * 512 + (v - 4) * 64; }
            gain += l * 64 + sub * 8;
            float x[8]; unpack8(raws[it], x);
            float ss = 0.f;
#pragma unroll
            for (int j = 0; j < 8; ++j) ss += x[j] * x[j];
            ss += shfl_xor_l(ss, 1, lane); ss += shfl_xor_l(ss, 2, lane); ss += shfl_xor_l(ss, 4, lane);
            const float rstd = 1.0f / sqrtf(ss * (1.0f / 64.0f) + RMS_EPS);
            const f32x4 g0 = *(const f32x4*)gain, g1 = *(const f32x4*)(gain + 4);
            float y[8];
#pragma unroll
            for (int j = 0; j < 4; ++j) { y[j] = x[j] * rstd * g0[j]; y[4 + j] = x[4 + j] * rstd * g1[j]; }
            if (isctx) {
                if (live) { *(f32x4*)(p.out + ko + sub * 8) = (f32x4){y[0], y[1], y[2], y[3]}; *(f32x4*)(p.out + ko + sub * 8 + 4) = (f32x4){y[4], y[5], y[6], y[7]}; }
            } else {
                const int axis = sub >> 2, pos = axis ? (t & 63) : (t >> 6), f0 = (sub & 1) * 8; const bool half = (sub >> 1) & 1;
                const f32x4 c0 = *(const f32x4*)(tab + TAB_COS + pos * 16 + f0), c1 = *(const f32x4*)(tab + TAB_COS + pos * 16 + f0 + 4);
                const f32x4 s0 = *(const f32x4*)(tab + TAB_SIN + pos * 16 + f0), s1 = *(const f32x4*)(tab + TAB_SIN + pos * 16 + f0 + 4);
#pragma unroll
                for (int j = 0; j < 8; ++j) { const float pr = shfl_xor_l(y[j], 2, lane); const float c = j < 4 ? c0[j & 3] : c1[j & 3], s = j < 4 ? s0[j & 3] : s1[j & 3];
                    y[j] = y[j] * c + (half ? pr : -pr) * s; }
            }
            if (live) *(v4u*)(zr + col + sub * 8) = pack8(y);
        }
        if (isctx) {
#pragma unroll 1
            for (int it = 0; it < 2; ++it) { const int g = it * 64 + lane; if (g < 96) {
                int col; size_t vo;
                if (g < 16)      { col = ZC_VW + g * 8; vo = O_WV + ((size_t)(seq * 4 + l) * 256 + t) * 128 + g * 8; }
                else if (g < 32) { col = ZC_VG + (g - 16) * 8; vo = O_GV + ((size_t)(seq * 4 + l) * 256 + t) * 128 + (g - 16) * 8; }
                else             { col = ZC_VD + (g - 32) * 8; vo = O_DV + ((size_t)(seq * 4 + l) * 256 + t) * 512 + (g - 32) * 8; }
                float x[8]; unpack8(*(const v4u*)(zr + col), x);
                *(f32x4*)(p.out + vo) = (f32x4){x[0], x[1], x[2], x[3]}; *(f32x4*)(p.out + vo + 4) = (f32x4){x[4], x[5], x[6], x[7]}; } }
        }
    }
#undef PREP_LOAD
    LAS unsigned short* tile = (LAS unsigned short*)(lds + wave * 16384);
    for (int it = gw; it < (MROWS / 64) * 12; it += NGW) {
        const int rb = it / 12, cb = it % 12, r0 = rb * 64; const bool isctx = r0 < M_C;
        const int seq = isctx ? (r0 >> 8) : ((r0 - M_C) >> 12), t0 = isctx ? (r0 & 255) : ((r0 - M_C) & 4095), T = isctx ? T_C : T_L;
        int col; bf16* dst;
        if (cb < 2)      { col = ZC_VW + cb * 64; dst = wsb(p, isctx ? VT_BC : VT_BL) + (size_t)((seq * 2 + cb) * 64) * T; }
        else if (cb < 4) { col = ZC_VG + (cb - 2) * 64; dst = wsb(p, isctx ? VT_CC : VT_CL) + (size_t)((seq * 2 + cb - 2) * 64) * T; }
        else             { col = ZC_VD + (cb - 4) * 64; dst = wsb(p, isctx ? VT_DC : VT_DL) + (size_t)((seq * 4 + ((cb - 4) >> 1)) * 128 + ((cb - 4) & 1) * 64) * T; }
#pragma unroll
        for (int i = 0; i < 8; ++i) { const int row = i * 8 + (lane >> 3), ch = lane & 7; const v4u raw = *(const v4u*)(Z + (size_t)(r0 + row) * DIN + col + ch * 8);
            LAS unsigned* d = (LAS unsigned*)(tile + row * 66 + ch * 8); d[0] = raw.x; d[1] = raw.y; d[2] = raw.z; d[3] = raw.w; }
        asm volatile("s_waitcnt lgkmcnt(0)" ::: "memory");
#pragma unroll
        for (int i = 0; i < 8; ++i) { const int drow = i * 8 + (lane >> 3), tch = lane & 7; unsigned short e[8];
#pragma unroll
            for (int j = 0; j < 8; ++j) e[j] = tile[(16 * (tch >> 1) + 4 * (tch & 1) + (j & 3) + 8 * (j >> 2)) * 66 + drow];
            v4u o; o.x = e[0] | ((unsigned)e[1] << 16); o.y = e[2] | ((unsigned)e[3] << 16); o.z = e[4] | ((unsigned)e[5] << 16); o.w = e[6] | ((unsigned)e[7] << 16);
            *(v4u*)(dst + (size_t)drow * T + t0 + tch * 8) = o; }
        asm volatile("s_waitcnt lgkmcnt(0)" ::: "memory");
    }
}

__device__ __forceinline__ void dcomb_phase(const Params& p, int l) {
    const int tid = opaque_tid(p.ph_hi), lane = tid & 63, wave = __builtin_amdgcn_readfirstlane(tid >> 6);
    const int gw = blockIdx.x * 8 + wave, NGW = gridDim.x * 8;
    const float* tab = wsf(p, WS_TAB); const float lam = tab[TAB_LAMD + l], omli = 1.0f - tab[TAB_LAMI + l];
    const bf16* OD = wsb(p, WS_OD); bf16* BR3 = wsb(p, WS_BR) + 3 * BRW;
    const int h = lane >> 4, sub = lane & 15;
    const float* og = inptr(I_DOG) + l * 128 + sub * 8; const f32x4 g0 = *(const f32x4*)og, g1 = *(const f32x4*)(og + 4);
    for (int r = gw; r < MROWS; r += NGW) {
        float a[8], b[8]; unpack8(*(const v4u*)(OD + (size_t)r * 1024 + (h * 2) * 128 + sub * 8), a); unpack8(*(const v4u*)(OD + (size_t)r * 1024 + (h * 2 + 1) * 128 + sub * 8), b);
        float ss = 0.f;
#pragma unroll
        for (int j = 0; j < 8; ++j) { a[j] -= lam * b[j]; ss += a[j] * a[j]; }
        ss += shfl_xor_l(ss, 1, lane); ss += shfl_xor_l(ss, 2, lane); ss += shfl_xor_l(ss, 4, lane); ss += shfl_xor_l(ss, 8, lane);
        const float rstd = 1.0f / sqrtf(ss * (1.0f / 128.0f) + RMS_EPS) * omli;
#pragma unroll
        for (int j = 0; j < 4; ++j) { a[j] *= rstd * g0[j]; a[4 + j] *= rstd * g1[j]; }
        *(v4u*)(BR3 + (size_t)r * BRP + h * 128 + sub * 8) = pack8(a);
    }
}

constexpr int LR_U16 = 0, LR_U32 = 9216, LR_PA = 25600, LR_PB = 41984, LR_HF = 58368;
template <int MODE, bool AB = false>
__device__ __forceinline__ void lru_sweep(const Params& p, int l, int dir, int n, int rowseq0  , int T, int tch0  ,
                                          float& h  , float& aprod, LAS unsigned char* lds, unsigned* ab = nullptr) {
    const int tid = opaque_tid(p.ph_hi), lane = tid & 63, wave = __builtin_amdgcn_readfirstlane(tid >> 6), r32 = lane & 31, hi = lane >> 5;
    const bf16* Z = wsb(p, WS_Z);
    LAS unsigned short* U16 = (LAS unsigned short*)(lds + LR_U16); LAS float* U32 = (LAS float*)(lds + LR_U32); LAS float* PA = (LAS float*)(lds + LR_PA); LAS float* PB = (LAS float*)(lds + LR_PB); LAS float* HF = (LAS float*)(lds + LR_HF);
    const int g = wave >> 2, mi = (wave >> 1) & 1, ni = wave & 1, dcol = ni * 32 + r32;
    bf16x8 wf[4];
    { const bf16* wp = wsb(p, WS_LRUW) + ((size_t)((g * 64 + (l * 2 + dir) * 8 + n) * 64 + dcol)) * 64 + hi * 8;
#pragma unroll
      for (int ks = 0; ks < 4; ++ks) wf[ks] = *(const bf16x8*)(wp + ks * 16); }
    const float gbias = inptr(g ? I_LBI : I_LBR)[(l * 2 + dir) * 512 + n * 64 + dcol];
    const int tt = tid >> 3, c8 = (tid & 7) * 8;
    float cw[4][8], cb[8], sp[8];
#pragma unroll
    for (int k = 0; k < 4; ++k) { const float* q = inptr(I_CONVW) + (l * 4 + k) * 512 + n * 64 + c8; const f32x4 a = *(const f32x4*)q, b = *(const f32x4*)(q + 4);
        cw[k][0] = a[0]; cw[k][1] = a[1]; cw[k][2] = a[2]; cw[k][3] = a[3]; cw[k][4] = b[0]; cw[k][5] = b[1]; cw[k][6] = b[2]; cw[k][7] = b[3]; }
    { const float* q = inptr(I_CONVB) + l * 512 + n * 64 + c8; const float* s = wsf(p, WS_TAB) + TAB_SPL + (l * 2 + dir) * 512 + n * 64 + c8;
#pragma unroll
      for (int j = 0; j < 8; ++j) { cb[j] = q[j]; sp[j] = s[j]; } }
    v4u xr[4], yr = {0u, 0u, 0u, 0u};
#define LRU_FETCH(j4_) do { const int t_ = tch0 + 64 * (j4_) + tt; if (!AB) { _Pragma("unroll") for (int k = 0; k < 4; ++k) { const int tk = t_ + k - 1; \
        xr[k] = (tk >= 0 && tk < T) ? *(const v4u*)(Z + (size_t)(rowseq0 + tk) * DIN + ZC_XA + n * 64 + c8) : (v4u){0u, 0u, 0u, 0u}; } } \
        if (MODE == 2) yr = *(const v4u*)(Z + (size_t)(rowseq0 + t_) * DIN + ZC_YA + n * 64 + c8); } while (0)
    unsigned wn[8] = {0u, 0u, 0u, 0u, 0u, 0u, 0u, 0u};
#define LRU_FETCH_AB(j4_) do { _Pragma("unroll") for (int k = 0; k < 8; ++k) { const int st_ = dir ? 63 - (8 * wave + k) : 8 * wave + k; wn[k] = ab[(size_t)(tch0 + 64 * (j4_) + st_) * 512 + lane]; } } while (0)
    LRU_FETCH(dir ? 3 : 0);
    if (AB) LRU_FETCH_AB(dir ? 3 : 0);
#pragma unroll 1
    for (int jj = 0; jj < 4; ++jj) {
        const int j4 = dir ? 3 - jj : jj, ts = tch0 + 64 * j4, t = ts + tt;
        float ya[8]; unsigned wc[8];
        if constexpr (!AB) {
        { float u[8];
#pragma unroll
          for (int j = 0; j < 8; ++j) u[j] = cb[j];
#pragma unroll
          for (int k = 0; k < 4; ++k) { float x[8]; unpack8(xr[k], x);
#pragma unroll
              for (int j = 0; j < 8; ++j) u[j] += cw[k][j] * x[j]; }
          if (MODE == 2) unpack8(yr, ya);
          *(LAS v4u*)(U16 + tt * 72 + c8) = pack8(u);
          *(LAS f32x4*)(U32 + tt * 64 + c8) = (f32x4){u[0], u[1], u[2], u[3]}; *(LAS f32x4*)(U32 + tt * 64 + c8 + 4) = (f32x4){u[4], u[5], u[6], u[7]}; }
        __syncthreads();
        if (jj < 3) LRU_FETCH(dir ? 2 - jj : jj + 1);
        { f32x16 acc = {};
#pragma unroll
          for (int ks = 0; ks < 4; ++ks) { const bf16x8 a = *(const LAS bf16x8*)(U16 + (mi * 32 + r32) * 72 + ks * 16 + hi * 8); acc = __builtin_amdgcn_mfma_f32_32x32x16_bf16(a, wf[ks], acc, 0, 0, 0); }
          LAS float* P = g ? PB : PA;
#pragma unroll
          for (int r = 0; r < 16; ++r) P[(mi * 32 + crow(r, hi)) * 64 + dcol] = acc[r] + gbias; }
        __syncthreads();
        { unsigned wab[8];
#pragma unroll
          for (int j = 0; j < 8; ++j) { const int idx = tt * 64 + c8 + j;
              const float rg = __builtin_amdgcn_rcpf(1.0f + __builtin_amdgcn_exp2f(-1.4426950408889634f * PA[idx])), ig = __builtin_amdgcn_rcpf(1.0f + __builtin_amdgcn_exp2f(-1.4426950408889634f * PB[idx]));
              const float la = -8.0f * rg * sp[j]; const float a = __builtin_amdgcn_exp2f(1.4426950408889634f * la);
              const float x = 2.0f * la; const float ser = -x * (1.0f + x * (0.5f + x * (0.16666667f + x * (0.041666668f + x * (0.0083333338f + x * 0.0013888889f)))));
              const float om = x > -0.25f ? ser : 1.0f - a * a;
              const float b = __builtin_amdgcn_sqrtf(om) * ig * U32[idx];
              if (MODE == 0) { const unsigned w = pk2(1.4426950408889634f * la, b); wab[j] = w; PA[idx] = __builtin_amdgcn_exp2f(bflo(w)); PB[idx] = bfhi(w); }
              else { PA[idx] = a; PB[idx] = b; } }
          if (MODE == 0) { unsigned* q = ab + (size_t)(ts + tt) * 512 + c8; *(v4u*)q = (v4u){wab[0], wab[1], wab[2], wab[3]}; *(v4u*)(q + 4) = (v4u){wab[4], wab[5], wab[6], wab[7]}; } }
        __syncthreads();
        } else {
            if (MODE == 2) unpack8(yr, ya);
#pragma unroll
            for (int k = 0; k < 8; ++k) wc[k] = wn[k];
            if (jj < 3) { LRU_FETCH(dir ? 2 - jj : jj + 1); LRU_FETCH_AB(dir ? 2 - jj : jj + 1); }
        }
        {
            LAS float* SC = (LAS float*)(lds + LR_U16);
            float av[8], bv[8];
#pragma unroll
            for (int k = 0; k < 8; ++k) { const int st = dir ? 63 - (8 * wave + k) : 8 * wave + k; if (AB) { av[k] = __builtin_amdgcn_exp2f(bflo(wc[k])); bv[k] = bfhi(wc[k]); } else { av[k] = PA[st * 64 + lane]; bv[k] = PB[st * 64 + lane]; } }
            float Al = av[0], Bl = bv[0];
#pragma unroll
            for (int k = 1; k < 8; ++k) { Bl = av[k] * Bl + bv[k]; Al *= av[k]; }
            SC[(wave * 2) * 64 + lane] = Al; SC[(wave * 2 + 1) * 64 + lane] = Bl;
            __syncthreads();
            float hv = h, hin = h;
#pragma unroll
            for (int v = 0; v < 8; ++v) { const float Av = SC[(2 * v) * 64 + lane], Bv = SC[(2 * v + 1) * 64 + lane]; if (v == wave) hin = hv; hv = Av * hv + Bv; if (MODE == 0) aprod *= Av; }
            h = hv;
#pragma unroll
            for (int k = 0; k < 8; ++k) { const int st = dir ? 63 - (8 * wave + k) : 8 * wave + k; hin = av[k] * hin + bv[k];
                if (MODE == 1) HF[(j4 * 64 + st) * 64 + lane] = hin;
                if (MODE == 2) PB[st * 64 + lane] = hin; }
        }
        __syncthreads();
        if (MODE == 2) {
            float o[8];
#pragma unroll
            for (int j = 0; j < 8; ++j) { const float hs = HF[(j4 * 64 + tt) * 64 + c8 + j] + PB[tt * 64 + c8 + j]; const float y = ya[j];
                const float ug = 0.7978845608028654f * (y + 0.044715f * y * y * y);
                const float gl = y * __builtin_amdgcn_rcpf(1.0f + __builtin_amdgcn_exp2f(-2.8853900817779268f * ug)); o[j] = hs * gl; }
            *(v4u*)(wsb(p, WS_BR) + (size_t)(rowseq0 + t) * BRP + n * 64 + c8) = pack8(o);
        }
    }
#undef LRU_FETCH
#undef LRU_FETCH_AB
}
__device__ __forceinline__ void lru_pass1(const Params& p, int l, LAS unsigned char* lds) {
    const int tid = opaque_tid(p.ph_hi), lane = tid & 63, wave = __builtin_amdgcn_readfirstlane(tid >> 6);
    float* SUM = wsf(p, WS_SUM);
#pragma unroll 1
    for (int it = blockIdx.x; it < NSEQ_L * 2 * 8 * 16; it += gridDim.x) {
        const int seq = it >> 8, dir = (it >> 7) & 1, n = (it >> 4) & 7, c = it & 15;
        float h = 0.f, ap = 1.f; asm volatile("" : "+v"(h), "+v"(ap));
        __syncthreads();
        lru_sweep<0>(p, l, dir, n, M_C + seq * T_L, T_L, c * 256, h, ap, lds, (unsigned*)(p.ws + WS_LAB) + ((size_t)(seq * 2 + dir) * T_L) * 512 + n * 64);
        if (wave == 0) { float* s = SUM + ((size_t)((seq * 2 + dir) * 16 + c) * 512 + n * 64 + lane) * 2; s[0] = ap; s[1] = h; }
    }
}
__device__ __forceinline__ void lru_pass2(const Params& p, int l, LAS unsigned char* lds) {
    const int tid = opaque_tid(p.ph_hi), lane = tid & 63, wave = __builtin_amdgcn_readfirstlane(tid >> 6);
    const float* SUM = wsf(p, WS_SUM);
#pragma unroll 1
    for (int it = blockIdx.x; it < NSEQ_L * 8 * 16 + NSEQ_C * 8; it += gridDim.x) {
        const bool lat = it < NSEQ_L * 8 * 16;
        int seq, n, c, rowseq0, T;
        if (lat) { seq = it >> 7; n = (it >> 4) & 7; c = it & 15; rowseq0 = M_C + seq * T_L; T = T_L; }
        else { const int i2 = it - NSEQ_L * 8 * 16; seq = i2 >> 3; n = i2 & 7; c = 0; rowseq0 = seq * T_C; T = T_C; }
        float hf = 0.f, hb = 0.f, dummy = 1.f; asm volatile("" : "+v"(hf), "+v"(hb), "+v"(dummy));
        if (lat) {
            const int ch = n * 64 + lane;
            hf = inptr(I_SLRU)[((size_t)(seq * 4 + l) * 2 + 0) * 512 + ch]; hb = inptr(I_SLRU)[((size_t)(seq * 4 + l) * 2 + 1) * 512 + ch];
            { pg8::f32x2_t sv[16];
#pragma unroll
              for (int cc = 0; cc < 16; ++cc) sv[cc] = *(const pg8::f32x2_t*)(SUM + ((size_t)((seq * 2 + 0) * 16 + cc) * 512 + ch) * 2);
#pragma unroll
              for (int cc = 0; cc < 16; ++cc) hf = cc < c ? sv[cc][0] * hf + sv[cc][1] : hf;
#pragma unroll
              for (int cc = 0; cc < 16; ++cc) sv[cc] = *(const pg8::f32x2_t*)(SUM + ((size_t)((seq * 2 + 1) * 16 + cc) * 512 + ch) * 2);
#pragma unroll
              for (int cc = 15; cc >= 0; --cc) hb = cc > c ? sv[cc][0] * hb + sv[cc][1] : hb; }
        }
        __syncthreads();
        if (lat) { unsigned* ab = (unsigned*)(p.ws + WS_LAB) + ((size_t)(seq * 2) * T_L) * 512 + n * 64;
            lru_sweep<1, true>(p, l, 0, n, rowseq0, T, c * 256, hf, dummy, lds, ab);
            lru_sweep<2, true>(p, l, 1, n, rowseq0, T, c * 256, hb, dummy, lds, ab + (size_t)T_L * 512); }
        else {
            lru_sweep<1>(p, l, 0, n, rowseq0, T, c * 256, hf, dummy, lds);
            lru_sweep<2>(p, l, 1, n, rowseq0, T, c * 256, hb, dummy, lds); }
        if (!lat && wave == 0) { float* o = p.out + O_LS + ((size_t)(seq * 4 + l) * 2) * 512 + n * 64 + lane; o[0] = hf; o[512] = hb; }
    }
}

struct AttnJob {
    const bf16* Q; const bf16* Ks; const bf16* VTs; const bf16* Kc; const bf16* VTc; bf16* O;
    int kspitch, vtspitch, kcpitch, opitch, s_t0, s_nt, c_nt, q0, window, wv, rope; float sink2; bool has_sink; const float* qg; const float* tab;
};
constexpr int AT_K = 0, AT_V = 32768;
#define GLDS16(gp, lp) __builtin_amdgcn_global_load_lds((const unsigned*)(gp), (LAS unsigned*)(lp), 16, 0, 0)
constexpr float ATT_THR = 8.0f;
template <int VW, int PROBE>
__device__ __forceinline__ void attn_unit(const AttnJob& J, LAS unsigned char* lds) {
    const int tid = opaque_tid(J.wv), lane = tid & 63, wid = __builtin_amdgcn_readfirstlane(tid >> 6), r32 = lane & 31, hi = lane >> 5;
    constexpr int NB = VW / 32;
    bf16x8 qf[4];
    { const bf16* qp = J.Q + (size_t)(wid * 32 + r32) * DIN + hi * 8;
      v4u raw[4];
#pragma unroll
      for (int ks = 0; ks < 4; ++ks) raw[ks] = *(const v4u*)(qp + ks * 16);
      float y[4][8]; float ss = 0.f;
#pragma unroll
      for (int ks = 0; ks < 4; ++ks) { unpack8(raw[ks], y[ks]);
#pragma unroll
          for (int j = 0; j < 8; ++j) ss += y[ks][j] * y[ks][j]; }
      { const auto rr_ = __builtin_amdgcn_permlane32_swap(__float_as_uint(ss), __float_as_uint(ss), false, false); ss = __uint_as_float(rr_[0]) + __uint_as_float(rr_[1]); }
      const float rstd = 1.0f / sqrtf(ss * (1.0f / 64.0f) + RMS_EPS);
#pragma unroll
      for (int ks = 0; ks < 4; ++ks) { const f32x4 g0 = *(const f32x4*)(J.qg + 16 * ks + 8 * hi), g1 = *(const f32x4*)(J.qg + 16 * ks + 8 * hi + 4);
#pragma unroll
          for (int j = 0; j < 4; ++j) { y[ks][j] = y[ks][j] * rstd * g0[j]; y[ks][4 + j] = y[ks][4 + j] * rstd * g1[j]; } }
      if (J.rope) { const int tq = J.q0 + wid * 32 + r32;
#pragma unroll
          for (int ax = 0; ax < 2; ++ax) { const int pos = ax ? (tq & 63) : (tq >> 6); const float* cp = J.tab + TAB_COS + pos * 16 + 8 * hi, * sp = J.tab + TAB_SIN + pos * 16 + 8 * hi;
              const f32x4 c0 = *(const f32x4*)cp, c1 = *(const f32x4*)(cp + 4), s0 = *(const f32x4*)sp, s1 = *(const f32x4*)(sp + 4);
#pragma unroll
              for (int j = 0; j < 8; ++j) { const float c = j < 4 ? c0[j & 3] : c1[j & 3], s = j < 4 ? s0[j & 3] : s1[j & 3]; const float a = y[2 * ax][j], b = y[2 * ax + 1][j];
                  y[2 * ax][j] = a * c - b * s; y[2 * ax + 1][j] = b * c + a * s; } } }
#pragma unroll
      for (int ks = 0; ks < 4; ++ks) {
#pragma unroll
          for (int j = 0; j < 8; ++j) y[ks][j] *= QSCALE;
          qf[ks] = __builtin_bit_cast(bf16x8, pack8(y[ks])); } }
    float mref = 0.f, lsum = 0.f; f32x16 o[NB]; f32x16 negm;
    { float zz = 0.f; asm volatile("" : "+v"(zz));
#pragma unroll
      for (int r = 0; r < 16; ++r) { negm[r] = zz;
#pragma unroll
          for (int b = 0; b < NB; ++b) o[b][r] = zz; } }
    const int NT = J.s_nt + J.c_nt, qw0 = J.q0 + wid * 32;
    const int krow = wid * 8 + (lane >> 3), kchunk = (lane & 7) ^ ((krow >> 1) & 7);
    const unsigned lk_s = (unsigned)krow * (unsigned)J.kspitch * 2u + kchunk * 16u, lk_c = (unsigned)krow * (unsigned)J.kcpitch * 2u + kchunk * 16u, lv_s = (unsigned)lane * (unsigned)J.vtspitch * 2u, lv_c = (unsigned)lane * (unsigned)(PAST * 2);
#define ATT_ISSUE_K(t_, slot_) do { const int t__ = (t_); \
        if (t__ < J.s_nt) GLDS16((const char*)J.Ks + (size_t)(J.s_t0 + t__ * 64) * J.kspitch * 2 + lk_s, lds + AT_K + (slot_) * 8192 + wid * 1024); \
        else GLDS16((const char*)J.Kc + (size_t)((t__ - J.s_nt) * 64) * J.kcpitch * 2 + lk_c, lds + AT_K + (slot_) * 8192 + wid * 1024); } while (0)
#define ATT_ISSUE_V(t_, slot_) do { const int t__ = (t_); \
        if (t__ < J.s_nt) { const char* vb_ = (const char*)J.VTs + (size_t)(J.s_t0 + t__ * 64 + wid * 8) * 2; GLDS16(vb_ + lv_s, lds + AT_V + (slot_) * 16384 + wid * 1024); \
            if (VW == 128) GLDS16(vb_ + (size_t)128 * J.vtspitch + lv_s, lds + AT_V + (slot_) * 16384 + 8192 + wid * 1024); } \
        else { const char* vb_ = (const char*)J.VTc + (size_t)((t__ - J.s_nt) * 64 + wid * 8) * 2; GLDS16(vb_ + lv_c, lds + AT_V + (slot_) * 16384 + wid * 1024); \
            if (VW == 128) GLDS16(vb_ + (size_t)128 * PAST + lv_c, lds + AT_V + (slot_) * 16384 + 8192 + wid * 1024); } } while (0)
#define ATT_NEED(t_) (!(J.window && (t_) < J.s_nt) || ((J.s_t0 + (t_) * 64 + 63 >= qw0 - 128) && (J.s_t0 + (t_) * 64 <= qw0 + 31 + 128)))
#define ATT_LDK(slot_) do { const LAS unsigned char* Kb = lds + AT_K + (slot_) * 8192 + (r32 >> 3) * 1024 + (r32 & 7) * 128; const int kx = ((r32 >> 1) & 7); \
        _Pragma("unroll") for (int ks = 0; ks < 4; ++ks) { kf[2 * ks] = *(const LAS bf16x8*)(Kb + (((2 * ks + hi) ^ kx) << 4)); kf[2 * ks + 1] = *(const LAS bf16x8*)(Kb + 4096 + (((2 * ks + hi) ^ kx) << 4)); } } while (0)
#define ATT_MMK(P0, P1) do { \
        P0 = __builtin_amdgcn_mfma_f32_32x32x16_bf16(kf[0], qf[0], negm, 0, 0, 0); P1 = __builtin_amdgcn_mfma_f32_32x32x16_bf16(kf[1], qf[0], negm, 0, 0, 0); \
        _Pragma("unroll") for (int ks = 1; ks < 4; ++ks) { P0 = __builtin_amdgcn_mfma_f32_32x32x16_bf16(kf[2 * ks], qf[ks], P0, 0, 0, 0); P1 = __builtin_amdgcn_mfma_f32_32x32x16_bf16(kf[2 * ks + 1], qf[ks], P1, 0, 0, 0); } } while (0)
#define ATT_LDV(VF, vslot_, b_) do { const LAS unsigned char* vb = lds + AT_V + (vslot_) * 16384 + ((b_) >> 1) * 8192 + (((b_) & 1) * 32 + r32) * 16 + hi * 1024; \
        _Pragma("unroll") for (int s_ = 0; s_ < 4; ++s_) VF[s_] = *(const LAS v4u*)(vb + (2 * s_) * 1024); } while (0)
#define ATT_MMV(VF, b_) do { _Pragma("unroll") for (int s_ = 0; s_ < 4; ++s_) o[b_] = __builtin_amdgcn_mfma_f32_32x32x16_bf16(__builtin_bit_cast(bf16x8, VF[s_]), __builtin_bit_cast(bf16x8, pw[s_]), o[b_], 0, 0, 0); } while (0)
#define ATT_SB __builtin_amdgcn_sched_barrier(0)
#define ATT_PVK(vslot_, kslot_, ldk_) do { ATT_LDV(vf0, vslot_, 0); ATT_LDV(vf1, vslot_, 1); ATT_SB; \
        if (VW == 128) { ATT_MMV(vf0, 0); ATT_SB; ATT_LDV(vf0, vslot_, 2 % NB); ATT_SB; ATT_MMV(vf1, 1); ATT_SB; ATT_LDV(vf1, vslot_, 3 % NB); ATT_SB; ATT_MMV(vf0, 2 % NB); ATT_SB; \
            ATT_MMV(vf1, 3 % NB); ATT_SB; if (ldk_) { ATT_LDK(kslot_); ATT_SB; } } \
        else { ATT_MMV(vf0, 0); ATT_MMV(vf1, 1); ATT_SB; if (ldk_) { ATT_LDK(kslot_); ATT_SB; } } } while (0)
#define ATT_MAX(PC0, PC1, t_) do { \
        if (J.window && (t_) < J.s_nt && !((J.s_t0 + (t_) * 64 >= qw0 + 31 - 128) && (J.s_t0 + (t_) * 64 + 63 <= qw0 + 128))) {     \
            int dbase = qw0 + r32 - (J.s_t0 + (t_) * 64) - 4 * hi; asm volatile("" : "+v"(dbase));     \
            _Pragma("unroll") for (int r = 0; r < 16; ++r) { int d0 = dbase - ((r & 3) + 8 * (r >> 2)); d0 = d0 < 0 ? -d0 : d0; int d1 = dbase - ((r & 3) + 8 * (r >> 2)) - 32; d1 = d1 < 0 ? -d1 : d1; \
                if (d0 > 128) PC0[r] = -INFINITY; if (d1 > 128) PC1[r] = -INFINITY; } } \
        float mx = fmaxf(fmaxf(PC0[0], PC1[0]), PC0[1]); \
        _Pragma("unroll") for (int r = 2; r < 16; r += 2) mx = fmaxf(fmaxf(mx, PC0[r]), PC0[r + 1]); \
        _Pragma("unroll") for (int r = 1; r < 15; r += 2) mx = fmaxf(fmaxf(mx, PC1[r]), PC1[r + 1]); \
        mx = fmaxf(mx, PC1[15]); { const auto rr_ = __builtin_amdgcn_permlane32_swap(__float_as_uint(mx), __float_as_uint(mx), false, false); mx = fmaxf(__uint_as_float(rr_[0]), __uint_as_float(rr_[1])); }     \
        if (__any(mx > ATT_THR)) { const float dl = fmaxf(mx, 0.f), f = __builtin_amdgcn_exp2f(-dl); mref += dl; lsum *= f; \
            _Pragma("unroll") for (int r = 0; r < 16; ++r) { PC0[r] -= dl; PC1[r] -= dl; negm[r] = -mref; } \
            _Pragma("unroll") for (int b = 0; b < NB; ++b) _Pragma("unroll") for (int r = 0; r < 16; ++r) o[b][r] *= f; } } while (0)
#define ATT_EXP(PC0, PC1) do { pg8::f32x2_t rs2 = {0.f, 0.f}; \
        _Pragma("unroll") for (int r = 0; r < 16; ++r) { PC0[r] = __builtin_amdgcn_exp2f(PC0[r]); PC1[r] = __builtin_amdgcn_exp2f(PC1[r]); } \
        _Pragma("unroll") for (int r = 0; r < 16; r += 2) { rs2 += (pg8::f32x2_t){PC0[r], PC0[r + 1]}; rs2 += (pg8::f32x2_t){PC1[r], PC1[r + 1]}; } \
        lsum += rs2[0] + rs2[1]; \
        _Pragma("unroll") for (int i = 0; i < 4; ++i) { pw[0][i] = pg8::cvt_pk_bf16(PC0[2 * i], PC0[2 * i + 1]); pw[1][i] = pg8::cvt_pk_bf16(PC0[8 + 2 * i], PC0[9 + 2 * i]); \
            pw[2][i] = pg8::cvt_pk_bf16(PC1[2 * i], PC1[2 * i + 1]); pw[3][i] = pg8::cvt_pk_bf16(PC1[8 + 2 * i], PC1[9 + 2 * i]); } } while (0)
#define ATT_WAITBAR(n_) asm volatile("s_waitcnt vmcnt(" #n_ ") lgkmcnt(0)\n\ts_barrier" ::: "memory")
#define ATT_TOP(t_) do { if (PROBE != 1) { if ((t_) + 3 < NT) ATT_ISSUE_K((t_) + 3, ((t_) + 3) & 3); if ((t_) + 2 < NT) ATT_ISSUE_V((t_) + 2, ((t_) + 2) & 3); } } while (0)
#define ATT_END(t_) do { if (PROBE == 1) ATT_WAITBAR(0); else if ((t_) + 3 < NT) { if (VW == 128) ATT_WAITBAR(3); else ATT_WAITBAR(2); } \
        else if ((t_) + 2 < NT) { if (VW == 128) ATT_WAITBAR(2); else ATT_WAITBAR(1); } else ATT_WAITBAR(0); } while (0)
    const bool grpA = wid < 4;
    __syncthreads();
    ATT_ISSUE_K(0, 0); ATT_ISSUE_V(0, 0); ATT_ISSUE_K(1, 1); ATT_ISSUE_V(1, 1); ATT_ISSUE_K(2, 2);
    if (VW == 128) ATT_WAITBAR(3); else ATT_WAITBAR(2);
    f32x16 p0, p1; v4u pw[4], vf0[4], vf1[4]; bf16x8 kf[8];
    constexpr bool PF = (VW == 64);
    if (grpA) {
        if (PF) ATT_LDK(0);
#pragma unroll 1
        for (int t = 0; t < NT; ++t) {
            ATT_TOP(t);
            ATT_SB;
            if (t > 0) ATT_PVK((t - 1) & 3, t & 3, !PF); else if (!PF) { ATT_LDK(t & 3); ATT_SB; }
            ATT_MMK(p0, p1);
            ATT_SB;
            if (PF) { ATT_LDK((t + 1) & 3); }
            ATT_SB;
            ATT_MAX(p0, p1, t); ATT_EXP(p0, p1);
            ATT_END(t);
        }
        ATT_PVK((NT - 1) & 3, 0, false);
    } else {
        ATT_LDK(0); ATT_SB; ATT_MMK(p0, p1);
#pragma unroll 1
        for (int t = 0; t < NT; ++t) {
            ATT_TOP(t);
            if (PF) { ATT_LDK((t + 1) & 3); }
            ATT_SB;
            ATT_MAX(p0, p1, t); ATT_EXP(p0, p1);
            ATT_SB;
            ATT_PVK(t & 3, (t + 1) & 3, !PF);
            if (t + 1 < NT) ATT_MMK(p0, p1);
            ATT_END(t);
        }
    }
#undef ATT_TOP
#undef ATT_END
#undef ATT_WAITBAR
#undef ATT_MAX
#undef ATT_EXP
#undef ATT_LDK
#undef ATT_MMK
#undef ATT_LDV
#undef ATT_MMV
#undef ATT_PVK
#undef ATT_SB
#undef ATT_ISSUE_K
#undef ATT_ISSUE_V
#undef ATT_NEED
    float lt = lsum + shfl_xor_l(lsum, 32, lane);
    if (J.has_sink) lt += __builtin_amdgcn_exp2f(J.sink2 - mref);
    const float inv = 1.0f / lt;
    bf16* op = J.O + (size_t)(wid * 32 + r32) * J.opitch + 8 * hi;
#pragma unroll
    for (int b = 0; b < NB; ++b)
#pragma unroll
        for (int e = 0; e < 4; e += 2) {
            const unsigned a0 = pk2(o[b][4 * e] * inv, o[b][4 * e + 1] * inv), a1 = pk2(o[b][4 * e + 2] * inv, o[b][4 * e + 3] * inv);
            const unsigned b0 = pk2(o[b][4 * e + 4] * inv, o[b][4 * e + 5] * inv), b1 = pk2(o[b][4 * e + 6] * inv, o[b][4 * e + 7] * inv);
            const auto s0 = __builtin_amdgcn_permlane32_swap(a0, b0, false, false), s1 = __builtin_amdgcn_permlane32_swap(a1, b1, false, false);
            *(v4u*)(op + b * 32 + 8 * e) = (v4u){s0[0], s1[0], s0[1], s1[1]}; }
}
constexpr int AU_DL = 512, AU_CL = 1024, AU_BL = 1536, AU_DC = 1792, AU_CC = 2048, AU_END = 2304;
template <int PROBE>
__device__ __forceinline__ void attn_phase(const Params& p, int l, LAS unsigned char* lds) {
    const bf16* Z = wsb(p, WS_Z);
#pragma unroll 1
    for (int u = blockIdx.x; u < AU_END; u += gridDim.x) {
        AttnJob J; bool is128 = false; J.wv = p.ph_hi; J.tab = wsf(p, WS_TAB); J.rope = u < AU_BL; J.window = 0; J.has_sink = false; J.sink2 = 0.f; J.kspitch = DIN;
        const bool xdeal = gridDim.x == 256; const int xcd = blockIdx.x & 7, slot = blockIdx.x >> 3;
        if (u < AU_BL) {
            int v = u & 511; if (xdeal) { const int k = ((v >> 8) << 5) + slot; v = ((xcd * 4 + (k >> 4)) << 4) + (k & 15); }
            const int seq = v >> 7, qb = v & 15; const size_t rs0 = (size_t)M_C + (size_t)seq * T_L, rq = rs0 + qb * 256;
            J.q0 = qb * 256; J.s_t0 = 0; J.s_nt = 64; J.c_nt = 8; J.vtspitch = T_L;
            if (u < AU_DL) { const int hj = (v >> 4) & 7, h = hj >> 1;
                J.Q = Z + rq * DIN + ZC_QD + hj * 64; J.Ks = Z + rs0 * DIN + ZC_KD + hj * 64; J.VTs = wsb(p, VT_DL) + (size_t)((seq * 4 + h) * 128) * T_L;
                J.Kc = wsb(p, CK_DK) + (size_t)((seq * 4 + l) * 512) * 512 + hj * 64; J.kcpitch = 512; J.VTc = wsb(p, CK_DVT) + (size_t)((seq * 4 + l) * 512 + h * 128) * 512;
                J.O = wsb(p, WS_OD) + rq * 1024 + hj * 128; J.opitch = 1024;
                is128 = true;
            } else { const int head = (v >> 4) & 7, kvh = head >> 2; const bool isB = u >= AU_CL;
                J.Q = Z + rq * DIN + (isB ? ZC_QW : ZC_QG) + head * 64; J.Ks = Z + rs0 * DIN + (isB ? ZC_KW : ZC_KG) + kvh * 64; J.VTs = wsb(p, isB ? VT_BL : VT_CL) + (size_t)((seq * 2 + kvh) * 64) * T_L;
                J.Kc = wsb(p, isB ? CK_WK : CK_GK) + (size_t)((seq * 4 + l) * 512) * 128 + kvh * 64; J.kcpitch = 128; J.VTc = wsb(p, isB ? CK_WVT : CK_GVT) + (size_t)((seq * 4 + l) * 128 + kvh * 64) * 512;
                J.O = wsb(p, WS_BR) + (isB ? 1 : 2) * BRW + rq * BRP + head * 64; J.opitch = BRP;
                if (isB) { J.window = 1; J.has_sink = true; J.sink2 = inptr(I_WSINK)[l * 8 + head] * 1.4426950408889634f;
                    const int klo = J.q0 - 128 < 0 ? 0 : J.q0 - 128, khi = J.q0 + 384 > T_L ? T_L : J.q0 + 384; J.s_t0 = klo; J.s_nt = (khi - klo) >> 6; }
            }
        } else {
            int v = (u - AU_BL) & 255; if (xdeal) v = xcd * 32 + slot;
            const int seq = v >> 3; const size_t rs0 = (size_t)seq * T_C;
            J.q0 = 0; J.s_t0 = 0; J.s_nt = 4; J.c_nt = 0; J.vtspitch = T_C; J.Kc = Z; J.VTc = Z; J.kcpitch = 0;
            if (u < AU_DC) { const int hj = v & 7, h = hj >> 1;
                J.Q = Z + rs0 * DIN + ZC_QD + hj * 64; J.Ks = Z + rs0 * DIN + ZC_KD + hj * 64; J.VTs = wsb(p, VT_DC) + (size_t)((seq * 4 + h) * 128) * T_C;
                J.O = wsb(p, WS_OD) + rs0 * 1024 + hj * 128; J.opitch = 1024;
                is128 = true;
            } else { const int head = v & 7, kvh = head >> 2; const bool isB = u >= AU_CC;
                J.Q = Z + rs0 * DIN + (isB ? ZC_QW : ZC_QG) + head * 64; J.Ks = Z + rs0 * DIN + (isB ? ZC_KW : ZC_KG) + kvh * 64; J.VTs = wsb(p, isB ? VT_BC : VT_CC) + (size_t)((seq * 2 + kvh) * 64) * T_C;
                J.O = wsb(p, WS_BR) + (isB ? 1 : 2) * BRW + rs0 * BRP + head * 64; J.opitch = BRP;
                if (isB) { J.has_sink = true; J.sink2 = inptr(I_WSINK)[l * 8 + head] * 1.4426950408889634f; }
            }
        }
        J.qg = inptr(is128 ? I_DQN : J.has_sink ? I_WQN : I_GQN) + l * 64;
        if (PROBE) { J.O = wsb(p, WS_H) + (J.O - (is128 ? wsb(p, WS_OD) : wsb(p, WS_BR))); }
        if (is128) attn_unit<128, PROBE>(J, lds); else attn_unit<64, PROBE>(J, lds);
    }
}

constexpr int NPL = 10;
constexpr int N_PHASES = 1 + DEPTH * NPL;
#ifndef PG8_SP2
#define PG8_SP2 true
#endif
#ifndef PG8_ALIGN
#define PG8_ALIGN true
#endif
__global__ void __launch_bounds__(512, 2) fwd_kernel(Params p_) {
    extern __shared__ __attribute__((aligned(16))) unsigned char lds_raw[];
    LAS unsigned char* lds = (LAS unsigned char*)lds_raw;
    const int tid = threadIdx.x, G = gridDim.x;
    const int lo = p_.ph_lo, hi = p_.ph_hi;
    Params p = p_; p.ph_hi = __builtin_amdgcn_readfirstlane(tid >> 6);
    for (int u = tid; u < (LDS_BYTES - LDSCTL_OFF) / 4; u += 512) ((LAS unsigned*)(lds + LDSCTL_OFF))[u] = 0u;
    __syncthreads();
    XcdBarrier bar = xcd_barrier_post((unsigned*)(p.ws + WS_CTL) + 1024, (volatile LAS unsigned*)(lds + LDSCTL_OFF + 64), p.ph_hi);
#ifndef PH_MASK
#define PH_MASK 0xFFFFFFFFu
#endif
#define IN(k) (lo <= (k) && (k) < hi)
#define EN(b) ((PH_MASK >> (b)) & 1u)
#ifndef ATT_PROBE
#define ATT_PROBE 0
#endif
#ifndef DUP_MASK
#define DUP_MASK 0u
#endif
#define DUP(b) (((DUP_MASK >> (b)) & 1u) ? 2 : 1)
#define SEAM(k) do { if (IN(k) && IN((k) + 1)) xcd_barrier(bar); } while (0)

    if (IN(0) && EN(10)) for (int rep_ = 0; rep_ < DUP(10); ++rep_) { prologue_phase(p, lds); __syncthreads(); }
    SEAM(0);
#pragma unroll 1
    for (int l = 0; l < DEPTH; ++l) {
        const int pb = 1 + l * NPL;
        const bf16* WL = wsb(p, WS_W) + (size_t)l * WL_ELEMS;
        const float* modl = wsf(p, WS_MOD) + (size_t)l * 5 * 12288;
        if (IN(pb + 0) && EN(0)) for (int rep_ = 0; rep_ < DUP(0); ++rep_) { if (l == 0) norm_phase<false>(p, l, 0); else norm_phase<true>(p, l, 0); }
        SEAM(pb + 0);
        if (IN(pb + 1) && EN(1)) for (int rep_ = 0; rep_ < DUP(1); ++rep_) {
            { pg8::Gemm g{wsb(p, WS_H), WL + W_IN_T, MROWS, DIN, DMODEL, 0, 0, p.ph_hi}; pg8::StaticOrder S; S.init(MROWS, DIN, G, (int)blockIdx.x);
              pg8::EpiBf16<0> E{wsb(p, WS_Z), DIN, nullptr, 0};
              pg8::gemm_phase<pg8::EpiBf16<0>, pg8::StaticOrder, PG8_ALIGN, PG8_SP2>(lds, g, S, E); }
            { pg8::Gemm g{(const bf16*)(p.ws + WS_H8), (const bf16*)(p.ws + WS_W8 + (size_t)l * 8192 * 2048), MROWS, 4 * DMODEL, DMODEL / 2, 0, 0, p.ph_hi}; pg8::StaticOrder S; S.init(MROWS, 4 * DMODEL, G, (int)blockIdx.x);
              pg8::EpiGateU8 E{p.ws + WS_G, inptr(I_BGATE) + (size_t)l * 4 * DMODEL, 0};
              pg8::gemm_phase<pg8::EpiGateU8, pg8::StaticOrder, false, PG8_SP2>(lds, g, S, E); }
        }
        SEAM(pb + 1);
        if (IN(pb + 2) && EN(2)) { prep_phase(p, l, lds); __syncthreads(); for (int rep_ = 0; rep_ < DUP(2); ++rep_) lru_pass1(p, l, lds); }
        SEAM(pb + 2);
        if (IN(pb + 3) && EN(3)) {
#if ATT_PROBE
            attn_phase<ATT_PROBE>(p, l, lds); __syncthreads();
#endif
            for (int rep_ = 0; rep_ < DUP(3); ++rep_) { attn_phase<0>(p, l, lds); __syncthreads(); } for (int rep_ = 0; rep_ < DUP(11); ++rep_) lru_pass2(p, l, lds); }
        SEAM(pb + 3);
        if (IN(pb + 4) && EN(4)) for (int rep_ = 0; rep_ < DUP(4); ++rep_) dcomb_phase(p, l);
        SEAM(pb + 4);
        if (IN(pb + 5) && EN(5)) for (int rep_ = 0; rep_ < DUP(5); ++rep_) {
            pg8::Gemm g{wsb(p, WS_BR), WL + W_BR_T, MROWS, DMODEL, DMODEL, 0, 0, p.ph_hi}; pg8::StaticOrder S; S.init(MROWS, DMODEL, G, (int)blockIdx.x);
            pg8::EpiMerge E{p.ws + WS_G, wsb(p, WS_H)};
            pg8::gemm_phase<pg8::EpiMerge, pg8::StaticOrder, PG8_ALIGN, PG8_SP2>(lds, g, S, E);
        }
        SEAM(pb + 5);
        if (IN(pb + 6) && EN(6)) {
            pg8::Gemm g{wsb(p, WS_H), WL + W_O_T, MROWS, DMODEL, DMODEL, 0, 0, p.ph_hi}; pg8::StaticOrder S; S.init(MROWS, DMODEL, G, (int)blockIdx.x);
            if (l == 0) { pg8::EpiRes<false, true> E{inptr(I_XP), inptr(I_XS) - (size_t)M_C * DMODEL, p.ws + WS_XB, modl + 2 * 2048, nullptr, 0};
                pg8::gemm_phase<pg8::EpiRes<false, true>, pg8::StaticOrder, PG8_ALIGN, PG8_SP2>(lds, g, S, E); }
            else { pg8::EpiRes<true, true> E{p.ws + WS_XB, p.ws + WS_XB, p.ws + WS_XB, modl + 2 * 2048, nullptr, 0};
                pg8::gemm_phase<pg8::EpiRes<true, true>, pg8::StaticOrder, PG8_ALIGN, PG8_SP2>(lds, g, S, E); }
        }
        SEAM(pb + 6);
        if (IN(pb + 7) && EN(7)) norm_phase<true>(p, l, 1);
        SEAM(pb + 7);
        if (IN(pb + 8) && EN(8)) for (int rep_ = 0; rep_ < DUP(8); ++rep_) {
            pg8::Gemm g{wsb(p, WS_H), WL + W_FF1_T, MROWS, DFF, DMODEL, 0, 0, p.ph_hi}; pg8::StaticOrder S; S.init(MROWS, DFF, G, (int)blockIdx.x);
            pg8::EpiBf16<2> E{wsb(p, WS_G), DFF, inptr(I_BFF1) + (size_t)l * DFF, 0};
            pg8::gemm_phase<pg8::EpiBf16<2>, pg8::StaticOrder, PG8_ALIGN, PG8_SP2>(lds, g, S, E);
        }
        SEAM(pb + 8);
        if (IN(pb + 9) && EN(9)) {
            pg8::Gemm g{wsb(p, WS_G), WL + W_FF2_T, MROWS, DMODEL, DFF, 0, 0, p.ph_hi}; pg8::StaticOrder S; S.init(MROWS, DMODEL, G, (int)blockIdx.x);
            if (l == DEPTH - 1) { pg8::EpiRes<true, false> E{p.ws + WS_XB, p.ws + WS_XB, p.out, modl + 5 * 2048, inptr(I_BFF2) + (size_t)l * DMODEL, 0};
                pg8::gemm_phase<pg8::EpiRes<true, false>, pg8::StaticOrder, PG8_ALIGN, PG8_SP2>(lds, g, S, E); }
            else { pg8::EpiRes<true, true> E{p.ws + WS_XB, p.ws + WS_XB, p.ws + WS_XB, modl + 5 * 2048, inptr(I_BFF2) + (size_t)l * DMODEL, 0};
                pg8::gemm_phase<pg8::EpiRes<true, true>, pg8::StaticOrder, PG8_ALIGN, PG8_SP2>(lds, g, S, E); }
        }
        SEAM(pb + 9);
    }
#undef IN
#undef SEAM
}

#if DBG
#ifndef CHECK_L
#define CHECK_L 0
#endif
constexpr size_t DBG_ERR = WS_DBG;
constexpr size_t DBG_ZS = WS_DBG + 1 * MiB;
constexpr size_t DBG_XS = WS_DBG + 2 * MiB;
constexpr size_t DBG_XS2 = WS_DBG + 3 * MiB;
constexpr size_t DBG_SC = WS_DBG + 4 * MiB;
constexpr size_t DBG_END = WS_DBG + 16 * MiB;
__device__ __forceinline__ unsigned dh(unsigned x) { x ^= x >> 16; x *= 0x7feb352du; x ^= x >> 15; x *= 0x846ca68bu; x ^= x >> 16; return x; }
__device__ __forceinline__ int srow(int i) {
    switch (i) { case 0: return 0; case 1: return 1; case 2: return 255; case 3: return 256; case 4: return 511; case 5: return 8191; case 6: return 8192; case 7: return 8193; case 8: return 8192 + 127; case 9: return 8192 + 128;
        case 10: return 8192 + 4095; case 11: return 8192 + 4096; case 12: return 8192 + 8191; case 13: return 24575; case 14: return 24575 - 4096; case 15: return 4000; default: break; }
    return (int)(dh(i * 7919u + 13u) % (unsigned)MROWS);
}
__device__ __forceinline__ void rep(const Params& p, int stage, float got, float ref, float atol) {
    float e = fabsf(got - ref) / (fabsf(ref) + atol); if (!(e == e) || !(got == got)) e = 1e6f;
    atomicMax((unsigned*)(p.ws + DBG_ERR) + stage, __float_as_uint(e));
}
__device__ __forceinline__ float f8d(unsigned char b) { const int e = (b >> 3) & 15, m = b & 7; const float v = e ? ldexpf(1.0f + m * 0.125f, e - 7) : ldexpf(m * 0.125f, -6); return (b & 128) ? -v : v; }
__device__ __forceinline__ float bfr(float x) { return __uint_as_float(f2bf(x) << 16); }
__device__ __forceinline__ const float* xrow(const Params& p, int l, int r) { return (r < M_C ? xbase_ctx(p, l) : xbase_lat(p, l)) + (size_t)r * 2048; }
__device__ __forceinline__ int rcond(int r) { return r < M_C ? 0 : 1 + ((r - M_C) >> 12); }

__global__ void ck_prologue(Params p, int l) {
    const int gt = blockIdx.x * blockDim.x + threadIdx.x;
    const bf16* WL = wsb(p, WS_W) + (size_t)l * WL_ELEMS;
    {
        const unsigned h0 = dh(gt * 2654435761u + 1u), h1 = dh(h0 + 77u);
        { const int k = h0 % 2048, n = h1 % 4096; rep(p, 0, bf2f(WL[W_IN_T + (size_t)n * 2048 + k]), bfr(p.in[I_WIN][((size_t)l * 2048 + k) * 4096 + n]), 1e-6f); }
        { const int k = h0 % 2048, n = h1 % 8192; rep(p, 0, f8d(p.ws[WS_W8 + ((size_t)l * 8192 + n) * 2048 + k]) * 0.015625f * 0.5f, p.in[I_WGATE][((size_t)l * 2048 + k) * 8192 + n] * 0.5f, 0.02f); }
        { const int b = h0 & 3, k = (h0 >> 2) % 512, n = h1 % 2048; rep(p, 0, bf2f(WL[W_BR_T + (size_t)n * 2048 + b * 512 + k]), bfr(p.in[I_WBR][(((size_t)l * 4 + b) * 512 + k) * 2048 + n]), 1e-6f); }
        { const int k = h0 % 2048, n = h1 % 2048; rep(p, 0, bf2f(WL[W_O_T + (size_t)n * 2048 + k]), bfr(p.in[I_WO][((size_t)l * 2048 + k) * 2048 + n]), 1e-6f); }
        { const int k = h0 % 2048, n = h1 % 8192; rep(p, 0, bf2f(WL[W_FF1_T + (size_t)n * 2048 + k]), bfr(p.in[I_WFF1][((size_t)l * 2048 + k) * 8192 + n]), 1e-6f); }
        { const int k = h0 % 8192, n = h1 % 2048; rep(p, 0, bf2f(WL[W_FF2_T + (size_t)n * 8192 + k]), bfr(p.in[I_WFF2][((size_t)l * 8192 + k) * 2048 + n]), 1e-6f); }
        { const int bl = h0 & 15, s = (h0 >> 4) % 512, c = h1 % 128;
          rep(p, 2, bf2f(wsb(p, CK_WK)[((size_t)bl * 512 + s) * 128 + c]), bfr(p.in[I_CWK][((size_t)bl * 512 + s) * 128 + c]), 1e-6f);
          rep(p, 2, bf2f(wsb(p, CK_GK)[((size_t)bl * 512 + s) * 128 + c]), bfr(p.in[I_CGK][((size_t)bl * 512 + s) * 128 + c]), 1e-6f);
          rep(p, 2, bf2f(wsb(p, CK_WVT)[((size_t)bl * 128 + c) * 512 + (s ^ ((c & 16) >> 2))]), bfr(p.in[I_CWV][((size_t)bl * 512 + s) * 128 + c]), 1e-6f);
          rep(p, 2, bf2f(wsb(p, CK_GVT)[((size_t)bl * 128 + c) * 512 + (s ^ ((c & 16) >> 2))]), bfr(p.in[I_CGV][((size_t)bl * 512 + s) * 128 + c]), 1e-6f);
          const int c5 = h1 % 512;
          rep(p, 2, bf2f(wsb(p, CK_DK)[((size_t)bl * 512 + s) * 512 + c5]), bfr(p.in[I_CDK][((size_t)bl * 512 + s) * 512 + c5]), 1e-6f);
          rep(p, 2, bf2f(wsb(p, CK_DVT)[((size_t)bl * 512 + c5) * 512 + (s ^ ((c5 & 16) >> 2))]), bfr(p.in[I_CDV][((size_t)bl * 512 + s) * 512 + c5]), 1e-6f);
          const int g = h0 & 1, lkn = (h0 >> 1) & 63, c6 = (h0 >> 8) & 63, d6 = h1 & 63;
          rep(p, 2, bf2f(wsb(p, WS_LRUW)[((size_t)(g * 64 + lkn) * 64 + d6) * 64 + c6]), bfr(p.in[g ? I_LWI : I_LWR][((size_t)lkn * 64 + c6) * 64 + d6]), 1e-6f);
          const int pos = h0 & 63, f = h1 & 15; const float ang = (float)pos * powf(10000.f, -(float)f / 16.f);
          rep(p, 2, wsf(p, WS_TAB)[TAB_COS + pos * 16 + f], cosf(ang), 1e-3f); rep(p, 2, wsf(p, WS_TAB)[TAB_SIN + pos * 16 + f], sinf(ang), 1e-3f); }
    }
    if (gt < 1024) { const int cond = gt % 5, j = dh(gt) % 12288; float s = 0.f;
        for (int k = 0; k < 2048; ++k) { const float c = cond == 0 ? p.in[I_CCTX][k] : p.in[I_C][(cond - 1) * 2048 + k]; s += (c / (1.f + expf(-c))) * p.in[I_WADA][((size_t)l * 2048 + k) * 12288 + j]; }
        rep(p, 1, wsf(p, WS_MOD)[((size_t)l * 5 + cond) * 12288 + j], s + p.in[I_BADA][l * 12288 + j], 1e-2f); }
}
__global__ void ck_norm(Params p, int l, int which, int stage) {
    const int r = srow(blockIdx.x); const float* x = xrow(p, l + which, r); __shared__ float red[256];
    float ss = 0.f; for (int c = threadIdx.x; c < 2048; c += 256) ss += x[c] * x[c];
    red[threadIdx.x] = ss; __syncthreads(); for (int o = 128; o > 0; o >>= 1) { if (threadIdx.x < o) red[threadIdx.x] += red[threadIdx.x + o]; __syncthreads(); }
    const float rstd = 1.f / sqrtf(red[0] / 2048.f + 1e-6f); const float* modl = wsf(p, WS_MOD) + ((size_t)l * 5 + rcond(r)) * 12288 + (which ? 3 : 0) * 2048;
    const float* g = p.in[which ? I_N2G : I_N1G] + l * 2048;
    for (int c = threadIdx.x; c < 2048; c += 256) rep(p, stage, bf2f(wsb(p, WS_H)[(size_t)r * 2048 + c]), x[c] * rstd * g[c] * (1.f + modl[2048 + c]) + modl[c], 0.05f);
}
__global__ void ck_gemm(Params p, int l, int mode, int stage) {
    const int r = srow(blockIdx.x); const bf16* WL = wsb(p, WS_W) + (size_t)l * WL_ELEMS;
    const bf16* A; const bf16* Bt; int N, K;
    if (mode == 0) { A = wsb(p, WS_H); Bt = WL + W_IN_T; N = 4096; K = 2048; } else if (mode == 1) { A = wsb(p, WS_H); Bt = WL + W_GATE_T; N = 8192; K = 2048; }
    else if (mode == 2) { A = wsb(p, WS_H); Bt = WL + W_FF1_T; N = 8192; K = 2048; } else if (mode == 3) { A = wsb(p, WS_H); Bt = WL + W_O_T; N = 2048; K = 2048; }
    else { A = wsb(p, WS_G); Bt = WL + W_FF2_T; N = 2048; K = 8192; }
    const int n = dh(blockIdx.x * 1000u + threadIdx.x * 31u + mode) % N;
    float s = 0.f;
    if (mode == 1) { const unsigned char* a8 = p.ws + WS_H8 + (size_t)r * 2048; const unsigned char* b8 = p.ws + WS_W8 + ((size_t)l * 8192 + n) * 2048; for (int k = 0; k < 2048; ++k) s += f8d(a8[k]) * f8d(b8[k]); s *= 0.015625f; }
    else for (int k = 0; k < K; ++k) s += bf2f(A[(size_t)r * K + k]) * bf2f(Bt[(size_t)n * K + k]);
    const float* modl = wsf(p, WS_MOD) + ((size_t)l * 5 + rcond(r)) * 12288;
    if (mode == 0) rep(p, stage, bf2f(wsb(p, WS_Z)[(size_t)r * 4096 + n]), s, 0.05f);
    if (mode == 1) rep(p, stage, bf2f(wsb(p, WS_G)[(size_t)r * 8192 + n]), 1.f + expf(-(s + p.in[I_BGATE][l * 8192 + n])), 0.05f);
    if (mode == 2) { const float a = fmaxf(s + p.in[I_BFF1][l * 8192 + n], 0.f); rep(p, stage, bf2f(wsb(p, WS_G)[(size_t)r * 8192 + n]), a * a, 0.05f); }
    if (mode == 3) rep(p, stage, p.out[(size_t)r * 2048 + n], wsf(p, DBG_XS)[(size_t)blockIdx.x * 2048 + n] + modl[2 * 2048 + n] * s, 0.05f);
    if (mode == 4) rep(p, stage, p.out[(size_t)r * 2048 + n], wsf(p, DBG_XS2)[(size_t)blockIdx.x * 2048 + n] + modl[5 * 2048 + n] * (s + p.in[I_BFF2][l * 2048 + n]), 0.05f);
}
__global__ void ck_save_z(Params p) { const int r = srow(blockIdx.x); for (int c = threadIdx.x; c < 4096; c += blockDim.x) wsb(p, DBG_ZS)[(size_t)blockIdx.x * 4096 + c] = wsb(p, WS_Z)[(size_t)r * 4096 + c]; }
__global__ void ck_save_x(Params p, int l, size_t dst) { const int r = srow(blockIdx.x); const float* x = xrow(p, l, r); for (int c = threadIdx.x; c < 2048; c += blockDim.x) wsf(p, dst)[(size_t)blockIdx.x * 2048 + c] = x[c]; }
__global__ void ck_prep(Params p, int l, int st) {
    const int r = srow(blockIdx.x); const bf16* zs = wsb(p, DBG_ZS) + (size_t)blockIdx.x * 4096; const bf16* z = wsb(p, WS_Z) + (size_t)r * 4096;
    const bool isctx = r < M_C; const int seq = isctx ? r >> 8 : (r - M_C) >> 12, t = isctx ? r & 255 : (r - M_C) & 4095;
    for (int idx = threadIdx.x; idx < 36 * 64; idx += blockDim.x) {
        const int v = idx >> 6, d = idx & 63;
        int col; const float* gain; bool isq; size_t ko = 0;
        if (v < 8) { col = ZC_QW + v * 64; gain = p.in[I_WQN]; isq = true; } else if (v < 10) { col = ZC_KW + (v - 8) * 64; gain = p.in[I_WKN]; isq = false; ko = O_WK + ((size_t)(seq * 4 + l) * 256 + t) * 128 + (v - 8) * 64; }
        else if (v < 18) { col = ZC_QG + (v - 10) * 64; gain = p.in[I_GQN]; isq = true; } else if (v < 20) { col = ZC_KG + (v - 18) * 64; gain = p.in[I_GKN]; isq = false; ko = O_GK + ((size_t)(seq * 4 + l) * 256 + t) * 128 + (v - 18) * 64; }
        else if (v < 28) { col = ZC_QD + (v - 20) * 64; gain = p.in[I_DQN]; isq = true; } else { col = ZC_KD + (v - 28) * 64; gain = p.in[I_DKN]; isq = false; ko = O_DK + ((size_t)(seq * 4 + l) * 256 + t) * 512 + (v - 28) * 64; }
        float ss = 0.f; for (int e = 0; e < 64; ++e) { const float xe = bf2f(zs[col + e]); ss += xe * xe; }
        const float rstd = 1.f / sqrtf(ss / 64.f + 1e-6f);
        float y = bf2f(zs[col + d]) * rstd * gain[l * 64 + d];
        if (isctx && !isq) rep(p, st + 1, p.out[ko + d], y, 0.02f);
        if (!isctx) { const int axis = d >> 5, half = (d >> 4) & 1, f = d & 15; const float pos = axis ? (float)(t & 63) : (float)(t >> 6); const float ang = pos * powf(10000.f, -(float)f / 16.f), c = cosf(ang), sn = sinf(ang);
            const float x1 = bf2f(zs[col + axis * 32 + f]) * rstd * gain[l * 64 + axis * 32 + f], x2 = bf2f(zs[col + axis * 32 + 16 + f]) * rstd * gain[l * 64 + axis * 32 + 16 + f]; y = half ? x2 * c + x1 * sn : x1 * c - x2 * sn; }
        if (isq) y *= 0.125f * 1.4426950408889634f;
        rep(p, st, bf2f(z[col + d]), y, 0.03f);
    }
    for (int idx = threadIdx.x; idx < 96 * 8; idx += blockDim.x) {
        const int g = idx >> 3, j = idx & 7; int col; size_t vo; const bf16* vt; const int T = isctx ? T_C : T_L;
        if (g < 16) { col = ZC_VW + g * 8; vo = O_WV + ((size_t)(seq * 4 + l) * 256 + t) * 128 + g * 8; vt = wsb(p, isctx ? VT_BC : VT_BL) + (size_t)(seq * 128 + g * 8) * T; }
        else if (g < 32) { col = ZC_VG + (g - 16) * 8; vo = O_GV + ((size_t)(seq * 4 + l) * 256 + t) * 128 + (g - 16) * 8; vt = wsb(p, isctx ? VT_CC : VT_CL) + (size_t)(seq * 128 + (g - 16) * 8) * T; }
        else { col = ZC_VD + (g - 32) * 8; vo = O_DV + ((size_t)(seq * 4 + l) * 256 + t) * 512 + (g - 32) * 8; vt = wsb(p, isctx ? VT_DC : VT_DL) + (size_t)(seq * 512 + (g - 32) * 8) * T; }
        const float zv = bf2f(zs[col + j]); if (isctx) rep(p, st + 1, p.out[vo + j], zv, 1e-3f); rep(p, st + 2, bf2f(vt[(size_t)j * T + (t ^ ((((g < 16 ? g : g < 32 ? g - 16 : g - 32) * 8 + j) & 16) >> 2))]), zv, 1e-6f); rep(p, st + 2, bf2f(z[col + j]), zv, 1e-6f);
    }
}
__global__ void ck_lru(Params p, int l, int stage) {
    const int i = blockIdx.x * blockDim.x + threadIdx.x; if (i >= 48) return;
    const bool lat = i < 16; const int seq = lat ? (i & 3) : (int)(dh(i) % 32u), ch = lat ? (int)(dh(i * 3u + 5u) % 512u) : (int)(dh(i * 5u + 1u) % 512u), n = ch >> 6, cl = ch & 63;
    const int T = lat ? T_L : T_C, row0 = lat ? M_C + seq * T_L : seq * T_C; const bf16* Z = wsb(p, WS_Z); float* HF = wsf(p, DBG_SC) + (size_t)i * 4096;
    for (int dir = 0; dir < 2; ++dir) {
        float h = lat ? p.in[I_SLRU][((size_t)(seq * 4 + l) * 2 + dir) * 512 + ch] : 0.f;
        const float spl = log1pf(expf(-p.in[I_LLAM][(l * 2 + dir) * 512 + ch]));
        for (int s = 0; s < T; ++s) { const int t = dir ? T - 1 - s : s;
            float pr = p.in[I_LBR][(l * 2 + dir) * 512 + ch], pi = p.in[I_LBI][(l * 2 + dir) * 512 + ch], umine = 0.f;
            for (int c = 0; c < 64; ++c) { float u = p.in[I_CONVB][l * 512 + n * 64 + c];
                for (int k = 0; k < 4; ++k) { const int tk = t + k - 1; if (tk >= 0 && tk < T) u += p.in[I_CONVW][(l * 4 + k) * 512 + n * 64 + c] * bf2f(Z[(size_t)(row0 + tk) * 4096 + n * 64 + c]); }
                if (c == cl) umine = u;
                const float ub = bfr(u);
                pr += ub * bfr(p.in[I_LWR][((size_t)((l * 2 + dir) * 8 + n) * 64 + c) * 64 + cl]); pi += ub * bfr(p.in[I_LWI][((size_t)((l * 2 + dir) * 8 + n) * 64 + c) * 64 + cl]); }
            const float rg = 1.f / (1.f + expf(-pr)), ig = 1.f / (1.f + expf(-pi)), la = -8.f * rg * spl, a = expf(la), b = sqrtf(-expm1f(2.f * la)) * ig * umine;
            h = a * h + b;
            if (dir == 0) HF[t] = h;
            else { const float y = bf2f(Z[(size_t)(row0 + t) * 4096 + 512 + ch]); const float gl = 0.5f * y * (1.f + tanhf(0.7978845608028654f * (y + 0.044715f * y * y * y)));
                rep(p, stage, bf2f(wsb(p, WS_BR)[(size_t)(row0 + t) * BRP + ch]), (HF[t] + h) * gl, 0.02f); }
        }
        if (!lat) rep(p, stage + 1, p.out[O_LS + ((size_t)(seq * 4 + l) * 2 + dir) * 512 + ch], h, 0.02f);
    }
}
__global__ void ck_attn(Params p, int l, int stage) {
    const int i = blockIdx.x, lane = threadIdx.x; const unsigned h0 = dh(i * 97u + 3u), h1 = dh(h0 + 11u);
    const int type = i % 3; const bool lat = (i / 3) & 1; const int seq = lat ? (h0 & 3) : (h0 & 31), head = (h0 >> 5) & 7;
    int t = lat ? (int)(h1 % 4096u) : (int)(h1 % 256u); if (i < 12) t = (i & 1) ? (lat ? 4095 : 255) : 0; if (i >= 12 && i < 24 && lat) t = 128 + (i & 1);
    const int T = lat ? T_L : T_C, row0 = lat ? M_C + seq * T_L : seq * T_C, r = row0 + t; const bf16* Z = wsb(p, WS_Z); __shared__ float SC[4608];
    int qcol, kcol, vcol, vw, kvh; const float* ck; const float* cv; int cpitch, ckoff, cvoff;
    if (type == 0) { kvh = head >> 2; qcol = ZC_QW + head * 64; kcol = ZC_KW + kvh * 64; vcol = ZC_VW + kvh * 64; vw = 64; ck = p.in[I_CWK]; cv = p.in[I_CWV]; cpitch = 128; ckoff = kvh * 64; cvoff = kvh * 64; }
    else if (type == 1) { kvh = head >> 2; qcol = ZC_QG + head * 64; kcol = ZC_KG + kvh * 64; vcol = ZC_VG + kvh * 64; vw = 64; ck = p.in[I_CGK]; cv = p.in[I_CGV]; cpitch = 128; ckoff = kvh * 64; cvoff = kvh * 64; }
    else { qcol = ZC_QD + head * 64; kcol = ZC_KD + head * 64; vcol = ZC_VD + (head >> 1) * 128; vw = 128; ck = p.in[I_CDK]; cv = p.in[I_CDV]; cpitch = 512; ckoff = head * 64; cvoff = (head >> 1) * 128; }
    const int nk = lat ? T_L + PAST : T_C; float q[64];
#pragma unroll
    for (int d = 0; d < 64; ++d) q[d] = bf2f(Z[(size_t)r * 4096 + qcol + d]);
    float mx = -1e30f;
    for (int k = lane; k < nk; k += 64) { float s = 0.f; bool ok = true;
        if (k < T) {
#pragma unroll
            for (int d = 0; d < 64; ++d) s += q[d] * bf2f(Z[(size_t)(row0 + k) * 4096 + kcol + d]); if (type == 0 && lat) { int dd = t - k; dd = dd < 0 ? -dd : dd; ok = dd <= 128; } }
        else { const float* kp = ck + ((size_t)(seq * 4 + l) * 512 + (k - T)) * cpitch + ckoff;
#pragma unroll
            for (int d = 0; d < 64; ++d) s += q[d] * kp[d]; }
        s = ok ? s : -INFINITY; SC[k] = s; mx = fmaxf(mx, s); }
    for (int o = 32; o > 0; o >>= 1) mx = fmaxf(mx, __shfl_xor(mx, o));
    float sum = 0.f; for (int k = lane; k < nk; k += 64) { const float e = exp2f(SC[k] - mx); SC[k] = e; sum += e; }
    for (int o = 32; o > 0; o >>= 1) sum += __shfl_xor(sum, o);
    __syncthreads();
    if (type == 0) sum += exp2f(p.in[I_WSINK][l * 8 + head] * 1.4426950408889634f - mx);
    __syncthreads();
    for (int d = lane; d < vw; d += 64) { float o = 0.f;
        for (int k = 0; k < nk; ++k) { const float v = k < T ? bf2f(Z[(size_t)(row0 + k) * 4096 + vcol + d]) : cv[((size_t)(seq * 4 + l) * 512 + (k - T)) * cpitch + cvoff + d]; o += SC[k] * v; }
        o /= sum;
        const float got = type == 0 ? bf2f(wsb(p, WS_BR)[(size_t)r * BRP + 512 + head * 64 + d]) : type == 1 ? bf2f(wsb(p, WS_BR)[(size_t)r * BRP + 1024 + head * 64 + d]) : bf2f(wsb(p, WS_OD)[(size_t)r * 1024 + head * 128 + d]);
        rep(p, stage + type, got, o, 0.02f); }
}
__global__ void ck_dcomb(Params p, int l, int stage) {
    const int r = srow(blockIdx.x), h = threadIdx.x >> 7, e = threadIdx.x & 127; __shared__ float red[512];
    float s1 = 0.f, s2 = 0.f; for (int d = 0; d < 64; ++d) { s1 += p.in[I_LQ1][l * 64 + d] * p.in[I_LK1][l * 64 + d]; s2 += p.in[I_LQ2][l * 64 + d] * p.in[I_LK2][l * 64 + d]; }
    const float li = 0.8f - 0.6f * expf(-0.3f * l), lam = expf(s1) - expf(s2) + li;
    const float o = bf2f(wsb(p, WS_OD)[(size_t)r * 1024 + (h * 2) * 128 + e]) - lam * bf2f(wsb(p, WS_OD)[(size_t)r * 1024 + (h * 2 + 1) * 128 + e]);
    red[threadIdx.x] = o * o; __syncthreads(); for (int st = 64; st > 0; st >>= 1) { if (e < st) red[threadIdx.x] += red[threadIdx.x + st]; __syncthreads(); }
    rep(p, stage, bf2f(wsb(p, WS_BR)[(size_t)r * BRP + 1536 + h * 128 + e]), o / sqrtf(red[h * 128] / 128.f + 1e-6f) * p.in[I_DOG][l * 128 + e] * (1.f - li), 0.02f);
}
__global__ void ck_merge(Params p, int l, int stage) {
    const int r = srow(blockIdx.x), n = dh(blockIdx.x * 777u + threadIdx.x) % 2048; const bf16* WL = wsb(p, WS_W) + (size_t)l * WL_ELEMS; float tot = 0.f;
    for (int b = 0; b < 4; ++b) { float s = 0.f; for (int c = 0; c < 512; ++c) s += bf2f(wsb(p, WS_BR)[(size_t)r * BRP + b * 512 + c]) * bf2f(WL[W_BR_T + (size_t)n * 2048 + b * 512 + c]);
        tot += s / bf2f(wsb(p, WS_G)[(size_t)r * 8192 + b * 2048 + n]); }
    rep(p, stage, bf2f(wsb(p, WS_H)[(size_t)r * 2048 + n]), tot, 0.05f);
}
__global__ void ck_encode(Params p) {
    if (threadIdx.x || blockIdx.x) return; const float* e = wsf(p, DBG_ERR);
    for (int s = 0; s < 64; ++s) if (e[s] > 0.06f) { int q = (int)floorf(log10f(e[s])); q = q < -6 ? -6 : q > 3 ? 3 : q; p.out[0] = (float)(10 + s) * powf(10.f, (float)(12 + q)); return; }
}
static void dbg_run(Params p, int grid, hipStream_t stream) {
    (void)hipMemsetAsync(p.ws + DBG_ERR, 0, 256, stream);
    auto ph = [&](int k) { p.ph_lo = k; p.ph_hi = k + 1; hipLaunchKernelGGL(fwd_kernel, dim3(grid), dim3(512), LDS_BYTES, stream, p); };
    ph(0);
    hipLaunchKernelGGL(ck_prologue, dim3(64), dim3(256), 0, stream, p, CHECK_L);
    for (int l = 0; l < DEPTH; ++l) {
        const int pb = 1 + l * NPL; const bool c = (l == CHECK_L);
        ph(pb + 0); if (c) hipLaunchKernelGGL(ck_norm, dim3(64), dim3(256), 0, stream, p, l, 0, 3);
        ph(pb + 1); if (c) { hipLaunchKernelGGL(ck_gemm, dim3(64), dim3(128), 0, stream, p, l, 0, 4); hipLaunchKernelGGL(ck_gemm, dim3(64), dim3(128), 0, stream, p, l, 1, 5); hipLaunchKernelGGL(ck_save_z, dim3(64), dim3(256), 0, stream, p); }
        ph(pb + 2); if (c) hipLaunchKernelGGL(ck_prep, dim3(64), dim3(256), 0, stream, p, l, 6);
        ph(pb + 3); if (c) { hipLaunchKernelGGL(ck_lru, dim3(1), dim3(64), 0, stream, p, l, 9); hipLaunchKernelGGL(ck_attn, dim3(240), dim3(64), 0, stream, p, l, 11); }
        ph(pb + 4); if (c) hipLaunchKernelGGL(ck_dcomb, dim3(64), dim3(512), 0, stream, p, l, 14);
        ph(pb + 5); if (c) { hipLaunchKernelGGL(ck_merge, dim3(64), dim3(128), 0, stream, p, l, 15); hipLaunchKernelGGL(ck_save_x, dim3(64), dim3(256), 0, stream, p, l, DBG_XS); }
        ph(pb + 6); if (c) { hipLaunchKernelGGL(ck_gemm, dim3(64), dim3(128), 0, stream, p, l, 3, 16); hipLaunchKernelGGL(ck_save_x, dim3(64), dim3(256), 0, stream, p, l + 1, DBG_XS2); }
        ph(pb + 7); if (c) hipLaunchKernelGGL(ck_norm, dim3(64), dim3(256), 0, stream, p, l, 1, 17);
        ph(pb + 8); if (c) hipLaunchKernelGGL(ck_gemm, dim3(64), dim3(128), 0, stream, p, l, 2, 18);
        ph(pb + 9); if (c) hipLaunchKernelGGL(ck_gemm, dim3(64), dim3(128), 0, stream, p, l, 4, 19);
    }
    hipLaunchKernelGGL(ck_encode, dim3(1), dim3(64), 0, stream, p);
}
#endif

extern "C" void kernel_launch(void* const* d_in, const int* in_sizes, int n_in, void* d_out, int out_size, void* d_ws, size_t ws_size, hipStream_t stream) {
    static int grid = 0;
    if (grid == 0) {
        size_t need = WS_END;
#if DBG
        need = DBG_END;
#endif
        if (n_in != N_IN || (size_t)out_size != O_END || ws_size < need) { fprintf(stderr, "kernel_launch: unexpected sizes: n_in %d out %d ws %zu (need %zu); nothing launched\n", n_in, out_size, ws_size, need); grid = -1; return; }
        int dev = 0, cus = 0, per_cu = 0;
        if (hipGetDevice(&dev) != hipSuccess || hipDeviceGetAttribute(&cus, hipDeviceAttributeMultiprocessorCount, dev) != hipSuccess) { grid = -1; return; }
        if (hipFuncSetAttribute((const void*)fwd_kernel, hipFuncAttributeMaxDynamicSharedMemorySize, LDS_BYTES) != hipSuccess) { fprintf(stderr, "kernel_launch: hipFuncSetAttribute failed\n"); grid = -1; return; }
        if (hipOccupancyMaxActiveBlocksPerMultiprocessor(&per_cu, (const void*)fwd_kernel, 512, LDS_BYTES) != hipSuccess || per_cu < 1) { fprintf(stderr, "kernel_launch: occupancy query says %d\n", per_cu); grid = -1; (void)hipGetLastError(); return; }
        grid = cus;
    }
    if (grid < 0) return;
    (void)hipMemsetAsync(d_ws, 0, ZERO_BYTES, stream);
    Params p{};
    for (int i = 0; i < N_IN; ++i) p.in[i] = (const float*)d_in[i];
    p.out = (float*)d_out; p.ws = (unsigned char*)d_ws;
#if DBG
    dbg_run(p, grid, stream);
#else
#if MULTI
    for (int ph = 0; ph < N_PHASES; ++ph) { p.ph_lo = ph; p.ph_hi = ph + 1; hipLaunchKernelGGL(fwd_kernel, dim3(grid), dim3(512), LDS_BYTES, stream, p); }
#else
    p.ph_lo = 0; p.ph_hi = N_PHASES;
    hipLaunchKernelGGL(fwd_kernel, dim3(grid), dim3(512), LDS_BYTES, stream, p);
#endif
#endif
}
```

```cpp
#include <hip/hip_runtime.h>
#include <cstdio>
#include <cstdint>

__device__ __forceinline__ float shfl_xor_l(float v, int o, int lane) { return __int_as_float(__builtin_amdgcn_ds_bpermute((lane ^ o) << 2, __float_as_int(v))); }
__device__ __forceinline__ int opaque_tid(int wv) { unsigned m = ~0u; asm volatile("" : "+s"(m), "+s"(wv));
    int t = (wv << 6) | (int)__builtin_amdgcn_mbcnt_hi(m, __builtin_amdgcn_mbcnt_lo(m, 0u)); asm volatile("" : "+v"(t)); return t; }

__device__ __forceinline__ const float* inptr(int i) {
    const float* const __attribute__((address_space(4)))* ka = (const float* const __attribute__((address_space(4)))*)__builtin_amdgcn_kernarg_segment_ptr();
    asm volatile("" : "+s"(i)); return ka[i]; }

#ifndef MULTI
#define MULTI 0
#endif
#ifndef DBG
#define DBG 0
#endif

namespace pg8 {
#define PG8_LAS __attribute__((address_space(3)))
typedef unsigned short bf16_t;
typedef short bf16x8 __attribute__((ext_vector_type(8)));
typedef float f32x4 __attribute__((ext_vector_type(4)));
typedef unsigned u32x4 __attribute__((ext_vector_type(4)));
constexpr int BM = 256, BK = 64, HALF = 128, HTB = HALF * BK * 2  , STAGE_BYTES = 8 * HTB, NXCD = 8, WGM = 4;

__host__ __device__ __forceinline__ int lds_byte(int r, int c) { const int st = (r >> 4) * 2 + (c >> 5), rr = r & 15, cc = c & 31, ob = rr * 64 + cc * 2; return st * 1024 + (ob ^ (((ob >> 9) & 1) << 5)); }
__host__ __device__ __forceinline__ void stage_rc(int b, int& R, int& C) { const int st = b / 1024, sb = b % 1024, swz = sb ^ (((sb >> 9) & 1) << 5); R = (st >> 1) * 16 + swz / 64; C = (st & 1) * 32 + (swz % 64) / 2; }
__host__ __device__ __forceinline__ int perm64(int R) { return 64 * (R >> 5) + 16 * ((R >> 2) & 3) + 4 * ((R >> 4) & 1) + (R & 3); }
__host__ __device__ __forceinline__ int perm32(int rho) { const int n = rho >> 4, i = rho & 15; return 8 * (i >> 2) + 4 * n + (i & 3); }

struct Unit { int pm, pn, kb; };
struct Gemm { const bf16_t* A; const bf16_t* Bt; int M, N, K; size_t a_kb, b_kb; int wv; };

struct StaticOrder {
    int nM, nN, nwg, G, c;
    __host__ __device__ void init(int M, int N, int G_, int c_) { nM = M / BM; nN = N / BM; nwg = nM * nN; G = G_; c = c_; }
    __host__ __device__ bool next(int i, Unit& u) const {
        const long L = (long)i * G + c; if (L >= nwg) return false;
        int wgid = (int)L; { const int q = nwg / NXCD, r = nwg % NXCD, xcd = wgid % NXCD, off = wgid / NXCD; wgid = (xcd < r ? xcd * (q + 1) : r * (q + 1) + (xcd - r) * q) + off; }
        const int nig = WGM * nN, gid = wgid / nig, fm = gid * WGM, gsz = (nM - fm) < WGM ? (nM - fm) : WGM;
        u.pm = fm + ((wgid % nig) % gsz); u.pn = (wgid % nig) / gsz; u.kb = 0; return true;
    }
    __device__ __forceinline__ void a_ready(const Unit&) const {}
    __device__ __forceinline__ void done(const Unit&) const {}
};
struct BankOrder : StaticOrder {
    __host__ __device__ bool next(int i, Unit& u) const { if (!StaticOrder::next(i >> 2, u)) return false; u.kb = i & 3; return true; }
};

typedef float f32x2_t __attribute__((ext_vector_type(2))); typedef __bf16 bf16x2_t __attribute__((ext_vector_type(2)));
__device__ __forceinline__ unsigned cvt_pk_bf16(float lo, float hi) { f32x2_t v = {lo, hi}; bf16x2_t b = __builtin_convertvector(v, bf16x2_t); return __builtin_bit_cast(unsigned, b); }
__device__ __forceinline__ float bf_lo(unsigned u) { return __uint_as_float(u << 16); }
__device__ __forceinline__ float bf_hi(unsigned u) { return __uint_as_float(u & 0xffff0000u); }
__device__ __forceinline__ float sigmoidf_fast(float x) { return __builtin_amdgcn_rcpf(1.0f + __builtin_amdgcn_exp2f(-1.4426950408889634f * x)); }

template <int ACT, bool F8 = false> struct EpiBf16 {
    static constexpr bool PERM = true, AFTER_DRAIN = false, SEG = false, FP8 = F8;
    bf16_t* O; int ldc; const float* bias; int pm_off;
    __device__ __forceinline__ void operator()(const f32x4 (&acc)[2][2][4][2], const Unit& u, int wr, int wc, int fr, int fq) const {
        const int row0 = (u.pm + pm_off) * BM + wr * 64 + fr; const int col0 = u.pn * BM + wc * 32 + 8 * fq;
        f32x4 bv[2][2];
#pragma unroll
        for (int bj = 0; bj < 2; ++bj)
#pragma unroll
            for (int n = 0; n < 2; ++n) bv[bj][n] = (ACT != 0) ? *(const f32x4*)(bias + col0 + bj * HALF + 4 * n) : (f32x4){0.f, 0.f, 0.f, 0.f};
#pragma unroll
        for (int ai = 0; ai < 2; ++ai)
#pragma unroll
            for (int m = 0; m < 4; ++m) { bf16_t* rowp = O + (size_t)(row0 + ai * HALF + m * 16) * ldc + col0;
#pragma unroll
                for (int bj = 0; bj < 2; ++bj) { f32x4 v0 = (F8 ? acc[ai][bj][m][0] * 0.015625f : acc[ai][bj][m][0]) + bv[bj][0], v1 = (F8 ? acc[ai][bj][m][1] * 0.015625f : acc[ai][bj][m][1]) + bv[bj][1];
                    if (ACT == 1) {
#pragma unroll
                        for (int j = 0; j < 4; ++j) { v0[j] = sigmoidf_fast(v0[j]); v1[j] = sigmoidf_fast(v1[j]); } }
                    if (ACT == 2) {
#pragma unroll
                        for (int j = 0; j < 4; ++j) { const float a = fmaxf(v0[j], 0.f), b = fmaxf(v1[j], 0.f); v0[j] = a * a; v1[j] = b * b; } }
                    if (ACT == 3) {
#pragma unroll
                        for (int j = 0; j < 4; ++j) { v0[j] = 1.0f + __builtin_amdgcn_exp2f(-1.4426950408889634f * v0[j]); v1[j] = 1.0f + __builtin_amdgcn_exp2f(-1.4426950408889634f * v1[j]); } }
                    u32x4 w; w.x = cvt_pk_bf16(v0[0], v0[1]); w.y = cvt_pk_bf16(v0[2], v0[3]); w.z = cvt_pk_bf16(v1[0], v1[1]); w.w = cvt_pk_bf16(v1[2], v1[3]);
                    __builtin_nontemporal_store(w, (u32x4*)(rowp + bj * HALF)); } }
    }
};
struct EpiGateU8 {
    static constexpr int PERM = 2; static constexpr bool AFTER_DRAIN = false, SEG = false, FP8 = true;
    unsigned char* O; const float* bias; int pm_off;
    __device__ __forceinline__ void operator()(const f32x4 (&acc)[2][2][4][2], const Unit& u, int wr, int wc, int fr, int fq) const {
        const int row0 = (u.pm + pm_off) * BM + wr * 64 + fr; const int col0 = u.pn * BM + wc * 64 + 16 * fq;
        f32x4 bv[2][2];
#pragma unroll
        for (int bj = 0; bj < 2; ++bj)
#pragma unroll
            for (int n = 0; n < 2; ++n) bv[bj][n] = *(const f32x4*)(bias + col0 + 8 * bj + 4 * n);
#pragma unroll
        for (int ai = 0; ai < 2; ++ai)
#pragma unroll
            for (int m = 0; m < 4; ++m) { u32x4 w;
#pragma unroll
                for (int bj = 0; bj < 2; ++bj)
#pragma unroll
                    for (int n = 0; n < 2; ++n) { const f32x4 v = acc[ai][bj][m][n] * 0.015625f + bv[bj][n]; unsigned q = 0;
#pragma unroll
                        for (int j = 0; j < 4; ++j) {
                            const float t = __builtin_amdgcn_rcpf(0.00390640259f + __builtin_amdgcn_exp2f(-1.4426950408889634f * v[j] - 7.99994364f));
                            q |= (unsigned)(int)t << (8 * j); }
                        w[2 * bj + n] = q; }
                __builtin_nontemporal_store(w, (u32x4*)(O + (size_t)(row0 + ai * HALF + m * 16) * 8192 + col0)); }
    }
};
template <bool SRC_BF, bool DST_BF> struct EpiRes {
    static constexpr bool PERM = true, AFTER_DRAIN = false, SEG = false, FP8 = false;
    const void* b_ctx; const void* b_lat; void* out; const float* gate  ; const float* bias; int pm_off;
    __device__ __forceinline__ void operator()(const f32x4 (&acc)[2][2][4][2], const Unit& u, int wr, int wc, int fr, int fq) const {
        const int pmg = u.pm + pm_off;
        const int row0 = pmg * BM + wr * 64 + fr, col0 = u.pn * BM + wc * 32 + 8 * fq;
        const int cond = pmg < 32 ? 0 : 1 + ((pmg - 32) >> 4);
        const void* base = pmg < 32 ? b_ctx : b_lat; const float* gp = gate + (size_t)cond * (6 * 2048);
        f32x4 bv[2][2], gv[2][2];
#pragma unroll
        for (int bj = 0; bj < 2; ++bj)
#pragma unroll
            for (int n = 0; n < 2; ++n) { bv[bj][n] = bias ? *(const f32x4*)(bias + col0 + bj * HALF + 4 * n) : (f32x4){0.f, 0.f, 0.f, 0.f}; gv[bj][n] = *(const f32x4*)(gp + col0 + bj * HALF + 4 * n); }
        if constexpr (SRC_BF) {
#pragma unroll
            for (int ai = 0; ai < 2; ++ai) {
                u32x4 xr[4][2];
#pragma unroll
                for (int m = 0; m < 4; ++m)
#pragma unroll
                    for (int bj = 0; bj < 2; ++bj) xr[m][bj] = *(const u32x4*)((const bf16_t*)base + (size_t)(row0 + ai * HALF + m * 16) * 2048 + col0 + bj * HALF);
                asm volatile("" ::: "memory");
#pragma unroll
                for (int m = 0; m < 4; ++m) { const size_t off = (size_t)(row0 + ai * HALF + m * 16) * 2048 + col0;
#pragma unroll
                    for (int bj = 0; bj < 2; ++bj) { const u32x4 r = xr[m][bj];
                        const f32x4 x0 = (f32x4){bf_lo(r.x), bf_hi(r.x), bf_lo(r.y), bf_hi(r.y)}, x1 = (f32x4){bf_lo(r.z), bf_hi(r.z), bf_lo(r.w), bf_hi(r.w)};
                        const f32x4 y0 = x0 + gv[bj][0] * (acc[ai][bj][m][0] + bv[bj][0]), y1 = x1 + gv[bj][1] * (acc[ai][bj][m][1] + bv[bj][1]);
                        if (DST_BF) { u32x4 w; w.x = cvt_pk_bf16(y0[0], y0[1]); w.y = cvt_pk_bf16(y0[2], y0[3]); w.z = cvt_pk_bf16(y1[0], y1[1]); w.w = cvt_pk_bf16(y1[2], y1[3]); *(u32x4*)((bf16_t*)out + off + bj * HALF) = w; }
                        else { float* q = (float*)out + off + bj * HALF; *(f32x4*)q = y0; *(f32x4*)(q + 4) = y1; } } }
                asm volatile("" ::: "memory");
            }
        } else {
#pragma unroll
        for (int ai = 0; ai < 2; ++ai)
#pragma unroll
            for (int m = 0; m < 4; ++m) { const size_t off = (size_t)(row0 + ai * HALF + m * 16) * 2048 + col0;
#pragma unroll
                for (int bj = 0; bj < 2; ++bj) { const float* q0 = (const float*)base + off + bj * HALF; const f32x4 x0 = *(const f32x4*)q0, x1 = *(const f32x4*)(q0 + 4);
                    const f32x4 y0 = x0 + gv[bj][0] * (acc[ai][bj][m][0] + bv[bj][0]), y1 = x1 + gv[bj][1] * (acc[ai][bj][m][1] + bv[bj][1]);
                    if (DST_BF) { u32x4 w; w.x = cvt_pk_bf16(y0[0], y0[1]); w.y = cvt_pk_bf16(y0[2], y0[3]); w.z = cvt_pk_bf16(y1[0], y1[1]); w.w = cvt_pk_bf16(y1[2], y1[3]); *(u32x4*)((bf16_t*)out + off + bj * HALF) = w; }
                    else { float* q = (float*)out + off + bj * HALF; *(f32x4*)q = y0; *(f32x4*)(q + 4) = y1; } }
                if (m & 1) asm volatile("" ::: "memory"); }
        }
    }
};
struct EpiMerge {
    static constexpr int PERM = 2; static constexpr bool AFTER_DRAIN = false, SEG = true, FP8 = false;
    const unsigned char* E; bf16_t* O;
    static __device__ __forceinline__ float ub(unsigned w, int j) { return (float)((w >> (8 * j)) & 0xffu); }
    __device__ __forceinline__ void seg(f32x4 (&acc)[2][2][4][2], const Unit& u, int b, int wr, int wc, int fr, int fq) const {
        const unsigned char* ep = E + (size_t)(u.pm * BM + wr * 64 + fr) * 8192 + b * 2048 + u.pn * BM + wc * 64 + 16 * fq;
#pragma unroll
        for (int ai = 0; ai < 2; ++ai) {
            u32x4 e0[4], e1[4];
#pragma unroll
            for (int m = 0; m < 4; ++m) { const unsigned char* q = ep + (size_t)(ai * HALF + m * 16) * 8192; e0[m] = *(const u32x4*)q; e1[m] = *(const u32x4*)(q + 2048); }
#pragma unroll
            for (int m = 0; m < 4; ++m)
#pragma unroll
                for (int bj = 0; bj < 2; ++bj)
#pragma unroll
                    for (int n = 0; n < 2; ++n)
#pragma unroll
                        for (int j = 0; j < 4; ++j) acc[ai][bj][m][n][j] *= (ub(e0[m][2 * bj + n], j) + 0.5f) * __builtin_amdgcn_rcpf(ub(e1[m][2 * bj + n], j) + 0.5f);
            asm volatile("" ::: "memory");
        }
    }
    __device__ __forceinline__ void operator()(const f32x4 (&acc)[2][2][4][2], const Unit& u, int wr, int wc, int fr, int fq) const {
        const int row0 = u.pm * BM + wr * 64 + fr; const int col0 = u.pn * BM + wc * 64 + 16 * fq;
        u32x4 gr[2][4];
#pragma unroll
        for (int ai = 0; ai < 2; ++ai)
#pragma unroll
            for (int m = 0; m < 4; ++m) gr[ai][m] = *(const u32x4*)(E + (size_t)(row0 + ai * HALF + m * 16) * 8192 + 3 * 2048 + col0);
        asm volatile("" ::: "memory");
#pragma unroll
        for (int ai = 0; ai < 2; ++ai)
#pragma unroll
            for (int m = 0; m < 4; ++m) { const size_t row = (size_t)(row0 + ai * HALF + m * 16);
                const u32x4 g = gr[ai][m];
#pragma unroll
                for (int bj = 0; bj < 2; ++bj) { f32x4 v0 = acc[ai][bj][m][0], v1 = acc[ai][bj][m][1];
#pragma unroll
                    for (int j = 0; j < 4; ++j) { v0[j] *= ub(g[2 * bj], j) * 0.00390640259f + 0.001953201295f; v1[j] *= ub(g[2 * bj + 1], j) * 0.00390640259f + 0.001953201295f; }
                    u32x4 w; w.x = cvt_pk_bf16(v0[0], v0[1]); w.y = cvt_pk_bf16(v0[2], v0[3]); w.z = cvt_pk_bf16(v1[0], v1[1]); w.w = cvt_pk_bf16(v1[2], v1[3]);
                    *(u32x4*)(O + row * 2048 + col0 + 8 * bj) = w; } }
    }
};

template <class Epi, class Sched, bool ALIGN_EPI = false, bool SP2 = false>
__device__ __forceinline__ void gemm_phase(PG8_LAS unsigned char* lds, const Gemm g, const Sched& S, const Epi& E) {
    typedef int v4i_t __attribute__((ext_vector_type(4))); typedef int v8i_t __attribute__((ext_vector_type(8)));
    int sc8_ = 0x7F7F7F7F; asm volatile("" : "+v"(sc8_));
    int tid_ = opaque_tid(g.wv);
    const int tid = tid_, wid = __builtin_amdgcn_readfirstlane(tid >> 6), lane = tid & 63, wr = wid >> 2, wc = wid & 3, fr = lane & 15, fq = lane >> 4;
    const int K = g.K, nt = K / BK;
    unsigned voffA[2], voffB[2];
#pragma unroll
    for (int i = 0; i < 2; ++i) { int R, C; stage_rc(tid * 16 + i * 8192, R, C); const int Rb = Epi::PERM == 2 ? perm64(R) : Epi::PERM ? ((R & ~31) + perm32(R & 31)) : R;
        voffA[i] = (unsigned)(R * K + C) * 2u; voffB[i] = (unsigned)(Rb * K + C) * 2u; }
    const size_t kstep = (size_t)(BK * 2);
    const size_t hstep = (size_t)HALF * K * 2;
    const size_t hstepB = Epi::PERM == 2 ? (size_t)(8 * K * 2) : hstep;
    const size_t tstep = 2 * hstep;
    const unsigned ldsw = (unsigned)wid * 1024u; const unsigned ldsbase = (unsigned)__builtin_amdgcn_readfirstlane((int)((unsigned)(unsigned long long)(lds) + (unsigned)wid * 1024u));
    const int aoff = lds_byte(wr * 64 + fr, fq * 8), boff = lds_byte(wc * 32 + fr, fq * 8);
#define PG8_SA(b, h) (((b) * 2 + (h)) * HTB)
#define PG8_SB(b, h) ((4 + (b) * 2 + (h)) * HTB)
#define PG8_STAGE(bufoff, gbase, voff) do { _Pragma("unroll") for (int _i = 0; _i < 2; ++_i) { unsigned keep_; \
        asm volatile("s_mov_b32 %0, m0\n\ts_mov_b32 m0, %3\n\ts_nop 0\n\tglobal_load_lds_dwordx4 %1, %2\n\ts_mov_b32 m0, %0" : "=&s"(keep_) : "v"((voff)[_i]), "s"((const char*)(gbase)), "s"(ldsbase + (unsigned)((bufoff) + _i * 8192)) : "memory"); } } while (0)
#define PG8_LDA(dst, b, h) do { _Pragma("unroll") for (int m = 0; m < 4; ++m) _Pragma("unroll") for (int k = 0; k < 2; ++k) dst[m][k] = *(const PG8_LAS bf16x8*)(lds + PG8_SA(b, h) + aoff + m * 2048 + k * 1024); } while (0)
#define PG8_LDB(dst, b, h) do { _Pragma("unroll") for (int n = 0; n < 2; ++n) _Pragma("unroll") for (int k = 0; k < 2; ++k) dst[n][k] = *(const PG8_LAS bf16x8*)(lds + PG8_SB(b, h) + boff + n * 2048 + k * 1024); } while (0)
#define PG8_CAT8(x0, x1) __builtin_shufflevector(__builtin_bit_cast(v4i_t, x0), __builtin_bit_cast(v4i_t, x1), 0, 1, 2, 3, 4, 5, 6, 7)
#define PG8_MMA(ai, bj, At, Bt) do { __builtin_amdgcn_s_setprio(1); \
        if constexpr (Epi::FP8) { _Pragma("unroll") for (int m = 0; m < 4; ++m) _Pragma("unroll") for (int n = 0; n < 2; ++n) { \
            const v8i_t b8_ = PG8_CAT8(Bt[n][0], Bt[n][1]), a8_ = PG8_CAT8(At[m][0], At[m][1]); \
              \
            asm volatile("v_mfma_scale_f32_16x16x128_f8f6f4 %0, %1, %2, %0, %3, %3 op_sel_hi:[0,0,0]" : "+v"(acc[ai][bj][m][n]) : "v"(b8_), "v"(a8_), "v"(sc8_)); } } \
        else { _Pragma("unroll") for (int m = 0; m < 4; ++m) _Pragma("unroll") for (int n = 0; n < 2; ++n) _Pragma("unroll") for (int k = 0; k < 2; ++k) \
            acc[ai][bj][m][n] = __builtin_amdgcn_mfma_f32_16x16x32_bf16(Bt[n][k], At[m][k], acc[ai][bj][m][n], 0, 0, 0); } \
        __builtin_amdgcn_s_setprio(0); } while (0)
#define PG8_WAIT_V(n) asm volatile("s_waitcnt vmcnt(" #n ")" ::: "memory")
#define PG8_WAIT_L(n) asm volatile("s_waitcnt lgkmcnt(" #n ")" ::: "memory")
#define PG8_BAR __builtin_amdgcn_s_barrier()
#define PG8_SCHED __builtin_amdgcn_sched_barrier(0)
    float zacc_ = 0.f; asm volatile("" : "+v"(zacc_));
    Unit cur, nxt; int ui = 0;
    if (!S.next(0, cur)) return;
    f32x4 acc[2][2][4][2];
#pragma unroll
    for (int a = 0; a < 2; ++a)
#pragma unroll
        for (int b = 0; b < 2; ++b)
#pragma unroll
            for (int m = 0; m < 4; ++m)
#pragma unroll
                for (int n = 0; n < 2; ++n) acc[a][b][m][n] = (f32x4){zacc_, zacc_, zacc_, zacc_};
    bf16x8 At[4][2], B0[2][2], B1[2][2];
    const char* cA = (const char*)g.A + (size_t)cur.kb * g.a_kb + (size_t)cur.pm * tstep; const char* cB = (const char*)g.Bt + (size_t)cur.kb * g.b_kb + (size_t)cur.pn * tstep;
    S.a_ready(cur);
    if constexpr (SP2) {
        PG8_STAGE(PG8_SB(0, 0), cB, voffB); PG8_STAGE(PG8_SB(0, 1), cB + hstepB, voffB); PG8_STAGE(PG8_SA(0, 0), cA, voffA); PG8_STAGE(PG8_SA(0, 1), cA + hstep, voffA);
        if (wr == 1) PG8_BAR;
        PG8_WAIT_V(2); PG8_BAR;
        PG8_STAGE(PG8_SB(1, 0), cB + kstep, voffB); PG8_STAGE(PG8_SA(1, 0), cA + kstep, voffA); PG8_STAGE(PG8_SB(1, 1), cB + hstepB + kstep, voffB);
        PG8_WAIT_V(6); PG8_BAR;
    } else {
        PG8_STAGE(PG8_SB(0, 0), cB, voffB); PG8_STAGE(PG8_SA(0, 0), cA, voffA); PG8_STAGE(PG8_SB(0, 1), cB + hstepB, voffB); PG8_STAGE(PG8_SA(0, 1), cA + hstep, voffA);
        if (wr == 1) PG8_BAR;
        PG8_WAIT_V(4); PG8_BAR;
        PG8_STAGE(PG8_SB(1, 0), cB + kstep, voffB); PG8_STAGE(PG8_SA(1, 0), cA + kstep, voffA); PG8_STAGE(PG8_SB(1, 1), cB + hstepB + kstep, voffB);
        PG8_WAIT_V(6); PG8_BAR;
    }
    for (;;) {
        const bool has_next = S.next(ui + 1, nxt);
        const char* nA = has_next ? (const char*)g.A + (size_t)nxt.kb * g.a_kb + (size_t)nxt.pm * tstep : cA; const char* nB = has_next ? (const char*)g.Bt + (size_t)nxt.kb * g.b_kb + (size_t)nxt.pn * tstep : cB;
        for (int t = 0; t < nt; t += 2) {
            const bool last = (t == nt - 2);
            const char* a1 = cA + (size_t)(t + 1) * kstep;
            const char* a2 = last ? nA : cA + (size_t)(t + 2) * kstep; const char* b2 = last ? nB : cB + (size_t)(t + 2) * kstep;
            const char* a3 = a2 + kstep; const char* b3 = b2 + kstep;
            if (last && has_next) S.a_ready(nxt);
            if constexpr (SP2) {
            PG8_LDB(B0, 0, 0); PG8_LDB(B1, 0, 1); PG8_SCHED; PG8_LDA(At, 0, 0); PG8_STAGE(PG8_SA(1, 1), a1 + hstep, voffA);
            PG8_WAIT_V(8); PG8_WAIT_L(0); PG8_BAR; PG8_MMA(0, 0, At, B0); PG8_MMA(0, 1, At, B1); PG8_BAR; PG8_SCHED;
            PG8_LDA(At, 0, 1); PG8_STAGE(PG8_SB(0, 0), b2, voffB); PG8_STAGE(PG8_SB(0, 1), b2 + hstepB, voffB); PG8_STAGE(PG8_SA(0, 0), a2, voffA);
            PG8_WAIT_V(8); PG8_WAIT_L(0); PG8_BAR; PG8_MMA(1, 0, At, B0); PG8_MMA(1, 1, At, B1); PG8_BAR; PG8_SCHED;
            PG8_LDB(B0, 1, 0); PG8_LDB(B1, 1, 1); PG8_SCHED; PG8_LDA(At, 1, 0); PG8_STAGE(PG8_SA(0, 1), a2 + hstep, voffA);
            PG8_WAIT_V(8); PG8_WAIT_L(0); PG8_BAR; PG8_MMA(0, 0, At, B0); PG8_MMA(0, 1, At, B1); PG8_BAR; PG8_SCHED;
            PG8_LDA(At, 1, 1); PG8_STAGE(PG8_SB(1, 0), b3, voffB); PG8_STAGE(PG8_SB(1, 1), b3 + hstepB, voffB); PG8_STAGE(PG8_SA(1, 0), a3, voffA);
            PG8_WAIT_V(8); PG8_WAIT_L(0); PG8_BAR; PG8_MMA(1, 0, At, B0); PG8_MMA(1, 1, At, B1); PG8_BAR; PG8_SCHED;
            if constexpr (Epi::SEG) { if (((t + 2) & 7) == 0 && !last) { E.seg(acc, cur, ((t + 2) >> 3) - 1, wr, wc, fr, fq); PG8_SCHED; } }
            } else {
            PG8_LDB(B0, 0, 0); PG8_SCHED; PG8_LDA(At, 0, 0); PG8_STAGE(PG8_SA(1, 1), a1 + hstep, voffA);
            PG8_WAIT_L(8); PG8_BAR; PG8_WAIT_L(0); PG8_MMA(0, 0, At, B0); PG8_BAR; PG8_SCHED;
            PG8_LDB(B1, 0, 1); PG8_STAGE(PG8_SB(0, 0), b2, voffB);
            PG8_BAR; PG8_WAIT_L(0); PG8_MMA(0, 1, At, B1); PG8_BAR;
            PG8_LDA(At, 0, 1); PG8_STAGE(PG8_SA(0, 0), a2, voffA);
            PG8_BAR; PG8_WAIT_L(0); PG8_MMA(1, 0, At, B0); PG8_BAR; PG8_SCHED;
            PG8_STAGE(PG8_SB(0, 1), b2 + hstepB, voffB);
            PG8_WAIT_V(6); PG8_BAR; PG8_MMA(1, 1, At, B1); PG8_BAR;
            PG8_LDB(B0, 1, 0); PG8_SCHED; PG8_LDA(At, 1, 0); PG8_STAGE(PG8_SA(0, 1), a2 + hstep, voffA);
            PG8_WAIT_L(8); PG8_BAR; PG8_WAIT_L(0); PG8_MMA(0, 0, At, B0); PG8_BAR; PG8_SCHED;
            PG8_LDB(B1, 1, 1); PG8_STAGE(PG8_SB(1, 0), b3, voffB);
            PG8_BAR; PG8_WAIT_L(0); PG8_MMA(0, 1, At, B1); PG8_BAR;
            PG8_LDA(At, 1, 1); PG8_STAGE(PG8_SA(1, 0), a3, voffA);
            PG8_BAR; PG8_WAIT_L(0); PG8_MMA(1, 0, At, B0); PG8_BAR; PG8_SCHED;
            PG8_STAGE(PG8_SB(1, 1), b3 + hstepB, voffB);
            PG8_WAIT_V(6); PG8_BAR; PG8_MMA(1, 1, At, B1); PG8_BAR;
            }
        }
        if constexpr (ALIGN_EPI) { if (wr == 0) PG8_BAR; }
        if constexpr (Epi::FP8) asm volatile("s_nop 15\n\ts_nop 7" ::: "memory");
        if constexpr (!Epi::AFTER_DRAIN) { E(acc, cur, wr, wc, fr, fq); S.done(cur); }
        if (!has_next) break;
#pragma unroll
        for (int a = 0; a < 2; ++a)
#pragma unroll
            for (int b = 0; b < 2; ++b)
#pragma unroll
                for (int m = 0; m < 4; ++m)
#pragma unroll
                    for (int n = 0; n < 2; ++n) acc[a][b][m][n] = (f32x4){zacc_, zacc_, zacc_, zacc_};
        cur = nxt; cA = nA; cB = nB; ++ui;
        if constexpr (ALIGN_EPI) { if (wr == 1) PG8_BAR; }
    }
    PG8_WAIT_V(0);
    if constexpr (!ALIGN_EPI) { if (wr == 0) PG8_BAR; }
    PG8_BAR;
    if constexpr (Epi::AFTER_DRAIN) { E.fused(acc, cur, wr, wc, fr, fq, lds, wid, lane); S.done(cur); }
#undef PG8_SA
#undef PG8_SB
#undef PG8_STAGE
#undef PG8_LDA
#undef PG8_LDB
#undef PG8_MMA
#undef PG8_CAT8
#undef PG8_WAIT_V
#undef PG8_WAIT_L
#undef PG8_BAR
#undef PG8_SCHED
}
}

constexpr int DMODEL = 2048, DEPTH = 4, NSEQ_C = 32, T_C = 256, NSEQ_L = 4, T_L = 4096, PAST = 512;
constexpr int M_C = NSEQ_C * T_C, M_L = NSEQ_L * T_L, MROWS = M_C + M_L;
constexpr int DIN = 4096, DFF = 8192, BRW = 512, BRP = 2048;
constexpr int ZC_XA = 0, ZC_YA = 512, ZC_QW = 1024, ZC_KW = 1536, ZC_VW = 1664, ZC_QG = 1792, ZC_KG = 2304, ZC_VG = 2432, ZC_QD = 2560, ZC_KD = 3072, ZC_VD = 3584;
enum { I_XP = 0, I_XS, I_CWK, I_CWV, I_CGK, I_CGV, I_CDK, I_CDV, I_SLRU, I_C, I_CCTX, I_WADA, I_BADA, I_N1G, I_N2G, I_WIN, I_CONVW, I_CONVB, I_LWR, I_LBR, I_LWI, I_LBI, I_LLAM,
       I_WQN, I_WKN, I_WSINK, I_GQN, I_GKN, I_DQN, I_DKN, I_LQ1, I_LK1, I_LQ2, I_LK2, I_DOG, I_WBR, I_WGATE, I_BGATE, I_WO, I_WFF1, I_BFF1, I_WFF2, I_BFF2, N_IN };
static_assert(N_IN == 43, "input count");
constexpr size_t O_YP = 0, O_YS = 16777216, O_WK = 50331648, O_WV = 54525952, O_GK = 58720256, O_GV = 62914560, O_DK = 67108864, O_DV = 83886080, O_LS = 100663296, O_END = 100794368;
constexpr float RMS_EPS = 1e-6f;
constexpr float QSCALE = 0.125f * 1.4426950408889634f;

constexpr size_t MiB = 1u << 20;
constexpr size_t WS_CTL = 0;
constexpr size_t WS_MOD = 1 * MiB;
constexpr size_t ZERO_BYTES = 64 * 1024;
constexpr size_t WS_TAB = 2 * MiB;
constexpr int TAB_COS = 0, TAB_SIN = 1024, TAB_SPL = 2048, TAB_LAMD = 2048 + 4096, TAB_LAMI = TAB_LAMD + 4;
constexpr size_t WS_LRUW = 3 * MiB;
constexpr size_t WS_SUM = 4 * MiB;
constexpr size_t WS_CK = 5 * MiB;
constexpr size_t CK_WK = WS_CK, CK_WVT = CK_WK + 2 * MiB, CK_GK = CK_WVT + 2 * MiB, CK_GVT = CK_GK + 2 * MiB, CK_DK = CK_GVT + 2 * MiB, CK_DVT = CK_DK + 8 * MiB;
constexpr size_t WS_VT = 29 * MiB;
constexpr size_t VT_BL = WS_VT, VT_CL = VT_BL + 4 * MiB, VT_DL = VT_CL + 4 * MiB, VT_BC = VT_DL + 16 * MiB, VT_CC = VT_BC + 2 * MiB, VT_DC = VT_CC + 2 * MiB;
constexpr size_t WS_W = 65 * MiB;
constexpr size_t WL_ELEMS = 67108864;
constexpr size_t W_IN_T = 0, W_GATE_T = 8388608, W_BR_T = 25165824, W_O_T = 29360128, W_FF1_T = 33554432, W_FF2_T = 50331648;
constexpr size_t WS_H = 577 * MiB;
constexpr size_t WS_Z = 673 * MiB;
constexpr size_t WS_G = 865 * MiB;
constexpr size_t WS_BR = 1249 * MiB;
constexpr size_t WS_OD = 1345 * MiB;
constexpr size_t WS_W8 = 1393 * MiB;
constexpr size_t WS_H8 = 1457 * MiB;
constexpr size_t WS_LAB = WS_G + 192 * MiB;
constexpr size_t WS_XB = 1505 * MiB;
constexpr size_t WS_END = 1601 * MiB;
constexpr size_t WS_DBG = WS_END;

constexpr int RING_BYTES = 131072, LDSCTL_OFF = RING_BYTES, LDS_BYTES = 147456;

#define GAS __attribute__((address_space(1)))
#define LAS __attribute__((address_space(3)))
typedef unsigned short bf16;
typedef unsigned v4u __attribute__((ext_vector_type(4)));
typedef unsigned v2u __attribute__((ext_vector_type(2)));
typedef float f32x4 __attribute__((ext_vector_type(4)));
typedef float f32x16 __attribute__((ext_vector_type(16)));
typedef short bf16x8 __attribute__((ext_vector_type(8)));
__device__ __forceinline__ unsigned f2bf(float f) { unsigned u = __builtin_bit_cast(unsigned, f); return (u + 0x7fffu + ((u >> 16) & 1u)) >> 16; }
__device__ __forceinline__ unsigned pk2(float lo, float hi) { return f2bf(lo) | (f2bf(hi) << 16); }
__device__ __forceinline__ float bflo(unsigned u) { return __uint_as_float(u << 16); }
__device__ __forceinline__ float bfhi(unsigned u) { return __uint_as_float(u & 0xffff0000u); }
__device__ __forceinline__ float bf2f(bf16 b) { return __uint_as_float(((unsigned)b) << 16); }
__device__ __forceinline__ void unpack8(const v4u r, float (&x)[8]) { x[0] = bflo(r.x); x[1] = bfhi(r.x); x[2] = bflo(r.y); x[3] = bfhi(r.y); x[4] = bflo(r.z); x[5] = bfhi(r.z); x[6] = bflo(r.w); x[7] = bfhi(r.w); }
__device__ __forceinline__ v4u pack8(const float (&x)[8]) { v4u r; r.x = pk2(x[0], x[1]); r.y = pk2(x[2], x[3]); r.z = pk2(x[4], x[5]); r.w = pk2(x[6], x[7]); return r; }
__device__ __forceinline__ int crow(int r, int hi) { return (r & 3) + 8 * (r >> 2) + 4 * hi; }

#define XB_TMO      128
#define XB_XCNT(j)  (256  + 64 * (j))
#define XB_XSUB(j)  (1280 + 64 * (j))
#define XB_XGEN(j)  (2304 + 64 * (j))
#define XB_TOP      3328
#define XB_TOPGEN   3392
#define XCD_BAR_WORDS 3456
#define XB_SPIN_CAP (1u << 18)

__device__ __forceinline__ unsigned xb_ld(unsigned* p)              { return __hip_atomic_load(p, __ATOMIC_RELAXED, __HIP_MEMORY_SCOPE_AGENT); }
__device__ __forceinline__ unsigned xb_add(unsigned* p, unsigned v) { return __hip_atomic_fetch_add(p, v, __ATOMIC_RELAXED, __HIP_MEMORY_SCOPE_AGENT); }
__device__ __forceinline__ unsigned xb_xcc_id() { return (unsigned)__builtin_amdgcn_s_getreg((3 << 11) | 20) & 0xFu; }
#define XB_SPIN(cond, bar) do { unsigned _sp = 0; while (cond) { __builtin_amdgcn_s_sleep(1); \
    if ((++_sp & 255u) == 0u) { if (xb_ld(&(bar)[XB_TMO])) break; if (_sp > XB_SPIN_CAP) { atomicAdd(&(bar)[XB_TMO], 1u); break; } } } } while (0)

struct XcdBarrier {
    unsigned* bar; unsigned x; int wv;
    volatile LAS unsigned* st;
};
__device__ __forceinline__ XcdBarrier xcd_barrier_post(unsigned* bar, volatile LAS unsigned* st, int wv) {
    XcdBarrier b; b.bar = bar; b.x = xb_xcc_id(); b.st = st; b.wv = wv;
    if (opaque_tid(wv) == 0) (void)xb_add(&bar[XB_XCNT(b.x)], 1u);
    return b;
}
__device__ __forceinline__ void xcd_barrier_complete(unsigned* bar, unsigned x, unsigned& nloc, unsigned& nx) {
    const unsigned G = gridDim.x * gridDim.y * gridDim.z;
    unsigned sum, cnt, mine, sp = 0u;
    for (;;) {
        sum = 0u; cnt = 0u; mine = 0u;
#pragma unroll
        for (unsigned j = 0; j < 16; ++j) { const unsigned c = xb_ld(&bar[XB_XCNT(j)]); sum += c; cnt += (c > 0u) ? 1u : 0u; mine = (j == x) ? c : mine; }
        if (sum == G) break;
        __builtin_amdgcn_s_sleep(1);
        if ((++sp & 255u) == 0u) { if (xb_ld(&bar[XB_TMO])) break; if (sp > XB_SPIN_CAP) { atomicAdd(&bar[XB_TMO], 1u); break; } }
    }
    nloc = mine > 0u ? mine : 1u; nx = cnt > 0u ? cnt : 1u;
}
__device__ __forceinline__ void xcd_barrier(const XcdBarrier& b) {
    asm volatile("s_waitcnt vmcnt(0)" ::: "memory");
    __syncthreads();
    if (opaque_tid(b.wv) == 0) {
        unsigned* bar = b.bar;
        __builtin_amdgcn_s_waitcnt(0);
        unsigned nloc = b.st[0], nx = b.st[1];
        if (nloc == 0u) { xcd_barrier_complete(bar, b.x, nloc, nx); b.st[0] = nloc; b.st[1] = nx; }
        const unsigned old = xb_add(&bar[XB_XSUB(b.x)], 1u);
        const unsigned gen = old / nloc;
        if (old + 1u == (gen + 1u) * nloc) {
            __builtin_amdgcn_fence(__ATOMIC_RELEASE, "agent");
            asm volatile("s_waitcnt vmcnt(0)" ::: "memory");
            const unsigned og = xb_add(&bar[XB_TOP], 1u);
            const unsigned tg = og / nx;
            if (og + 1u == (tg + 1u) * nx) xb_add(&bar[XB_TOPGEN], 1u);
            else XB_SPIN(xb_ld(&bar[XB_TOPGEN]) == tg, bar);
            __builtin_amdgcn_fence(__ATOMIC_ACQUIRE, "agent");
            xb_add(&bar[XB_XGEN(b.x)], 1u);
            asm volatile("s_waitcnt vmcnt(0)" ::: "memory");
        } else {
            XB_SPIN(xb_ld(&bar[XB_XGEN(b.x)]) == gen, bar);
            __builtin_amdgcn_fence(__ATOMIC_ACQUIRE, "agent");
            asm volatile("s_waitcnt vmcnt(0)" ::: "memory");
        }
    }
    __syncthreads();
}

struct Params { const float* in[N_IN]; float* out; unsigned char* ws; int ph_lo, ph_hi; };
static_assert(sizeof(Params) == (N_IN + 2) * 8 + 8, "Params has no padding");

__device__ __forceinline__ unsigned char* wsbase(const Params& p) { unsigned long long w = (unsigned long long)p.ws; asm volatile("" : "+s"(w)); return (unsigned char*)w; }
__device__ __forceinline__ bf16* wsb(const Params& p, size_t off) { return (bf16*)(wsbase(p) + off); }
__device__ __forceinline__ float* wsf(const Params& p, size_t off) { return (float*)(wsbase(p) + off); }
__device__ __forceinline__ const float* xbase_ctx(const Params& p, int l) { return l == 0 ? inptr(I_XP) : p.out; }
__device__ __forceinline__ const float* xbase_lat(const Params& p, int l) { return l == 0 ? inptr(I_XS) - (size_t)M_C * DMODEL : p.out; }
__device__ __forceinline__ float wave_sum(float v, int lane) {
#pragma unroll
    for (int o = 1; o < 64; o <<= 1) v += shfl_xor_l(v, o, lane);
    return v;
}

__device__ __forceinline__ void transpose_item(const float* W, int K, int N, bf16* WT, LAS float* scr, int item, int lane, bool vswap = false) {
    const int nblk = N / 32, kb = item / nblk, nb = item % nblk, k0 = 64 * kb, n0 = 32 * nb;
#pragma unroll 8
    for (int i = 0; i < 32; ++i) { const int kk = 2 * i + (lane >> 5); scr[kk * 33 + (lane & 31)] = W[(size_t)(k0 + kk) * N + n0 + (lane & 31)]; }
    asm volatile("s_waitcnt lgkmcnt(0)" ::: "memory");
    const int c = lane & 7;
#pragma unroll
    for (int j = 0; j < 4; ++j) { const int n = (lane >> 3) + 8 * j; const LAS float* s = scr + (8 * c) * 33 + n;
        v4u o; o.x = pk2(s[0 * 33], s[1 * 33]); o.y = pk2(s[2 * 33], s[3 * 33]); o.z = pk2(s[4 * 33], s[5 * 33]); o.w = pk2(s[6 * 33], s[7 * 33]);
        if (vswap) { const LAS float* s2 = scr + (16 * (c >> 1) + 4 * (c & 1)) * 33 + n;
            o.x = pk2(s2[0 * 33], s2[1 * 33]); o.y = pk2(s2[2 * 33], s2[3 * 33]); o.z = pk2(s2[8 * 33], s2[9 * 33]); o.w = pk2(s2[10 * 33], s2[11 * 33]); }
        *(v4u*)(WT + (size_t)(n0 + n) * K + k0 + 8 * c) = o; }
    asm volatile("s_waitcnt lgkmcnt(0)" ::: "memory");
}
__device__ __forceinline__ void transpose_item8(const float* W, int K, int N, unsigned char* WT, LAS float* scr, int item, int lane) {
    const int nblk = N / 32, kb = item / nblk, nb = item % nblk, k0 = 64 * kb, n0 = 32 * nb;
#pragma unroll 8
    for (int i = 0; i < 32; ++i) { const int kk = 2 * i + (lane >> 5); scr[kk * 33 + (lane & 31)] = W[(size_t)(k0 + kk) * N + n0 + (lane & 31)]; }
    asm volatile("s_waitcnt lgkmcnt(0)" ::: "memory");
    const int c = lane & 7;
#pragma unroll
    for (int j = 0; j < 4; ++j) { const int n = (lane >> 3) + 8 * j; const LAS float* s = scr + (8 * c) * 33 + n;
        int lo = 0, hi = 0;
        lo = __builtin_amdgcn_cvt_pk_fp8_f32(s[0 * 33] * 64.f, s[1 * 33] * 64.f, lo, false); lo = __builtin_amdgcn_cvt_pk_fp8_f32(s[2 * 33] * 64.f, s[3 * 33] * 64.f, lo, true);
        hi = __builtin_amdgcn_cvt_pk_fp8_f32(s[4 * 33] * 64.f, s[5 * 33] * 64.f, hi, false); hi = __builtin_amdgcn_cvt_pk_fp8_f32(s[6 * 33] * 64.f, s[7 * 33] * 64.f, hi, true);
        *(v2u*)(WT + (size_t)(n0 + n) * K + k0 + 8 * c) = (v2u){(unsigned)lo, (unsigned)hi}; }
    asm volatile("s_waitcnt lgkmcnt(0)" ::: "memory");
}
constexpr int N_TR_W = 131072, N_TR_ALL = N_TR_W + 512 + 512 + 2048 + 256;
__device__ __forceinline__ void prologue_phase(const Params& p, LAS unsigned char* lds) {
    const int tid = opaque_tid(p.ph_hi), lane = tid & 63, wave = __builtin_amdgcn_readfirstlane(tid >> 6);
    const int G = gridDim.x, gw = blockIdx.x * 8 + wave, NGW = G * 8;
    LAS float* scr = (LAS float*)(lds + wave * 16384);
    for (int it = gw; it < N_TR_ALL; it += NGW) {
        if (it < N_TR_W) {
            const int l = it >> 15; int r = it & 32767; bf16* WL = wsb(p, WS_W) + (size_t)l * WL_ELEMS;
            if (r < 4096) { transpose_item(inptr(I_WIN) + (size_t)l * 2048 * 4096, 2048, 4096, WL + W_IN_T, scr, r, lane); continue; } r -= 4096;
            if (r < 8192) { transpose_item8(inptr(I_WGATE) + (size_t)l * 2048 * 8192, 2048, 8192, p.ws + WS_W8 + (size_t)l * 8192 * 2048, scr, r, lane); continue; } r -= 8192;
            if (r < 2048) { transpose_item(inptr(I_WBR) + (size_t)l * 2048 * 2048, 2048, 2048, WL + W_BR_T, scr, r, lane); continue; } r -= 2048;
            if (r < 2048) { transpose_item(inptr(I_WO) + (size_t)l * 2048 * 2048, 2048, 2048, WL + W_O_T, scr, r, lane); continue; } r -= 2048;
            if (r < 8192) { transpose_item(inptr(I_WFF1) + (size_t)l * 2048 * 8192, 2048, 8192, WL + W_FF1_T, scr, r, lane); continue; } r -= 8192;
            transpose_item(inptr(I_WFF2) + (size_t)l * 8192 * 2048, 8192, 2048, WL + W_FF2_T, scr, r, lane);
        } else {
            int r = it - N_TR_W;
            if (r < 512) { const int bl = r >> 5; transpose_item(inptr(I_CWV) + (size_t)bl * 512 * 128, 512, 128, wsb(p, CK_WVT) + (size_t)bl * 128 * 512, scr, r & 31, lane, true); continue; } r -= 512;
            if (r < 512) { const int bl = r >> 5; transpose_item(inptr(I_CGV) + (size_t)bl * 512 * 128, 512, 128, wsb(p, CK_GVT) + (size_t)bl * 128 * 512, scr, r & 31, lane, true); continue; } r -= 512;
            if (r < 2048) { const int bl = r >> 7; transpose_item(inptr(I_CDV) + (size_t)bl * 512 * 512, 512, 512, wsb(p, CK_DVT) + (size_t)bl * 512 * 512, scr, r & 127, lane, true); continue; } r -= 2048;
            { const int mtx = r >> 1, g = mtx >> 6, lkn = mtx & 63;
              transpose_item(inptr(g ? I_LWI : I_LWR) + (size_t)lkn * 4096, 64, 64, wsb(p, WS_LRUW) + (size_t)(g * 64 + lkn) * 4096, scr, r & 1, lane); }
        }
    }
    {
        const size_t gt = (size_t)blockIdx.x * 512 + tid, NT = (size_t)G * 512;
        for (size_t i = gt; i < 1048576 / 8; i += NT) {
            float x[8]; const f32x4 a = *(const f32x4*)(inptr(I_CWK) + i * 8), b = *(const f32x4*)(inptr(I_CWK) + i * 8 + 4);
            x[0] = a[0]; x[1] = a[1]; x[2] = a[2]; x[3] = a[3]; x[4] = b[0]; x[5] = b[1]; x[6] = b[2]; x[7] = b[3]; *(v4u*)(wsb(p, CK_WK) + i * 8) = pack8(x);
            const f32x4 c = *(const f32x4*)(inptr(I_CGK) + i * 8), d = *(const f32x4*)(inptr(I_CGK) + i * 8 + 4);
            x[0] = c[0]; x[1] = c[1]; x[2] = c[2]; x[3] = c[3]; x[4] = d[0]; x[5] = d[1]; x[6] = d[2]; x[7] = d[3]; *(v4u*)(wsb(p, CK_GK) + i * 8) = pack8(x); }
        for (size_t i = gt; i < 4194304 / 8; i += NT) {
            float x[8]; const f32x4 a = *(const f32x4*)(inptr(I_CDK) + i * 8), b = *(const f32x4*)(inptr(I_CDK) + i * 8 + 4);
            x[0] = a[0]; x[1] = a[1]; x[2] = a[2]; x[3] = a[3]; x[4] = b[0]; x[5] = b[1]; x[6] = b[2]; x[7] = b[3]; *(v4u*)(wsb(p, CK_DK) + i * 8) = pack8(x); }
    }
    if (blockIdx.x == 0) {
        float* tab = wsf(p, WS_TAB);
        if (tid < 16) {
            const double inv = tid == 0 ? 1.0 : tid == 1 ? 0.5623413251903491 : tid == 2 ? 0.31622776601683794 : tid == 3 ? 0.1778279410038923 : tid == 4 ? 0.1 : tid == 5 ? 0.05623413251903491 : tid == 6 ? 0.03162277660168379 :
                tid == 7 ? 0.01778279410038923 : tid == 8 ? 0.01 : tid == 9 ? 0.005623413251903491 : tid == 10 ? 0.0031622776601683794 : tid == 11 ? 0.0017782794100389228 : tid == 12 ? 0.001 : tid == 13 ? 0.0005623413251903491 :
                tid == 14 ? 0.00031622776601683794 : 0.00017782794100389227;
            double c1 = 1.0, s1 = inv, tc = 1.0, tsn = inv; const double x2 = inv * inv;
            for (int k = 1; k <= 14; ++k) { tc = -tc * x2 / (double)((2 * k - 1) * (2 * k)); tsn = -tsn * x2 / (double)((2 * k) * (2 * k + 1)); c1 += tc; s1 += tsn; }
            double c = 1.0, s = 0.0;
            for (int pos = 0; pos < 64; ++pos) { tab[TAB_COS + pos * 16 + tid] = (float)c; tab[TAB_SIN + pos * 16 + tid] = (float)s; const double cn = c * c1 - s * s1, sn = s * c1 + c * s1; c = cn; s = sn; }
        }
        for (int i = tid; i < 4096; i += 512) { const float lam = inptr(I_LLAM)[i]; tab[TAB_SPL + i] = lam > 15.f ? __expf(-lam) : log1pf(__expf(-lam)); }
        if (tid < 4) { float s1 = 0.f, s2 = 0.f; for (int d = 0; d < 64; ++d) { s1 += inptr(I_LQ1)[tid * 64 + d] * inptr(I_LK1)[tid * 64 + d]; s2 += inptr(I_LQ2)[tid * 64 + d] * inptr(I_LK2)[tid * 64 + d]; }
            const float li = 0.8f - 0.6f * expf(-0.3f * (float)tid); tab[TAB_LAMD + tid] = expf(s1) - expf(s2) + li; tab[TAB_LAMI + tid] = li; }
    }
    {
        LAS float* sv = (LAS float*)lds;
        LAS float* red = (LAS float*)(lds + 5 * 2048 * 4);
        float* mod = wsf(p, WS_MOD);
        __syncthreads();
        for (int i = tid; i < 5 * 2048; i += 512) { const int cond = i >> 11, k = i & 2047; const float c = cond == 0 ? inptr(I_CCTX)[k] : inptr(I_C)[(cond - 1) * 2048 + k]; sv[i] = c / (1.0f + __expf(-c)); }
        __syncthreads();
        const int q = tid >> 7, jl = tid & 127;
        for (int it = blockIdx.x; it < 4 * 96; it += G) {
            const int l = it / 96, j = (it % 96) * 128 + jl;
            float a0 = 0.f, a1 = 0.f, a2 = 0.f, a3 = 0.f, a4 = 0.f;
            const float* w = inptr(I_WADA) + ((size_t)l * 2048 + q * 512) * 12288 + j; const LAS float* s0 = sv + q * 512;
#pragma unroll 8
            for (int kk = 0; kk < 512; ++kk) { const float wv = w[(size_t)kk * 12288]; a0 += s0[kk] * wv; a1 += s0[2048 + kk] * wv; a2 += s0[4096 + kk] * wv; a3 += s0[6144 + kk] * wv; a4 += s0[8192 + kk] * wv; }
            red[(q * 5 + 0) * 128 + jl] = a0; red[(q * 5 + 1) * 128 + jl] = a1; red[(q * 5 + 2) * 128 + jl] = a2; red[(q * 5 + 3) * 128 + jl] = a3; red[(q * 5 + 4) * 128 + jl] = a4;
            __syncthreads();
            for (int i = tid; i < 5 * 128; i += 512) { const int cond = i >> 7, jj = i & 127; const int col = (it % 96) * 128 + jj;
                const float v = ((red[(0 * 5 + cond) * 128 + jj] + red[(1 * 5 + cond) * 128 + jj]) + (red[(2 * 5 + cond) * 128 + jj] + red[(3 * 5 + cond) * 128 + jj])) + inptr(I_BADA)[l * 12288 + col];
                mod[((size_t)l * 5 + cond) * 12288 + col] = v; }
            __syncthreads();
        }
    }
}

template <bool XBF  >
__device__ __forceinline__ void norm_phase(const Params& p, int l, int which  ) {
    const int tid = opaque_tid(p.ph_hi), lane = tid & 63, wave = __builtin_amdgcn_readfirstlane(tid >> 6);
    const int gw = blockIdx.x * 8 + wave, NGW = gridDim.x * 8;
    const float* g = inptr(which ? I_N2G : I_N1G) + l * 2048;
    const float* modl = wsf(p, WS_MOD) + (size_t)l * 5 * 12288;
    bf16* H = wsb(p, WS_H);
    for (int r = gw; r < MROWS; r += NGW) {
        const int cond = r < M_C ? 0 : 1 + ((r - M_C) >> 12);
        const float* sh = modl + (size_t)cond * 12288 + (which ? 3 : 0) * 2048, * sc = sh + 2048;
        float v[4][8]; float ss = 0.f;
#pragma unroll
        for (int j = 0; j < 4; ++j) { const int c = 8 * lane + 512 * j;
            if (XBF) { const v4u raw = *(const v4u*)(wsb(p, WS_XB) + (size_t)r * 2048 + c); unpack8(raw, v[j]); }
            else { const float* x = (r < M_C ? inptr(I_XP) : inptr(I_XS) - (size_t)M_C * DMODEL) + (size_t)r * 2048 + c; const f32x4 a = *(const f32x4*)x, b = *(const f32x4*)(x + 4);
#pragma unroll
                for (int k = 0; k < 4; ++k) { v[j][k] = a[k]; v[j][4 + k] = b[k]; } }
            ss += ((v[j][0] * v[j][0] + v[j][1] * v[j][1]) + (v[j][2] * v[j][2] + v[j][3] * v[j][3])) + ((v[j][4] * v[j][4] + v[j][5] * v[j][5]) + (v[j][6] * v[j][6] + v[j][7] * v[j][7])); }
        const float rstd = 1.0f / sqrtf(wave_sum(ss, lane) * (1.0f / 2048.0f) + RMS_EPS);
#pragma unroll
        for (int j = 0; j < 4; ++j) { const int c = 8 * lane + 512 * j; float y[8];
#pragma unroll
            for (int h = 0; h < 2; ++h) { const f32x4 gg = *(const f32x4*)(g + c + 4 * h), s1 = *(const f32x4*)(sc + c + 4 * h), s0 = *(const f32x4*)(sh + c + 4 * h);
#pragma unroll
                for (int k = 0; k < 4; ++k) y[4 * h + k] = (v[j][4 * h + k] * rstd) * gg[k] * (s1[k] + 1.0f) + s0[k]; }
            *(v4u*)(H + (size_t)r * 2048 + c) = pack8(y);
            if (!which) { int q0 = 0, q1 = 0; q0 = __builtin_amdgcn_cvt_pk_fp8_f32(y[0], y[1], q0, false); q0 = __builtin_amdgcn_cvt_pk_fp8_f32(y[2], y[3], q0, true);
                q1 = __builtin_amdgcn_cvt_pk_fp8_f32(y[4], y[5], q1, false); q1 = __builtin_amdgcn_cvt_pk_fp8_f32(y[6], y[7], q1, true);
                *(v2u*)(p.ws + WS_H8 + (size_t)r * 2048 + c) = (v2u){(unsigned)q0, (unsigned)q1}; } }
    }
}

__device__ __forceinline__ void prep_phase(const Params& p, int l, LAS unsigned char* lds) {
    const int tid = opaque_tid(p.ph_hi), lane = tid & 63, wave = __builtin_amdgcn_readfirstlane(tid >> 6);
    const int gw = blockIdx.x * 8 + wave, NGW = gridDim.x * 8;
    bf16* Z = wsb(p, WS_Z); const float* tab = wsf(p, WS_TAB);
    v4u nraw[2] = {{0u, 0u, 0u, 0u}, {0u, 0u, 0u, 0u}};
#define PREP_LOAD(r_) do { const bf16* zq_ = Z + (size_t)(r_) * DIN + (lane & 7) * 8; _Pragma("unroll") for (int it = 0; it < 2; ++it) { int v = it * 8 + (lane >> 3); if (v > 11) v = 11; \
        const int col = v < 2 ? ZC_KW + v * 64 : v < 4 ? ZC_KG + (v - 2) * 64 : ZC_KD + (v - 4) * 64; nraw[it] = *(const v4u*)(zq_ + col); } } while (0)
    if (gw < MROWS) PREP_LOAD(gw);
    for (int r = gw; r < MROWS; r += NGW) {
        const bool isctx = r < M_C; const int seq = isctx ? (r >> 8) : ((r - M_C) >> 12), t = isctx ? (r & 255) : ((r - M_C) & 4095);
        bf16* zr = Z + (size_t)r * DIN; const int sub = lane & 7;
        v4u raws[2] = {nraw[0], nraw[1]};
        { const int rn = r + NGW < MROWS ? r + NGW : r; PREP_LOAD(rn); asm volatile("" ::: "memory"); }
#pragma unroll
        for (int it = 0; it < 2; ++it) {
            int v = it * 8 + (lane >> 3); const bool live = v < 12; if (!live) v = 11;
            int col; const float* gain; size_t ko;
            if (v < 2)      { col = ZC_KW + v * 64; gain = inptr(I_WKN); ko = O_WK + ((size_t)(seq * 4 + l) * 256 + t) * 128 + v * 64; }
            else if (v < 4) { col = ZC_KG + (v - 2) * 64; gain = inptr(I_GKN); ko = O_GK + ((size_t)(seq * 4 + l) * 256 + t) * 128 + (v - 2) * 64; }
            else            { col = ZC_KD + (v - 4) * 64; gain = inptr(I_DKN); ko = O_DK + ((size_t)(seq * 4 + l) * 256 + t) * 512 + (v - 4) * 64; }
            gain += l * 64 + sub * 8;
            float x[8]; unpack8(raws[it], x);
            float ss = 0.f;
#pragma unroll
            for (int j = 0; j < 8; ++j) ss += x[j] * x[j];
            ss += shfl_xor_l(ss, 1, lane); ss += shfl_xor_l(ss, 2, lane); ss += shfl_xor_l(ss, 4, lane);
            const float rstd = 1.0f / sqrtf(ss * (1.0f / 64.0f) + RMS_EPS);
            const f32x4 g0 = *(const f32x4*)gain, g1 = *(const f32x4*)(gain + 4);
            float y[8];
#pragma unroll
            for (int j = 0; j < 4; ++j) { y[j] = x[j] * rstd * g0[j]; y[4 + j] = x[4 + j] * rstd * g1[j]; }
            if (isctx) {
                if (live) { *(f32x4*)(p.out + ko + sub * 8) = (f32x4){y[0], y[1], y[2], y[3]}; *(f32x4*)(p.out + ko + sub * 8 + 4) = (f32x4){y[4], y[5], y[6], y[7]}; }
            } else {
                const int axis = sub >> 2, pos = axis ? (t & 63) : (t >> 6), f0 = (sub & 1) * 8; const bool half = (sub >> 1) & 1;
                const f32x4 c0 = *(const f32x4*)(tab + TAB_COS + pos * 16 + f0), c1 = *(const f32x4*)(tab + TAB_COS + pos * 16 + f0 + 4);
                const f32x4 s0 = *(const f32x4*)(tab + TAB_SIN + pos * 16 + f0), s1 = *(const f32x4*)(tab + TAB_SIN + pos * 16 + f0 + 4);
#pragma unroll
                for (int j = 0; j < 8; ++j) { const float pr = shfl_xor_l(y[j], 2, lane); const float c = j < 4 ? c0[j & 3] : c1[j & 3], s = j < 4 ? s0[j & 3] : s1[j & 3];
                    y[j] = y[j] * c + (half ? pr : -pr) * s; }
            }
            if (live) *(v4u*)(zr + col + sub * 8) = pack8(y);
        }
        if (isctx) {
#pragma unroll 1
            for (int it = 0; it < 2; ++it) { const int g = it * 64 + lane; if (g < 96) {
                int col; size_t vo;
                if (g < 16)      { col = ZC_VW + g * 8; vo = O_WV + ((size_t)(seq * 4 + l) * 256 + t) * 128 + g * 8; }
                else if (g < 32) { col = ZC_VG + (g - 16) * 8; vo = O_GV + ((size_t)(seq * 4 + l) * 256 + t) * 128 + (g - 16) * 8; }
                else             { col = ZC_VD + (g - 32) * 8; vo = O_DV + ((size_t)(seq * 4 + l) * 256 + t) * 512 + (g - 32) * 8; }
                float x[8]; unpack8(*(const v4u*)(zr + col), x);
                *(f32x4*)(p.out + vo) = (f32x4){x[0], x[1], x[2], x[3]}; *(f32x4*)(p.out + vo + 4) = (f32x4){x[4], x[5], x[6], x[7]}; } }
        }
    }
#undef PREP_LOAD
    LAS unsigned short* tile = (LAS unsigned short*)(lds + wave * 16384);
    v4u braw[8];
#define PREPB_LOAD(it_) do { const int rb_ = (it_) / 12, cb_ = (it_) % 12; const int col_ = cb_ < 2 ? ZC_VW + cb_ * 64 : cb_ < 4 ? ZC_VG + (cb_ - 2) * 64 : ZC_VD + (cb_ - 4) * 64; \
        _Pragma("unroll") for (int i = 0; i < 8; ++i) braw[i] = *(const v4u*)(Z + (size_t)(rb_ * 64 + i * 8 + (lane >> 3)) * DIN + col_ + (lane & 7) * 8); } while (0)
    if (gw < (MROWS / 64) * 12) PREPB_LOAD(gw);
    for (int it = gw; it < (MROWS / 64) * 12; it += NGW) {
        const int rb = it / 12, cb = it % 12, r0 = rb * 64; const bool isctx = r0 < M_C;
        const int seq = isctx ? (r0 >> 8) : ((r0 - M_C) >> 12), t0 = isctx ? (r0 & 255) : ((r0 - M_C) & 4095), T = isctx ? T_C : T_L;
        int col; bf16* dst;
        if (cb < 2)      { col = ZC_VW + cb * 64; dst = wsb(p, isctx ? VT_BC : VT_BL) + (size_t)((seq * 2 + cb) * 64) * T; }
        else if (cb < 4) { col = ZC_VG + (cb - 2) * 64; dst = wsb(p, isctx ? VT_CC : VT_CL) + (size_t)((seq * 2 + cb - 2) * 64) * T; }
        else             { col = ZC_VD + (cb - 4) * 64; dst = wsb(p, isctx ? VT_DC : VT_DL) + (size_t)((seq * 4 + ((cb - 4) >> 1)) * 128 + ((cb - 4) & 1) * 64) * T; }
#pragma unroll
        for (int i = 0; i < 8; ++i) { const int row = i * 8 + (lane >> 3), ch = lane & 7; const v4u raw = braw[i];
            LAS unsigned* d = (LAS unsigned*)(tile + row * 66 + ch * 8); d[0] = raw.x; d[1] = raw.y; d[2] = raw.z; d[3] = raw.w; }
        { const int itn = it + NGW < (MROWS / 64) * 12 ? it + NGW : it; PREPB_LOAD(itn); }
        asm volatile("s_waitcnt lgkmcnt(0)" ::: "memory");
#pragma unroll
        for (int i = 0; i < 8; ++i) { const int drow = i * 8 + (lane >> 3), tch = lane & 7; unsigned short e[8];
#pragma unroll
            for (int j = 0; j < 8; ++j) e[j] = tile[(16 * (tch >> 1) + 4 * (tch & 1) + (j & 3) + 8 * (j >> 2)) * 66 + drow];
            v4u o; o.x = e[0] | ((unsigned)e[1] << 16); o.y = e[2] | ((unsigned)e[3] << 16); o.z = e[4] | ((unsigned)e[5] << 16); o.w = e[6] | ((unsigned)e[7] << 16);
            *(v4u*)(dst + (size_t)drow * T + t0 + tch * 8) = o; }
        asm volatile("s_waitcnt lgkmcnt(0)" ::: "memory");
    }
#undef PREPB_LOAD
}

__device__ __forceinline__ void dcomb_phase(const Params& p, int l) {
    const int tid = opaque_tid(p.ph_hi), lane = tid & 63, wave = __builtin_amdgcn_readfirstlane(tid >> 6);
    const int gw = blockIdx.x * 8 + wave, NGW = gridDim.x * 8;
    const float* tab = wsf(p, WS_TAB); const float lam = tab[TAB_LAMD + l], omli = 1.0f - tab[TAB_LAMI + l];
    const bf16* OD = wsb(p, WS_OD); bf16* BR3 = wsb(p, WS_BR) + 3 * BRW;
    const int h = lane >> 4, sub = lane & 15;
    const float* og = inptr(I_DOG) + l * 128 + sub * 8; const f32x4 g0 = *(const f32x4*)og, g1 = *(const f32x4*)(og + 4);
    for (int r = gw; r < MROWS; r += NGW) {
        float a[8], b[8]; unpack8(*(const v4u*)(OD + (size_t)r * 1024 + (h * 2) * 128 + sub * 8), a); unpack8(*(const v4u*)(OD + (size_t)r * 1024 + (h * 2 + 1) * 128 + sub * 8), b);
        float ss = 0.f;
#pragma unroll
        for (int j = 0; j < 8; ++j) { a[j] -= lam * b[j]; ss += a[j] * a[j]; }
        ss += shfl_xor_l(ss, 1, lane); ss += shfl_xor_l(ss, 2, lane); ss += shfl_xor_l(ss, 4, lane); ss += shfl_xor_l(ss, 8, lane);
        const float rstd = 1.0f / sqrtf(ss * (1.0f / 128.0f) + RMS_EPS) * omli;
#pragma unroll
        for (int j = 0; j < 4; ++j) { a[j] *= rstd * g0[j]; a[4 + j] *= rstd * g1[j]; }
        *(v4u*)(BR3 + (size_t)r * BRP + h * 128 + sub * 8) = pack8(a);
    }
}

constexpr int LR_U16 = 0, LR_U32 = 9216, LR_PA = 25600, LR_PB = 41984, LR_HF = 58368;
template <int MODE, bool AB = false>
__device__ __forceinline__ void lru_sweep(const Params& p, int l, int dir, int n, int rowseq0  , int T, int tch0  ,
                                          float& h  , float& aprod, LAS unsigned char* lds, unsigned* ab = nullptr) {
    const int tid = opaque_tid(p.ph_hi), lane = tid & 63, wave = __builtin_amdgcn_readfirstlane(tid >> 6), r32 = lane & 31, hi = lane >> 5;
    const bf16* Z = wsb(p, WS_Z);
    LAS unsigned short* U16 = (LAS unsigned short*)(lds + LR_U16); LAS float* U32 = (LAS float*)(lds + LR_U32); LAS float* PA = (LAS float*)(lds + LR_PA); LAS float* PB = (LAS float*)(lds + LR_PB); LAS float* HF = (LAS float*)(lds + LR_HF);
    const int g = wave >> 2, mi = (wave >> 1) & 1, ni = wave & 1, dcol = ni * 32 + r32;
    bf16x8 wf[4];
    { const bf16* wp = wsb(p, WS_LRUW) + ((size_t)((g * 64 + (l * 2 + dir) * 8 + n) * 64 + dcol)) * 64 + hi * 8;
#pragma unroll
      for (int ks = 0; ks < 4; ++ks) wf[ks] = *(const bf16x8*)(wp + ks * 16); }
    const float gbias = inptr(g ? I_LBI : I_LBR)[(l * 2 + dir) * 512 + n * 64 + dcol];
    const int tt = tid >> 3, c8 = (tid & 7) * 8;
    float cw[4][8], cb[8], sp[8];
#pragma unroll
    for (int k = 0; k < 4; ++k) { const float* q = inptr(I_CONVW) + (l * 4 + k) * 512 + n * 64 + c8; const f32x4 a = *(const f32x4*)q, b = *(const f32x4*)(q + 4);
        cw[k][0] = a[0]; cw[k][1] = a[1]; cw[k][2] = a[2]; cw[k][3] = a[3]; cw[k][4] = b[0]; cw[k][5] = b[1]; cw[k][6] = b[2]; cw[k][7] = b[3]; }
    { const float* q = inptr(I_CONVB) + l * 512 + n * 64 + c8; const float* s = wsf(p, WS_TAB) + TAB_SPL + (l * 2 + dir) * 512 + n * 64 + c8;
#pragma unroll
      for (int j = 0; j < 8; ++j) { cb[j] = q[j]; sp[j] = s[j]; } }
    v4u xr[4], yr = {0u, 0u, 0u, 0u};
#define LRU_FETCH(j4_) do { const int t_ = tch0 + 64 * (j4_) + tt; if (!AB) { _Pragma("unroll") for (int k = 0; k < 4; ++k) { const int tk = t_ + k - 1; \
        xr[k] = (tk >= 0 && tk < T) ? *(const v4u*)(Z + (size_t)(rowseq0 + tk) * DIN + ZC_XA + n * 64 + c8) : (v4u){0u, 0u, 0u, 0u}; } } \
        if (MODE == 2) yr = *(const v4u*)(Z + (size_t)(rowseq0 + t_) * DIN + ZC_YA + n * 64 + c8); } while (0)
    unsigned wn[8] = {0u, 0u, 0u, 0u, 0u, 0u, 0u, 0u};
#define LRU_FETCH_AB(j4_) do { _Pragma("unroll") for (int k = 0; k < 8; ++k) { const int st_ = dir ? 63 - (8 * wave + k) : 8 * wave + k; wn[k] = ab[(size_t)(tch0 + 64 * (j4_) + st_) * 512 + lane]; } } while (0)
    LRU_FETCH(dir ? 3 : 0);
    if (AB) LRU_FETCH_AB(dir ? 3 : 0);
#pragma unroll 1
    for (int jj = 0; jj < 4; ++jj) {
        const int j4 = dir ? 3 - jj : jj, ts = tch0 + 64 * j4, t = ts + tt;
        float ya[8]; unsigned wc[8];
        if constexpr (!AB) {
        { float u[8];
#pragma unroll
          for (int j = 0; j < 8; ++j) u[j] = cb[j];
#pragma unroll
          for (int k = 0; k < 4; ++k) { float x[8]; unpack8(xr[k], x);
#pragma unroll
              for (int j = 0; j < 8; ++j) u[j] += cw[k][j] * x[j]; }
          if (MODE == 2) unpack8(yr, ya);
          *(LAS v4u*)(U16 + tt * 72 + c8) = pack8(u);
          *(LAS f32x4*)(U32 + tt * 64 + c8) = (f32x4){u[0], u[1], u[2], u[3]}; *(LAS f32x4*)(U32 + tt * 64 + c8 + 4) = (f32x4){u[4], u[5], u[6], u[7]}; }
        __syncthreads();
        if (jj < 3) LRU_FETCH(dir ? 2 - jj : jj + 1);
        { f32x16 acc = {};
#pragma unroll
          for (int ks = 0; ks < 4; ++ks) { const bf16x8 a = *(const LAS bf16x8*)(U16 + (mi * 32 + r32) * 72 + ks * 16 + hi * 8); acc = __builtin_amdgcn_mfma_f32_32x32x16_bf16(a, wf[ks], acc, 0, 0, 0); }
          LAS float* P = g ? PB : PA;
#pragma unroll
          for (int r = 0; r < 16; ++r) P[(mi * 32 + crow(r, hi)) * 64 + dcol] = acc[r] + gbias; }
        __syncthreads();
        { unsigned wab[8];
#pragma unroll
          for (int j = 0; j < 8; ++j) { const int idx = tt * 64 + c8 + j;
              const float rg = __builtin_amdgcn_rcpf(1.0f + __builtin_amdgcn_exp2f(-1.4426950408889634f * PA[idx])), ig = __builtin_amdgcn_rcpf(1.0f + __builtin_amdgcn_exp2f(-1.4426950408889634f * PB[idx]));
              const float la = -8.0f * rg * sp[j]; const float a = __builtin_amdgcn_exp2f(1.4426950408889634f * la);
              const float x = 2.0f * la; const float ser = -x * (1.0f + x * (0.5f + x * (0.16666667f + x * (0.041666668f + x * (0.0083333338f + x * 0.0013888889f)))));
              const float om = x > -0.25f ? ser : 1.0f - a * a;
              const float b = __builtin_amdgcn_sqrtf(om) * ig * U32[idx];
              if (MODE == 0) { const unsigned w = pk2(1.4426950408889634f * la, b); wab[j] = w; PA[idx] = __builtin_amdgcn_exp2f(bflo(w)); PB[idx] = bfhi(w); }
              else { PA[idx] = a; PB[idx] = b; } }
          if (MODE == 0) { unsigned* q = ab + (size_t)(ts + tt) * 512 + c8; *(v4u*)q = (v4u){wab[0], wab[1], wab[2], wab[3]}; *(v4u*)(q + 4) = (v4u){wab[4], wab[5], wab[6], wab[7]}; } }
        __syncthreads();
        } else {
            if (MODE == 2) unpack8(yr, ya);
#pragma unroll
            for (int k = 0; k < 8; ++k) wc[k] = wn[k];
            if (jj < 3) { LRU_FETCH(dir ? 2 - jj : jj + 1); LRU_FETCH_AB(dir ? 2 - jj : jj + 1); }
        }
        {
            LAS float* SC = (LAS float*)(lds + LR_U16);
            float av[8], bv[8];
#pragma unroll
            for (int k = 0; k < 8; ++k) { const int st = dir ? 63 - (8 * wave + k) : 8 * wave + k; if (AB) { av[k] = __builtin_amdgcn_exp2f(bflo(wc[k])); bv[k] = bfhi(wc[k]); } else { av[k] = PA[st * 64 + lane]; bv[k] = PB[st * 64 + lane]; } }
            float Al = av[0], Bl = bv[0];
#pragma unroll
            for (int k = 1; k < 8; ++k) { Bl = av[k] * Bl + bv[k]; Al *= av[k]; }
            SC[(wave * 2) * 64 + lane] = Al; SC[(wave * 2 + 1) * 64 + lane] = Bl;
            __syncthreads();
            float hv = h, hin = h;
#pragma unroll
            for (int v = 0; v < 8; ++v) { const float Av = SC[(2 * v) * 64 + lane], Bv = SC[(2 * v + 1) * 64 + lane]; if (v == wave) hin = hv; hv = Av * hv + Bv; if (MODE == 0) aprod *= Av; }
            h = hv;
#pragma unroll
            for (int k = 0; k < 8; ++k) { const int st = dir ? 63 - (8 * wave + k) : 8 * wave + k; hin = av[k] * hin + bv[k];
                if (MODE == 1) HF[(j4 * 64 + st) * 64 + lane] = hin;
                if (MODE == 2) PB[st * 64 + lane] = hin; }
        }
        __syncthreads();
        if (MODE == 2) {
            float o[8];
#pragma unroll
            for (int j = 0; j < 8; ++j) { const float hs = HF[(j4 * 64 + tt) * 64 + c8 + j] + PB[tt * 64 + c8 + j]; const float y = ya[j];
                const float ug = 0.7978845608028654f * (y + 0.044715f * y * y * y);
                const float gl = y * __builtin_amdgcn_rcpf(1.0f + __builtin_amdgcn_exp2f(-2.8853900817779268f * ug)); o[j] = hs * gl; }
            *(v4u*)(wsb(p, WS_BR) + (size_t)(rowseq0 + t) * BRP + n * 64 + c8) = pack8(o);
        }
    }
#undef LRU_FETCH
#undef LRU_FETCH_AB
}
__device__ __forceinline__ void lru_pass1(const Params& p, int l, LAS unsigned char* lds) {
    const int tid = opaque_tid(p.ph_hi), lane = tid & 63, wave = __builtin_amdgcn_readfirstlane(tid >> 6);
    float* SUM = wsf(p, WS_SUM);
#pragma unroll 1
    for (int it = blockIdx.x; it < NSEQ_L * 2 * 8 * 16; it += gridDim.x) {
        const int seq = it >> 8, dir = (it >> 7) & 1, n = (it >> 4) & 7, c = it & 15;
        float h = 0.f, ap = 1.f; asm volatile("" : "+v"(h), "+v"(ap));
        __syncthreads();
        lru_sweep<0>(p, l, dir, n, M_C + seq * T_L, T_L, c * 256, h, ap, lds, (unsigned*)(p.ws + WS_LAB) + ((size_t)(seq * 2 + dir) * T_L) * 512 + n * 64);
        if (wave == 0) { float* s = SUM + ((size_t)((seq * 2 + dir) * 16 + c) * 512 + n * 64 + lane) * 2; s[0] = ap; s[1] = h; }
    }
}
__device__ __forceinline__ void lru_pass2(const Params& p, int l, LAS unsigned char* lds) {
    const int tid = opaque_tid(p.ph_hi), lane = tid & 63, wave = __builtin_amdgcn_readfirstlane(tid >> 6);
    const float* SUM = wsf(p, WS_SUM);
#pragma unroll 1
    for (int it = blockIdx.x; it < NSEQ_L * 8 * 16 + NSEQ_C * 8; it += gridDim.x) {
        const bool lat = it < NSEQ_L * 8 * 16;
        int seq, n, c, rowseq0, T;
        if (lat) { seq = it >> 7; n = (it >> 4) & 7; c = it & 15; rowseq0 = M_C + seq * T_L; T = T_L; }
        else { const int i2 = it - NSEQ_L * 8 * 16; seq = i2 >> 3; n = i2 & 7; c = 0; rowseq0 = seq * T_C; T = T_C; }
        float hf = 0.f, hb = 0.f, dummy = 1.f; asm volatile("" : "+v"(hf), "+v"(hb), "+v"(dummy));
        if (lat) {
            const int ch = n * 64 + lane;
            hf = inptr(I_SLRU)[((size_t)(seq * 4 + l) * 2 + 0) * 512 + ch]; hb = inptr(I_SLRU)[((size_t)(seq * 4 + l) * 2 + 1) * 512 + ch];
            { pg8::f32x2_t sv[16];
#pragma unroll
              for (int cc = 0; cc < 16; ++cc) sv[cc] = *(const pg8::f32x2_t*)(SUM + ((size_t)((seq * 2 + 0) * 16 + cc) * 512 + ch) * 2);
#pragma unroll
              for (int cc = 0; cc < 16; ++cc) hf = cc < c ? sv[cc][0] * hf + sv[cc][1] : hf;
#pragma unroll
              for (int cc = 0; cc < 16; ++cc) sv[cc] = *(const pg8::f32x2_t*)(SUM + ((size_t)((seq * 2 + 1) * 16 + cc) * 512 + ch) * 2);
#pragma unroll
              for (int cc = 15; cc >= 0; --cc) hb = cc > c ? sv[cc][0] * hb + sv[cc][1] : hb; }
        }
        __syncthreads();
        if (lat) { unsigned* ab = (unsigned*)(p.ws + WS_LAB) + ((size_t)(seq * 2) * T_L) * 512 + n * 64;
            lru_sweep<1, true>(p, l, 0, n, rowseq0, T, c * 256, hf, dummy, lds, ab);
            lru_sweep<2, true>(p, l, 1, n, rowseq0, T, c * 256, hb, dummy, lds, ab + (size_t)T_L * 512); }
        else {
            lru_sweep<1>(p, l, 0, n, rowseq0, T, c * 256, hf, dummy, lds);
            lru_sweep<2>(p, l, 1, n, rowseq0, T, c * 256, hb, dummy, lds); }
        if (!lat && wave == 0) { float* o = p.out + O_LS + ((size_t)(seq * 4 + l) * 2) * 512 + n * 64 + lane; o[0] = hf; o[512] = hb; }
    }
}

struct AttnJob {
    const bf16* Q; const bf16* Ks; const bf16* VTs; const bf16* Kc; const bf16* VTc; bf16* O;
    int kspitch, vtspitch, kcpitch, opitch, s_t0, s_nt, c_nt, q0, window, wv, rope; float sink2; bool has_sink; const float* qg; const float* tab;
};
constexpr int AT_K = 0, AT_V = 32768;
#define GLDS16(gp, lp) __builtin_amdgcn_global_load_lds((const unsigned*)(gp), (LAS unsigned*)(lp), 16, 0, 0)
constexpr float ATT_THR = 8.0f;
template <int VW, int PROBE>
__device__ __forceinline__ void attn_unit(const AttnJob& J, LAS unsigned char* lds) {
    const int tid = opaque_tid(J.wv), lane = tid & 63, wid = __builtin_amdgcn_readfirstlane(tid >> 6), r32 = lane & 31, hi = lane >> 5;
    constexpr int NB = VW / 32;
    bf16x8 qf[4];
    { const bf16* qp = J.Q + (size_t)(wid * 32 + r32) * DIN + hi * 8;
      v4u raw[4];
#pragma unroll
      for (int ks = 0; ks < 4; ++ks) raw[ks] = *(const v4u*)(qp + ks * 16);
      float y[4][8]; float ss = 0.f;
#pragma unroll
      for (int ks = 0; ks < 4; ++ks) { unpack8(raw[ks], y[ks]);
#pragma unroll
          for (int j = 0; j < 8; ++j) ss += y[ks][j] * y[ks][j]; }
      { const auto rr_ = __builtin_amdgcn_permlane32_swap(__float_as_uint(ss), __float_as_uint(ss), false, false); ss = __uint_as_float(rr_[0]) + __uint_as_float(rr_[1]); }
      const float rstd = 1.0f / sqrtf(ss * (1.0f / 64.0f) + RMS_EPS);
#pragma unroll
      for (int ks = 0; ks < 4; ++ks) { const f32x4 g0 = *(const f32x4*)(J.qg + 16 * ks + 8 * hi), g1 = *(const f32x4*)(J.qg + 16 * ks + 8 * hi + 4);
#pragma unroll
          for (int j = 0; j < 4; ++j) { y[ks][j] = y[ks][j] * rstd * g0[j]; y[ks][4 + j] = y[ks][4 + j] * rstd * g1[j]; } }
      if (J.rope) { const int tq = J.q0 + wid * 32 + r32;
#pragma unroll
          for (int ax = 0; ax < 2; ++ax) { const int pos = ax ? (tq & 63) : (tq >> 6); const float* cp = J.tab + TAB_COS + pos * 16 + 8 * hi, * sp = J.tab + TAB_SIN + pos * 16 + 8 * hi;
              const f32x4 c0 = *(const f32x4*)cp, c1 = *(const f32x4*)(cp + 4), s0 = *(const f32x4*)sp, s1 = *(const f32x4*)(sp + 4);
#pragma unroll
              for (int j = 0; j < 8; ++j) { const float c = j < 4 ? c0[j & 3] : c1[j & 3], s = j < 4 ? s0[j & 3] : s1[j & 3]; const float a = y[2 * ax][j], b = y[2 * ax + 1][j];
                  y[2 * ax][j] = a * c - b * s; y[2 * ax + 1][j] = b * c + a * s; } } }
#pragma unroll
      for (int ks = 0; ks < 4; ++ks) {
#pragma unroll
          for (int j = 0; j < 8; ++j) y[ks][j] *= QSCALE;
          qf[ks] = __builtin_bit_cast(bf16x8, pack8(y[ks])); } }
    float mref = 0.f, lsum = 0.f; f32x16 o[NB]; f32x16 negm;
    { float zz = 0.f; asm volatile("" : "+v"(zz));
#pragma unroll
      for (int r = 0; r < 16; ++r) { negm[r] = zz;
#pragma unroll
          for (int b = 0; b < NB; ++b) o[b][r] = zz; } }
    const int NT = J.s_nt + J.c_nt, qw0 = J.q0 + wid * 32;
    const int krow = wid * 8 + (lane >> 3), kchunk = (lane & 7) ^ ((krow >> 1) & 7);
    const unsigned lk_s = (unsigned)krow * (unsigned)J.kspitch * 2u + kchunk * 16u, lk_c = (unsigned)krow * (unsigned)J.kcpitch * 2u + kchunk * 16u, lv_s = (unsigned)lane * (unsigned)J.vtspitch * 2u, lv_c = (unsigned)lane * (unsigned)(PAST * 2);
#define ATT_ISSUE_K(t_, slot_) do { const int t__ = (t_); \
        if (t__ < J.s_nt) GLDS16((const char*)J.Ks + (size_t)(J.s_t0 + t__ * 64) * J.kspitch * 2 + lk_s, lds + AT_K + (slot_) * 8192 + wid * 1024); \
        else GLDS16((const char*)J.Kc + (size_t)((t__ - J.s_nt) * 64) * J.kcpitch * 2 + lk_c, lds + AT_K + (slot_) * 8192 + wid * 1024); } while (0)
#define ATT_ISSUE_V(t_, slot_) do { const int t__ = (t_); \
        if (t__ < J.s_nt) { const char* vb_ = (const char*)J.VTs + (size_t)(J.s_t0 + t__ * 64 + wid * 8) * 2; GLDS16(vb_ + lv_s, lds + AT_V + (slot_) * 16384 + wid * 1024); \
            if (VW == 128) GLDS16(vb_ + (size_t)128 * J.vtspitch + lv_s, lds + AT_V + (slot_) * 16384 + 8192 + wid * 1024); } \
        else { const char* vb_ = (const char*)J.VTc + (size_t)((t__ - J.s_nt) * 64 + wid * 8) * 2; GLDS16(vb_ + lv_c, lds + AT_V + (slot_) * 16384 + wid * 1024); \
            if (VW == 128) GLDS16(vb_ + (size_t)128 * PAST + lv_c, lds + AT_V + (slot_) * 16384 + 8192 + wid * 1024); } } while (0)
#define ATT_NEED(t_) (!(J.window && (t_) < J.s_nt) || ((J.s_t0 + (t_) * 64 + 63 >= qw0 - 128) && (J.s_t0 + (t_) * 64 <= qw0 + 31 + 128)))
#define ATT_LDK(slot_) do { const LAS unsigned char* Kb = lds + AT_K + (slot_) * 8192 + (r32 >> 3) * 1024 + (r32 & 7) * 128; const int kx = ((r32 >> 1) & 7); \
        _Pragma("unroll") for (int ks = 0; ks < 4; ++ks) { kf[2 * ks] = *(const LAS bf16x8*)(Kb + (((2 * ks + hi) ^ kx) << 4)); kf[2 * ks + 1] = *(const LAS bf16x8*)(Kb + 4096 + (((2 * ks + hi) ^ kx) << 4)); } } while (0)
#define ATT_MMK(P0, P1) do { \
        P0 = __builtin_amdgcn_mfma_f32_32x32x16_bf16(kf[0], qf[0], negm, 0, 0, 0); P1 = __builtin_amdgcn_mfma_f32_32x32x16_bf16(kf[1], qf[0], negm, 0, 0, 0); \
        _Pragma("unroll") for (int ks = 1; ks < 4; ++ks) { P0 = __builtin_amdgcn_mfma_f32_32x32x16_bf16(kf[2 * ks], qf[ks], P0, 0, 0, 0); P1 = __builtin_amdgcn_mfma_f32_32x32x16_bf16(kf[2 * ks + 1], qf[ks], P1, 0, 0, 0); } } while (0)
#define ATT_LDV(VF, vslot_, b_) do { const LAS unsigned char* vb = lds + AT_V + (vslot_) * 16384 + ((b_) >> 1) * 8192 + (((b_) & 1) * 32 + r32) * 16 + hi * 1024; \
        _Pragma("unroll") for (int s_ = 0; s_ < 4; ++s_) VF[s_] = *(const LAS v4u*)(vb + (2 * s_) * 1024); } while (0)
#define ATT_MMV(VF, b_) do { _Pragma("unroll") for (int s_ = 0; s_ < 4; ++s_) o[b_] = __builtin_amdgcn_mfma_f32_32x32x16_bf16(__builtin_bit_cast(bf16x8, VF[s_]), __builtin_bit_cast(bf16x8, pw[s_]), o[b_], 0, 0, 0); } while (0)
#define ATT_SB __builtin_amdgcn_sched_barrier(0)
#define ATT_PVK(vslot_, kslot_, ldk_) do { ATT_LDV(vf0, vslot_, 0); ATT_LDV(vf1, vslot_, 1); ATT_SB; \
        if (VW == 128) { ATT_MMV(vf0, 0); ATT_SB; ATT_LDV(vf0, vslot_, 2 % NB); ATT_SB; ATT_MMV(vf1, 1); ATT_SB; ATT_LDV(vf1, vslot_, 3 % NB); ATT_SB; ATT_MMV(vf0, 2 % NB); ATT_SB; \
            ATT_MMV(vf1, 3 % NB); ATT_SB; if (ldk_) { ATT_LDK(kslot_); ATT_SB; } } \
        else { ATT_MMV(vf0, 0); ATT_MMV(vf1, 1); ATT_SB; if (ldk_) { ATT_LDK(kslot_); ATT_SB; } } } while (0)
#define ATT_MAX(PC0, PC1, t_) do { \
        if (J.window && (t_) < J.s_nt && !((J.s_t0 + (t_) * 64 >= qw0 + 31 - 128) && (J.s_t0 + (t_) * 64 + 63 <= qw0 + 128))) {     \
            int dbase = qw0 + r32 - (J.s_t0 + (t_) * 64) - 4 * hi; asm volatile("" : "+v"(dbase));     \
            _Pragma("unroll") for (int r = 0; r < 16; ++r) { int d0 = dbase - ((r & 3) + 8 * (r >> 2)); d0 = d0 < 0 ? -d0 : d0; int d1 = dbase - ((r & 3) + 8 * (r >> 2)) - 32; d1 = d1 < 0 ? -d1 : d1; \
                if (d0 > 128) PC0[r] = -INFINITY; if (d1 > 128) PC1[r] = -INFINITY; } } \
        float mx = fmaxf(fmaxf(PC0[0], PC1[0]), PC0[1]); \
        _Pragma("unroll") for (int r = 2; r < 16; r += 2) mx = fmaxf(fmaxf(mx, PC0[r]), PC0[r + 1]); \
        _Pragma("unroll") for (int r = 1; r < 15; r += 2) mx = fmaxf(fmaxf(mx, PC1[r]), PC1[r + 1]); \
        mx = fmaxf(mx, PC1[15]); { const auto rr_ = __builtin_amdgcn_permlane32_swap(__float_as_uint(mx), __float_as_uint(mx), false, false); mx = fmaxf(__uint_as_float(rr_[0]), __uint_as_float(rr_[1])); }     \
        if (__any(mx > ATT_THR)) { const float dl = fmaxf(mx, 0.f), f = __builtin_amdgcn_exp2f(-dl); mref += dl; lsum *= f; \
            _Pragma("unroll") for (int r = 0; r < 16; ++r) { PC0[r] -= dl; PC1[r] -= dl; negm[r] = -mref; } \
            _Pragma("unroll") for (int b = 0; b < NB; ++b) _Pragma("unroll") for (int r = 0; r < 16; ++r) o[b][r] *= f; } } while (0)
#define ATT_EXP(PC0, PC1) do { pg8::f32x2_t rs2 = {0.f, 0.f}; \
        _Pragma("unroll") for (int r = 0; r < 16; ++r) { PC0[r] = __builtin_amdgcn_exp2f(PC0[r]); PC1[r] = __builtin_amdgcn_exp2f(PC1[r]); } \
        _Pragma("unroll") for (int r = 0; r < 16; r += 2) { rs2 += (pg8::f32x2_t){PC0[r], PC0[r + 1]}; rs2 += (pg8::f32x2_t){PC1[r], PC1[r + 1]}; } \
        lsum += rs2[0] + rs2[1]; \
        _Pragma("unroll") for (int i = 0; i < 4; ++i) { pw[0][i] = pg8::cvt_pk_bf16(PC0[2 * i], PC0[2 * i + 1]); pw[1][i] = pg8::cvt_pk_bf16(PC0[8 + 2 * i], PC0[9 + 2 * i]); \
            pw[2][i] = pg8::cvt_pk_bf16(PC1[2 * i], PC1[2 * i + 1]); pw[3][i] = pg8::cvt_pk_bf16(PC1[8 + 2 * i], PC1[9 + 2 * i]); } } while (0)
#define ATT_WAITBAR(n_) asm volatile("s_waitcnt vmcnt(" #n_ ") lgkmcnt(0)\n\ts_barrier" ::: "memory")
#define ATT_TOP(t_) do { if (PROBE != 1) { if ((t_) + 3 < NT) ATT_ISSUE_K((t_) + 3, ((t_) + 3) & 3); if ((t_) + 2 < NT) ATT_ISSUE_V((t_) + 2, ((t_) + 2) & 3); } } while (0)
#define ATT_END(t_) do { if (PROBE == 1) ATT_WAITBAR(0); else if ((t_) + 3 < NT) { if (VW == 128) ATT_WAITBAR(3); else ATT_WAITBAR(2); } \
        else if ((t_) + 2 < NT) { if (VW == 128) ATT_WAITBAR(2); else ATT_WAITBAR(1); } else ATT_WAITBAR(0); } while (0)
    const bool grpA = wid < 4;
    __syncthreads();
    ATT_ISSUE_K(0, 0); ATT_ISSUE_V(0, 0); ATT_ISSUE_K(1, 1); ATT_ISSUE_V(1, 1); ATT_ISSUE_K(2, 2);
    if (VW == 128) ATT_WAITBAR(3); else ATT_WAITBAR(2);
    f32x16 p0, p1; v4u pw[4], vf0[4], vf1[4]; bf16x8 kf[8];
    constexpr bool PF = (VW == 64);
    if (grpA) {
        if (PF) ATT_LDK(0);
#pragma unroll 1
        for (int t = 0; t < NT; ++t) {
            ATT_TOP(t);
            ATT_SB;
            if (t > 0) ATT_PVK((t - 1) & 3, t & 3, !PF); else if (!PF) { ATT_LDK(t & 3); ATT_SB; }
            ATT_MMK(p0, p1);
            ATT_SB;
            if (PF) { ATT_LDK((t + 1) & 3); }
            ATT_SB;
            ATT_MAX(p0, p1, t); ATT_EXP(p0, p1);
            ATT_END(t);
        }
        ATT_PVK((NT - 1) & 3, 0, false);
    } else {
        ATT_LDK(0); ATT_SB; ATT_MMK(p0, p1);
#pragma unroll 1
        for (int t = 0; t < NT; ++t) {
            ATT_TOP(t);
            if (PF) { ATT_LDK((t + 1) & 3); }
            ATT_SB;
            ATT_MAX(p0, p1, t); ATT_EXP(p0, p1);
            ATT_SB;
            ATT_PVK(t & 3, (t + 1) & 3, !PF);
            if (t + 1 < NT) ATT_MMK(p0, p1);
            ATT_END(t);
        }
    }
#undef ATT_TOP
#undef ATT_END
#undef ATT_WAITBAR
#undef ATT_MAX
#undef ATT_EXP
#undef ATT_LDK
#undef ATT_MMK
#undef ATT_LDV
#undef ATT_MMV
#undef ATT_PVK
#undef ATT_SB
#undef ATT_ISSUE_K
#undef ATT_ISSUE_V
#undef ATT_NEED
    float lt = lsum + shfl_xor_l(lsum, 32, lane);
    if (J.has_sink) lt += __builtin_amdgcn_exp2f(J.sink2 - mref);
    const float inv = 1.0f / lt;
    bf16* op = J.O + (size_t)(wid * 32 + r32) * J.opitch + 8 * hi;
#pragma unroll
    for (int b = 0; b < NB; ++b)
#pragma unroll
        for (int e = 0; e < 4; e += 2) {
            const unsigned a0 = pk2(o[b][4 * e] * inv, o[b][4 * e + 1] * inv), a1 = pk2(o[b][4 * e + 2] * inv, o[b][4 * e + 3] * inv);
            const unsigned b0 = pk2(o[b][4 * e + 4] * inv, o[b][4 * e + 5] * inv), b1 = pk2(o[b][4 * e + 6] * inv, o[b][4 * e + 7] * inv);
            const auto s0 = __builtin_amdgcn_permlane32_swap(a0, b0, false, false), s1 = __builtin_amdgcn_permlane32_swap(a1, b1, false, false);
            *(v4u*)(op + b * 32 + 8 * e) = (v4u){s0[0], s1[0], s0[1], s1[1]}; }
}
constexpr int AU_DL = 512, AU_CL = 1024, AU_BL = 1536, AU_DC = 1792, AU_CC = 2048, AU_END = 2304;
template <int PROBE>
__device__ __forceinline__ void attn_phase(const Params& p, int l, LAS unsigned char* lds) {
    const bf16* Z = wsb(p, WS_Z);
#pragma unroll 1
    for (int u = blockIdx.x; u < AU_END; u += gridDim.x) {
        AttnJob J; bool is128 = false; J.wv = p.ph_hi; J.tab = wsf(p, WS_TAB); J.rope = u < AU_BL; J.window = 0; J.has_sink = false; J.sink2 = 0.f; J.kspitch = DIN;
        const bool xdeal = gridDim.x == 256; const int xcd = blockIdx.x & 7, slot = blockIdx.x >> 3;
        if (u < AU_BL) {
            int v = u & 511; if (xdeal) { const int k = ((v >> 8) << 5) + slot; v = ((xcd * 4 + (k >> 4)) << 4) + (k & 15); }
            const int seq = v >> 7, qb = v & 15; const size_t rs0 = (size_t)M_C + (size_t)seq * T_L, rq = rs0 + qb * 256;
            J.q0 = qb * 256; J.s_t0 = 0; J.s_nt = 64; J.c_nt = 8; J.vtspitch = T_L;
            if (u < AU_DL) { const int hj = (v >> 4) & 7, h = hj >> 1;
                J.Q = Z + rq * DIN + ZC_QD + hj * 64; J.Ks = Z + rs0 * DIN + ZC_KD + hj * 64; J.VTs = wsb(p, VT_DL) + (size_t)((seq * 4 + h) * 128) * T_L;
                J.Kc = wsb(p, CK_DK) + (size_t)((seq * 4 + l) * 512) * 512 + hj * 64; J.kcpitch = 512; J.VTc = wsb(p, CK_DVT) + (size_t)((seq * 4 + l) * 512 + h * 128) * 512;
                J.O = wsb(p, WS_OD) + rq * 1024 + hj * 128; J.opitch = 1024;
                is128 = true;
            } else { const int head = (v >> 4) & 7, kvh = head >> 2; const bool isB = u >= AU_CL;
                J.Q = Z + rq * DIN + (isB ? ZC_QW : ZC_QG) + head * 64; J.Ks = Z + rs0 * DIN + (isB ? ZC_KW : ZC_KG) + kvh * 64; J.VTs = wsb(p, isB ? VT_BL : VT_CL) + (size_t)((seq * 2 + kvh) * 64) * T_L;
                J.Kc = wsb(p, isB ? CK_WK : CK_GK) + (size_t)((seq * 4 + l) * 512) * 128 + kvh * 64; J.kcpitch = 128; J.VTc = wsb(p, isB ? CK_WVT : CK_GVT) + (size_t)((seq * 4 + l) * 128 + kvh * 64) * 512;
                J.O = wsb(p, WS_BR) + (isB ? 1 : 2) * BRW + rq * BRP + head * 64; J.opitch = BRP;
                if (isB) { J.window = 1; J.has_sink = true; J.sink2 = inptr(I_WSINK)[l * 8 + head] * 1.4426950408889634f;
                    const int klo = J.q0 - 128 < 0 ? 0 : J.q0 - 128, khi = J.q0 + 384 > T_L ? T_L : J.q0 + 384; J.s_t0 = klo; J.s_nt = (khi - klo) >> 6; }
            }
        } else {
            int v = (u - AU_BL) & 255; if (xdeal) v = xcd * 32 + slot;
            const int seq = v >> 3; const size_t rs0 = (size_t)seq * T_C;
            J.q0 = 0; J.s_t0 = 0; J.s_nt = 4; J.c_nt = 0; J.vtspitch = T_C; J.Kc = Z; J.VTc = Z; J.kcpitch = 0;
            if (u < AU_DC) { const int hj = v & 7, h = hj >> 1;
                J.Q = Z + rs0 * DIN + ZC_QD + hj * 64; J.Ks = Z + rs0 * DIN + ZC_KD + hj * 64; J.VTs = wsb(p, VT_DC) + (size_t)((seq * 4 + h) * 128) * T_C;
                J.O = wsb(p, WS_OD) + rs0 * 1024 + hj * 128; J.opitch = 1024;
                is128 = true;
            } else { const int head = v & 7, kvh = head >> 2; const bool isB = u >= AU_CC;
                J.Q = Z + rs0 * DIN + (isB ? ZC_QW : ZC_QG) + head * 64; J.Ks = Z + rs0 * DIN + (isB ? ZC_KW : ZC_KG) + kvh * 64; J.VTs = wsb(p, isB ? VT_BC : VT_CC) + (size_t)((seq * 2 + kvh) * 64) * T_C;
                J.O = wsb(p, WS_BR) + (isB ? 1 : 2) * BRW + rs0 * BRP + head * 64; J.opitch = BRP;
                if (isB) { J.has_sink = true; J.sink2 = inptr(I_WSINK)[l * 8 + head] * 1.4426950408889634f; }
            }
        }
        J.qg = inptr(is128 ? I_DQN : J.has_sink ? I_WQN : I_GQN) + l * 64;
        if (PROBE) { J.O = wsb(p, WS_H) + (J.O - (is128 ? wsb(p, WS_OD) : wsb(p, WS_BR))); }
        if (is128) attn_unit<128, PROBE>(J, lds); else attn_unit<64, PROBE>(J, lds);
    }
}

constexpr int NPL = 10;
constexpr int N_PHASES = 1 + DEPTH * NPL;
#ifndef PG8_SP2
#define PG8_SP2 true
#endif
#ifndef PG8_ALIGN
#define PG8_ALIGN true
#endif
__global__ void __launch_bounds__(512, 2) fwd_kernel(Params p_) {
    extern __shared__ __attribute__((aligned(16))) unsigned char lds_raw[];
    LAS unsigned char* lds = (LAS unsigned char*)lds_raw;
    const int tid = threadIdx.x, G = gridDim.x;
    const int lo = p_.ph_lo, hi = p_.ph_hi;
    Params p = p_; p.ph_hi = __builtin_amdgcn_readfirstlane(tid >> 6);
    for (int u = tid; u < (LDS_BYTES - LDSCTL_OFF) / 4; u += 512) ((LAS unsigned*)(lds + LDSCTL_OFF))[u] = 0u;
    __syncthreads();
    XcdBarrier bar = xcd_barrier_post((unsigned*)(p.ws + WS_CTL) + 1024, (volatile LAS unsigned*)(lds + LDSCTL_OFF + 64), p.ph_hi);
#ifndef PH_MASK
#define PH_MASK 0xFFFFFFFFu
#endif
#define IN(k) (lo <= (k) && (k) < hi)
#define EN(b) ((PH_MASK >> (b)) & 1u)
#ifndef ATT_PROBE
#define ATT_PROBE 0
#endif
#ifndef DUP_MASK
#define DUP_MASK 0u
#endif
#define DUP(b) (((DUP_MASK >> (b)) & 1u) ? 2 : 1)
#define SEAM(k) do { if (IN(k) && IN((k) + 1)) xcd_barrier(bar); } while (0)

    if (IN(0) && EN(10)) for (int rep_ = 0; rep_ < DUP(10); ++rep_) { prologue_phase(p, lds); __syncthreads(); }
    SEAM(0);
#pragma unroll 1
    for (int l = 0; l < DEPTH; ++l) {
        const int pb = 1 + l * NPL;
        const bf16* WL = wsb(p, WS_W) + (size_t)l * WL_ELEMS;
        const float* modl = wsf(p, WS_MOD) + (size_t)l * 5 * 12288;
        if (IN(pb + 0) && EN(0)) for (int rep_ = 0; rep_ < DUP(0); ++rep_) { if (l == 0) norm_phase<false>(p, l, 0); else norm_phase<true>(p, l, 0); }
        SEAM(pb + 0);
        if (IN(pb + 1) && EN(1)) for (int rep_ = 0; rep_ < DUP(1); ++rep_) {
            { pg8::Gemm g{wsb(p, WS_H), WL + W_IN_T, MROWS, DIN, DMODEL, 0, 0, p.ph_hi}; pg8::StaticOrder S; S.init(MROWS, DIN, G, (int)blockIdx.x);
              pg8::EpiBf16<0> E{wsb(p, WS_Z), DIN, nullptr, 0};
              pg8::gemm_phase<pg8::EpiBf16<0>, pg8::StaticOrder, PG8_ALIGN, PG8_SP2>(lds, g, S, E); }
            { pg8::Gemm g{(const bf16*)(p.ws + WS_H8), (const bf16*)(p.ws + WS_W8 + (size_t)l * 8192 * 2048), MROWS, 4 * DMODEL, DMODEL / 2, 0, 0, p.ph_hi}; pg8::StaticOrder S; S.init(MROWS, 4 * DMODEL, G, (int)blockIdx.x);
              pg8::EpiGateU8 E{p.ws + WS_G, inptr(I_BGATE) + (size_t)l * 4 * DMODEL, 0};
              pg8::gemm_phase<pg8::EpiGateU8, pg8::StaticOrder, false, PG8_SP2>(lds, g, S, E); }
        }
        SEAM(pb + 1);
        if (IN(pb + 2) && EN(2)) { prep_phase(p, l, lds); __syncthreads(); for (int rep_ = 0; rep_ < DUP(2); ++rep_) lru_pass1(p, l, lds); }
        SEAM(pb + 2);
        if (IN(pb + 3) && EN(3)) {
#if ATT_PROBE
            attn_phase<ATT_PROBE>(p, l, lds); __syncthreads();
#endif
            for (int rep_ = 0; rep_ < DUP(3); ++rep_) { attn_phase<0>(p, l, lds); __syncthreads(); } for (int rep_ = 0; rep_ < DUP(11); ++rep_) lru_pass2(p, l, lds); }
        SEAM(pb + 3);
        if (IN(pb + 4) && EN(4)) for (int rep_ = 0; rep_ < DUP(4); ++rep_) dcomb_phase(p, l);
        SEAM(pb + 4);
        if (IN(pb + 5) && EN(5)) for (int rep_ = 0; rep_ < DUP(5); ++rep_) {
            pg8::Gemm g{wsb(p, WS_BR), WL + W_BR_T, MROWS, DMODEL, DMODEL, 0, 0, p.ph_hi}; pg8::StaticOrder S; S.init(MROWS, DMODEL, G, (int)blockIdx.x);
            pg8::EpiMerge E{p.ws + WS_G, wsb(p, WS_H)};
            pg8::gemm_phase<pg8::EpiMerge, pg8::StaticOrder, PG8_ALIGN, PG8_SP2>(lds, g, S, E);
        }
        SEAM(pb + 5);
        if (IN(pb + 6) && EN(6)) {
            pg8::Gemm g{wsb(p, WS_H), WL + W_O_T, MROWS, DMODEL, DMODEL, 0, 0, p.ph_hi}; pg8::StaticOrder S; S.init(MROWS, DMODEL, G, (int)blockIdx.x);
            if (l == 0) { pg8::EpiRes<false, true> E{inptr(I_XP), inptr(I_XS) - (size_t)M_C * DMODEL, p.ws + WS_XB, modl + 2 * 2048, nullptr, 0};
                pg8::gemm_phase<pg8::EpiRes<false, true>, pg8::StaticOrder, PG8_ALIGN, PG8_SP2>(lds, g, S, E); }
            else { pg8::EpiRes<true, true> E{p.ws + WS_XB, p.ws + WS_XB, p.ws + WS_XB, modl + 2 * 2048, nullptr, 0};
                pg8::gemm_phase<pg8::EpiRes<true, true>, pg8::StaticOrder, PG8_ALIGN, PG8_SP2>(lds, g, S, E); }
        }
        SEAM(pb + 6);
        if (IN(pb + 7) && EN(7)) norm_phase<true>(p, l, 1);
        SEAM(pb + 7);
        if (IN(pb + 8) && EN(8)) for (int rep_ = 0; rep_ < DUP(8); ++rep_) {
            pg8::Gemm g{wsb(p, WS_H), WL + W_FF1_T, MROWS, DFF, DMODEL, 0, 0, p.ph_hi}; pg8::StaticOrder S; S.init(MROWS, DFF, G, (int)blockIdx.x);
            pg8::EpiBf16<2> E{wsb(p, WS_G), DFF, inptr(I_BFF1) + (size_t)l * DFF, 0};
            pg8::gemm_phase<pg8::EpiBf16<2>, pg8::StaticOrder, PG8_ALIGN, PG8_SP2>(lds, g, S, E);
        }
        SEAM(pb + 8);
        if (IN(pb + 9) && EN(9)) {
            pg8::Gemm g{wsb(p, WS_G), WL + W_FF2_T, MROWS, DMODEL, DFF, 0, 0, p.ph_hi}; pg8::StaticOrder S; S.init(MROWS, DMODEL, G, (int)blockIdx.x);
            if (l == DEPTH - 1) { pg8::EpiRes<true, false> E{p.ws + WS_XB, p.ws + WS_XB, p.out, modl + 5 * 2048, inptr(I_BFF2) + (size_t)l * DMODEL, 0};
                pg8::gemm_phase<pg8::EpiRes<true, false>, pg8::StaticOrder, PG8_ALIGN, PG8_SP2>(lds, g, S, E); }
            else { pg8::EpiRes<true, true> E{p.ws + WS_XB, p.ws + WS_XB, p.ws + WS_XB, modl + 5 * 2048, inptr(I_BFF2) + (size_t)l * DMODEL, 0};
                pg8::gemm_phase<pg8::EpiRes<true, true>, pg8::StaticOrder, PG8_ALIGN, PG8_SP2>(lds, g, S, E); }
        }
        SEAM(pb + 9);
    }
#undef IN
#undef SEAM
}

#if DBG
#ifndef CHECK_L
#define CHECK_L 0
#endif
constexpr size_t DBG_ERR = WS_DBG;
constexpr size_t DBG_ZS = WS_DBG + 1 * MiB;
constexpr size_t DBG_XS = WS_DBG + 2 * MiB;
constexpr size_t DBG_XS2 = WS_DBG + 3 * MiB;
constexpr size_t DBG_SC = WS_DBG + 4 * MiB;
constexpr size_t DBG_END = WS_DBG + 16 * MiB;
__device__ __forceinline__ unsigned dh(unsigned x) { x ^= x >> 16; x *= 0x7feb352du; x ^= x >> 15; x *= 0x846ca68bu; x ^= x >> 16; return x; }
__device__ __forceinline__ int srow(int i) {
    switch (i) { case 0: return 0; case 1: return 1; case 2: return 255; case 3: return 256; case 4: return 511; case 5: return 8191; case 6: return 8192; case 7: return 8193; case 8: return 8192 + 127; case 9: return 8192 + 128;
        case 10: return 8192 + 4095; case 11: return 8192 + 4096; case 12: return 8192 + 8191; case 13: return 24575; case 14: return 24575 - 4096; case 15: return 4000; default: break; }
    return (int)(dh(i * 7919u + 13u) % (unsigned)MROWS);
}
__device__ __forceinline__ void rep(const Params& p, int stage, float got, float ref, float atol) {
    float e = fabsf(got - ref) / (fabsf(ref) + atol); if (!(e == e) || !(got == got)) e = 1e6f;
    atomicMax((unsigned*)(p.ws + DBG_ERR) + stage, __float_as_uint(e));
}
__device__ __forceinline__ float f8d(unsigned char b) { const int e = (b >> 3) & 15, m = b & 7; const float v = e ? ldexpf(1.0f + m * 0.125f, e - 7) : ldexpf(m * 0.125f, -6); return (b & 128) ? -v : v; }
__device__ __forceinline__ float bfr(float x) { return __uint_as_float(f2bf(x) << 16); }
__device__ __forceinline__ const float* xrow(const Params& p, int l, int r) { return (r < M_C ? xbase_ctx(p, l) : xbase_lat(p, l)) + (size_t)r * 2048; }
__device__ __forceinline__ int rcond(int r) { return r < M_C ? 0 : 1 + ((r - M_C) >> 12); }

__global__ void ck_prologue(Params p, int l) {
    const int gt = blockIdx.x * blockDim.x + threadIdx.x;
    const bf16* WL = wsb(p, WS_W) + (size_t)l * WL_ELEMS;
    {
        const unsigned h0 = dh(gt * 2654435761u + 1u), h1 = dh(h0 + 77u);
        { const int k = h0 % 2048, n = h1 % 4096; rep(p, 0, bf2f(WL[W_IN_T + (size_t)n * 2048 + k]), bfr(p.in[I_WIN][((size_t)l * 2048 + k) * 4096 + n]), 1e-6f); }
        { const int k = h0 % 2048, n = h1 % 8192; rep(p, 0, f8d(p.ws[WS_W8 + ((size_t)l * 8192 + n) * 2048 + k]) * 0.015625f * 0.5f, p.in[I_WGATE][((size_t)l * 2048 + k) * 8192 + n] * 0.5f, 0.02f); }
        { const int b = h0 & 3, k = (h0 >> 2) % 512, n = h1 % 2048; rep(p, 0, bf2f(WL[W_BR_T + (size_t)n * 2048 + b * 512 + k]), bfr(p.in[I_WBR][(((size_t)l * 4 + b) * 512 + k) * 2048 + n]), 1e-6f); }
        { const int k = h0 % 2048, n = h1 % 2048; rep(p, 0, bf2f(WL[W_O_T + (size_t)n * 2048 + k]), bfr(p.in[I_WO][((size_t)l * 2048 + k) * 2048 + n]), 1e-6f); }
        { const int k = h0 % 2048, n = h1 % 8192; rep(p, 0, bf2f(WL[W_FF1_T + (size_t)n * 2048 + k]), bfr(p.in[I_WFF1][((size_t)l * 2048 + k) * 8192 + n]), 1e-6f); }
        { const int k = h0 % 8192, n = h1 % 2048; rep(p, 0, bf2f(WL[W_FF2_T + (size_t)n * 8192 + k]), bfr(p.in[I_WFF2][((size_t)l * 8192 + k) * 2048 + n]), 1e-6f); }
        { const int bl = h0 & 15, s = (h0 >> 4) % 512, c = h1 % 128;
          rep(p, 2, bf2f(wsb(p, CK_WK)[((size_t)bl * 512 + s) * 128 + c]), bfr(p.in[I_CWK][((size_t)bl * 512 + s) * 128 + c]), 1e-6f);
          rep(p, 2, bf2f(wsb(p, CK_GK)[((size_t)bl * 512 + s) * 128 + c]), bfr(p.in[I_CGK][((size_t)bl * 512 + s) * 128 + c]), 1e-6f);
          rep(p, 2, bf2f(wsb(p, CK_WVT)[((size_t)bl * 128 + c) * 512 + (s ^ ((c & 16) >> 2))]), bfr(p.in[I_CWV][((size_t)bl * 512 + s) * 128 + c]), 1e-6f);
          rep(p, 2, bf2f(wsb(p, CK_GVT)[((size_t)bl * 128 + c) * 512 + (s ^ ((c & 16) >> 2))]), bfr(p.in[I_CGV][((size_t)bl * 512 + s) * 128 + c]), 1e-6f);
          const int c5 = h1 % 512;
          rep(p, 2, bf2f(wsb(p, CK_DK)[((size_t)bl * 512 + s) * 512 + c5]), bfr(p.in[I_CDK][((size_t)bl * 512 + s) * 512 + c5]), 1e-6f);
          rep(p, 2, bf2f(wsb(p, CK_DVT)[((size_t)bl * 512 + c5) * 512 + (s ^ ((c5 & 16) >> 2))]), bfr(p.in[I_CDV][((size_t)bl * 512 + s) * 512 + c5]), 1e-6f);
          const int g = h0 & 1, lkn = (h0 >> 1) & 63, c6 = (h0 >> 8) & 63, d6 = h1 & 63;
          rep(p, 2, bf2f(wsb(p, WS_LRUW)[((size_t)(g * 64 + lkn) * 64 + d6) * 64 + c6]), bfr(p.in[g ? I_LWI : I_LWR][((size_t)lkn * 64 + c6) * 64 + d6]), 1e-6f);
          const int pos = h0 & 63, f = h1 & 15; const float ang = (float)pos * powf(10000.f, -(float)f / 16.f);
          rep(p, 2, wsf(p, WS_TAB)[TAB_COS + pos * 16 + f], cosf(ang), 1e-3f); rep(p, 2, wsf(p, WS_TAB)[TAB_SIN + pos * 16 + f], sinf(ang), 1e-3f); }
    }
    if (gt < 1024) { const int cond = gt % 5, j = dh(gt) % 12288; float s = 0.f;
        for (int k = 0; k < 2048; ++k) { const float c = cond == 0 ? p.in[I_CCTX][k] : p.in[I_C][(cond - 1) * 2048 + k]; s += (c / (1.f + expf(-c))) * p.in[I_WADA][((size_t)l * 2048 + k) * 12288 + j]; }
        rep(p, 1, wsf(p, WS_MOD)[((size_t)l * 5 + cond) * 12288 + j], s + p.in[I_BADA][l * 12288 + j], 1e-2f); }
}
__global__ void ck_norm(Params p, int l, int which, int stage) {
    const int r = srow(blockIdx.x); const float* x = xrow(p, l + which, r); __shared__ float red[256];
    float ss = 0.f; for (int c = threadIdx.x; c < 2048; c += 256) ss += x[c] * x[c];
    red[threadIdx.x] = ss; __syncthreads(); for (int o = 128; o > 0; o >>= 1) { if (threadIdx.x < o) red[threadIdx.x] += red[threadIdx.x + o]; __syncthreads(); }
    const float rstd = 1.f / sqrtf(red[0] / 2048.f + 1e-6f); const float* modl = wsf(p, WS_MOD) + ((size_t)l * 5 + rcond(r)) * 12288 + (which ? 3 : 0) * 2048;
    const float* g = p.in[which ? I_N2G : I_N1G] + l * 2048;
    for (int c = threadIdx.x; c < 2048; c += 256) rep(p, stage, bf2f(wsb(p, WS_H)[(size_t)r * 2048 + c]), x[c] * rstd * g[c] * (1.f + modl[2048 + c]) + modl[c], 0.05f);
}
__global__ void ck_gemm(Params p, int l, int mode, int stage) {
    const int r = srow(blockIdx.x); const bf16* WL = wsb(p, WS_W) + (size_t)l * WL_ELEMS;
    const bf16* A; const bf16* Bt; int N, K;
    if (mode == 0) { A = wsb(p, WS_H); Bt = WL + W_IN_T; N = 4096; K = 2048; } else if (mode == 1) { A = wsb(p, WS_H); Bt = WL + W_GATE_T; N = 8192; K = 2048; }
    else if (mode == 2) { A = wsb(p, WS_H); Bt = WL + W_FF1_T; N = 8192; K = 2048; } else if (mode == 3) { A = wsb(p, WS_H); Bt = WL + W_O_T; N = 2048; K = 2048; }
    else { A = wsb(p, WS_G); Bt = WL + W_FF2_T; N = 2048; K = 8192; }
    const int n = dh(blockIdx.x * 1000u + threadIdx.x * 31u + mode) % N;
    float s = 0.f;
    if (mode == 1) { const unsigned char* a8 = p.ws + WS_H8 + (size_t)r * 2048; const unsigned char* b8 = p.ws + WS_W8 + ((size_t)l * 8192 + n) * 2048; for (int k = 0; k < 2048; ++k) s += f8d(a8[k]) * f8d(b8[k]); s *= 0.015625f; }
    else for (int k = 0; k < K; ++k) s += bf2f(A[(size_t)r * K + k]) * bf2f(Bt[(size_t)n * K + k]);
    const float* modl = wsf(p, WS_MOD) + ((size_t)l * 5 + rcond(r)) * 12288;
    if (mode == 0) rep(p, stage, bf2f(wsb(p, WS_Z)[(size_t)r * 4096 + n]), s, 0.05f);
    if (mode == 1) rep(p, stage, bf2f(wsb(p, WS_G)[(size_t)r * 8192 + n]), 1.f + expf(-(s + p.in[I_BGATE][l * 8192 + n])), 0.05f);
    if (mode == 2) { const float a = fmaxf(s + p.in[I_BFF1][l * 8192 + n], 0.f); rep(p, stage, bf2f(wsb(p, WS_G)[(size_t)r * 8192 + n]), a * a, 0.05f); }
    if (mode == 3) rep(p, stage, p.out[(size_t)r * 2048 + n], wsf(p, DBG_XS)[(size_t)blockIdx.x * 2048 + n] + modl[2 * 2048 + n] * s, 0.05f);
    if (mode == 4) rep(p, stage, p.out[(size_t)r * 2048 + n], wsf(p, DBG_XS2)[(size_t)blockIdx.x * 2048 + n] + modl[5 * 2048 + n] * (s + p.in[I_BFF2][l * 2048 + n]), 0.05f);
}
__global__ void ck_save_z(Params p) { const int r = srow(blockIdx.x); for (int c = threadIdx.x; c < 4096; c += blockDim.x) wsb(p, DBG_ZS)[(size_t)blockIdx.x * 4096 + c] = wsb(p, WS_Z)[(size_t)r * 4096 + c]; }
__global__ void ck_save_x(Params p, int l, size_t dst) { const int r = srow(blockIdx.x); const float* x = xrow(p, l, r); for (int c = threadIdx.x; c < 2048; c += blockDim.x) wsf(p, dst)[(size_t)blockIdx.x * 2048 + c] = x[c]; }
__global__ void ck_prep(Params p, int l, int st) {
    const int r = srow(blockIdx.x); const bf16* zs = wsb(p, DBG_ZS) + (size_t)blockIdx.x * 4096; const bf16* z = wsb(p, WS_Z) + (size_t)r * 4096;
    const bool isctx = r < M_C; const int seq = isctx ? r >> 8 : (r - M_C) >> 12, t = isctx ? r & 255 : (r - M_C) & 4095;
    for (int idx = threadIdx.x; idx < 36 * 64; idx += blockDim.x) {
        const int v = idx >> 6, d = idx & 63;
        int col; const float* gain; bool isq; size_t ko = 0;
        if (v < 8) { col = ZC_QW + v * 64; gain = p.in[I_WQN]; isq = true; } else if (v < 10) { col = ZC_KW + (v - 8) * 64; gain = p.in[I_WKN]; isq = false; ko = O_WK + ((size_t)(seq * 4 + l) * 256 + t) * 128 + (v - 8) * 64; }
        else if (v < 18) { col = ZC_QG + (v - 10) * 64; gain = p.in[I_GQN]; isq = true; } else if (v < 20) { col = ZC_KG + (v - 18) * 64; gain = p.in[I_GKN]; isq = false; ko = O_GK + ((size_t)(seq * 4 + l) * 256 + t) * 128 + (v - 18) * 64; }
        else if (v < 28) { col = ZC_QD + (v - 20) * 64; gain = p.in[I_DQN]; isq = true; } else { col = ZC_KD + (v - 28) * 64; gain = p.in[I_DKN]; isq = false; ko = O_DK + ((size_t)(seq * 4 + l) * 256 + t) * 512 + (v - 28) * 64; }
        float ss = 0.f; for (int e = 0; e < 64; ++e) { const float xe = bf2f(zs[col + e]); ss += xe * xe; }
        const float rstd = 1.f / sqrtf(ss / 64.f + 1e-6f);
        float y = bf2f(zs[col + d]) * rstd * gain[l * 64 + d];
        if (isctx && !isq) rep(p, st + 1, p.out[ko + d], y, 0.02f);
        if (!isctx) { const int axis = d >> 5, half = (d >> 4) & 1, f = d & 15; const float pos = axis ? (float)(t & 63) : (float)(t >> 6); const float ang = pos * powf(10000.f, -(float)f / 16.f), c = cosf(ang), sn = sinf(ang);
            const float x1 = bf2f(zs[col + axis * 32 + f]) * rstd * gain[l * 64 + axis * 32 + f], x2 = bf2f(zs[col + axis * 32 + 16 + f]) * rstd * gain[l * 64 + axis * 32 + 16 + f]; y = half ? x2 * c + x1 * sn : x1 * c - x2 * sn; }
        if (isq) y *= 0.125f * 1.4426950408889634f;
        rep(p, st, bf2f(z[col + d]), y, 0.03f);
    }
    for (int idx = threadIdx.x; idx < 96 * 8; idx += blockDim.x) {
        const int g = idx >> 3, j = idx & 7; int col; size_t vo; const bf16* vt; const int T = isctx ? T_C : T_L;
        if (g < 16) { col = ZC_VW + g * 8; vo = O_WV + ((size_t)(seq * 4 + l) * 256 + t) * 128 + g * 8; vt = wsb(p, isctx ? VT_BC : VT_BL) + (size_t)(seq * 128 + g * 8) * T; }
        else if (g < 32) { col = ZC_VG + (g - 16) * 8; vo = O_GV + ((size_t)(seq * 4 + l) * 256 + t) * 128 + (g - 16) * 8; vt = wsb(p, isctx ? VT_CC : VT_CL) + (size_t)(seq * 128 + (g - 16) * 8) * T; }
        else { col = ZC_VD + (g - 32) * 8; vo = O_DV + ((size_t)(seq * 4 + l) * 256 + t) * 512 + (g - 32) * 8; vt = wsb(p, isctx ? VT_DC : VT_DL) + (size_t)(seq * 512 + (g - 32) * 8) * T; }
        const float zv = bf2f(zs[col + j]); if (isctx) rep(p, st + 1, p.out[vo + j], zv, 1e-3f); rep(p, st + 2, bf2f(vt[(size_t)j * T + (t ^ ((((g < 16 ? g : g < 32 ? g - 16 : g - 32) * 8 + j) & 16) >> 2))]), zv, 1e-6f); rep(p, st + 2, bf2f(z[col + j]), zv, 1e-6f);
    }
}
__global__ void ck_lru(Params p, int l, int stage) {
    const int i = blockIdx.x * blockDim.x + threadIdx.x; if (i >= 48) return;
    const bool lat = i < 16; const int seq = lat ? (i & 3) : (int)(dh(i) % 32u), ch = lat ? (int)(dh(i * 3u + 5u) % 512u) : (int)(dh(i * 5u + 1u) % 512u), n = ch >> 6, cl = ch & 63;
    const int T = lat ? T_L : T_C, row0 = lat ? M_C + seq * T_L : seq * T_C; const bf16* Z = wsb(p, WS_Z); float* HF = wsf(p, DBG_SC) + (size_t)i * 4096;
    for (int dir = 0; dir < 2; ++dir) {
        float h = lat ? p.in[I_SLRU][((size_t)(seq * 4 + l) * 2 + dir) * 512 + ch] : 0.f;
        const float spl = log1pf(expf(-p.in[I_LLAM][(l * 2 + dir) * 512 + ch]));
        for (int s = 0; s < T; ++s) { const int t = dir ? T - 1 - s : s;
            float pr = p.in[I_LBR][(l * 2 + dir) * 512 + ch], pi = p.in[I_LBI][(l * 2 + dir) * 512 + ch], umine = 0.f;
            for (int c = 0; c < 64; ++c) { float u = p.in[I_CONVB][l * 512 + n * 64 + c];
                for (int k = 0; k < 4; ++k) { const int tk = t + k - 1; if (tk >= 0 && tk < T) u += p.in[I_CONVW][(l * 4 + k) * 512 + n * 64 + c] * bf2f(Z[(size_t)(row0 + tk) * 4096 + n * 64 + c]); }
                if (c == cl) umine = u;
                const float ub = bfr(u);
                pr += ub * bfr(p.in[I_LWR][((size_t)((l * 2 + dir) * 8 + n) * 64 + c) * 64 + cl]); pi += ub * bfr(p.in[I_LWI][((size_t)((l * 2 + dir) * 8 + n) * 64 + c) * 64 + cl]); }
            const float rg = 1.f / (1.f + expf(-pr)), ig = 1.f / (1.f + expf(-pi)), la = -8.f * rg * spl, a = expf(la), b = sqrtf(-expm1f(2.f * la)) * ig * umine;
            h = a * h + b;
            if (dir == 0) HF[t] = h;
            else { const float y = bf2f(Z[(size_t)(row0 + t) * 4096 + 512 + ch]); const float gl = 0.5f * y * (1.f + tanhf(0.7978845608028654f * (y + 0.044715f * y * y * y)));
                rep(p, stage, bf2f(wsb(p, WS_BR)[(size_t)(row0 + t) * BRP + ch]), (HF[t] + h) * gl, 0.02f); }
        }
        if (!lat) rep(p, stage + 1, p.out[O_LS + ((size_t)(seq * 4 + l) * 2 + dir) * 512 + ch], h, 0.02f);
    }
}
__global__ void ck_attn(Params p, int l, int stage) {
    const int i = blockIdx.x, lane = threadIdx.x; const unsigned h0 = dh(i * 97u + 3u), h1 = dh(h0 + 11u);
    const int type = i % 3; const bool lat = (i / 3) & 1; const int seq = lat ? (h0 & 3) : (h0 & 31), head = (h0 >> 5) & 7;
    int t = lat ? (int)(h1 % 4096u) : (int)(h1 % 256u); if (i < 12) t = (i & 1) ? (lat ? 4095 : 255) : 0; if (i >= 12 && i < 24 && lat) t = 128 + (i & 1);
    const int T = lat ? T_L : T_C, row0 = lat ? M_C + seq * T_L : seq * T_C, r = row0 + t; const bf16* Z = wsb(p, WS_Z); __shared__ float SC[4608];
    int qcol, kcol, vcol, vw, kvh; const float* ck; const float* cv; int cpitch, ckoff, cvoff;
    if (type == 0) { kvh = head >> 2; qcol = ZC_QW + head * 64; kcol = ZC_KW + kvh * 64; vcol = ZC_VW + kvh * 64; vw = 64; ck = p.in[I_CWK]; cv = p.in[I_CWV]; cpitch = 128; ckoff = kvh * 64; cvoff = kvh * 64; }
    else if (type == 1) { kvh = head >> 2; qcol = ZC_QG + head * 64; kcol = ZC_KG + kvh * 64; vcol = ZC_VG + kvh * 64; vw = 64; ck = p.in[I_CGK]; cv = p.in[I_CGV]; cpitch = 128; ckoff = kvh * 64; cvoff = kvh * 64; }
    else { qcol = ZC_QD + head * 64; kcol = ZC_KD + head * 64; vcol = ZC_VD + (head >> 1) * 128; vw = 128; ck = p.in[I_CDK]; cv = p.in[I_CDV]; cpitch = 512; ckoff = head * 64; cvoff = (head >> 1) * 128; }
    const int nk = lat ? T_L + PAST : T_C; float q[64];
#pragma unroll
    for (int d = 0; d < 64; ++d) q[d] = bf2f(Z[(size_t)r * 4096 + qcol + d]);
    float mx = -1e30f;
    for (int k = lane; k < nk; k += 64) { float s = 0.f; bool ok = true;
        if (k < T) {
#pragma unroll
            for (int d = 0; d < 64; ++d) s += q[d] * bf2f(Z[(size_t)(row0 + k) * 4096 + kcol + d]); if (type == 0 && lat) { int dd = t - k; dd = dd < 0 ? -dd : dd; ok = dd <= 128; } }
        else { const float* kp = ck + ((size_t)(seq * 4 + l) * 512 + (k - T)) * cpitch + ckoff;
#pragma unroll
            for (int d = 0; d < 64; ++d) s += q[d] * kp[d]; }
        s = ok ? s : -INFINITY; SC[k] = s; mx = fmaxf(mx, s); }
    for (int o = 32; o > 0; o >>= 1) mx = fmaxf(mx, __shfl_xor(mx, o));
    float sum = 0.f; for (int k = lane; k < nk; k += 64) { const float e = exp2f(SC[k] - mx); SC[k] = e; sum += e; }
    for (int o = 32; o > 0; o >>= 1) sum += __shfl_xor(sum, o);
    __syncthreads();
    if (type == 0) sum += exp2f(p.in[I_WSINK][l * 8 + head] * 1.4426950408889634f - mx);
    __syncthreads();
    for (int d = lane; d < vw; d += 64) { float o = 0.f;
        for (int k = 0; k < nk; ++k) { const float v = k < T ? bf2f(Z[(size_t)(row0 + k) * 4096 + vcol + d]) : cv[((size_t)(seq * 4 + l) * 512 + (k - T)) * cpitch + cvoff + d]; o += SC[k] * v; }
        o /= sum;
        const float got = type == 0 ? bf2f(wsb(p, WS_BR)[(size_t)r * BRP + 512 + head * 64 + d]) : type == 1 ? bf2f(wsb(p, WS_BR)[(size_t)r * BRP + 1024 + head * 64 + d]) : bf2f(wsb(p, WS_OD)[(size_t)r * 1024 + head * 128 + d]);
        rep(p, stage + type, got, o, 0.02f); }
}
__global__ void ck_dcomb(Params p, int l, int stage) {
    const int r = srow(blockIdx.x), h = threadIdx.x >> 7, e = threadIdx.x & 127; __shared__ float red[512];
    float s1 = 0.f, s2 = 0.f; for (int d = 0; d < 64; ++d) { s1 += p.in[I_LQ1][l * 64 + d] * p.in[I_LK1][l * 64 + d]; s2 += p.in[I_LQ2][l * 64 + d] * p.in[I_LK2][l * 64 + d]; }
    const float li = 0.8f - 0.6f * expf(-0.3f * l), lam = expf(s1) - expf(s2) + li;
    const float o = bf2f(wsb(p, WS_OD)[(size_t)r * 1024 + (h * 2) * 128 + e]) - lam * bf2f(wsb(p, WS_OD)[(size_t)r * 1024 + (h * 2 + 1) * 128 + e]);
    red[threadIdx.x] = o * o; __syncthreads(); for (int st = 64; st > 0; st >>= 1) { if (e < st) red[threadIdx.x] += red[threadIdx.x + st]; __syncthreads(); }
    rep(p, stage, bf2f(wsb(p, WS_BR)[(size_t)r * BRP + 1536 + h * 128 + e]), o / sqrtf(red[h * 128] / 128.f + 1e-6f) * p.in[I_DOG][l * 128 + e] * (1.f - li), 0.02f);
}
__global__ void ck_merge(Params p, int l, int stage) {
    const int r = srow(blockIdx.x), n = dh(blockIdx.x * 777u + threadIdx.x) % 2048; const bf16* WL = wsb(p, WS_W) + (size_t)l * WL_ELEMS; float tot = 0.f;
    for (int b = 0; b < 4; ++b) { float s = 0.f; for (int c = 0; c < 512; ++c) s += bf2f(wsb(p, WS_BR)[(size_t)r * BRP + b * 512 + c]) * bf2f(WL[W_BR_T + (size_t)n * 2048 + b * 512 + c]);
        tot += s / bf2f(wsb(p, WS_G)[(size_t)r * 8192 + b * 2048 + n]); }
    rep(p, stage, bf2f(wsb(p, WS_H)[(size_t)r * 2048 + n]), tot, 0.05f);
}
__global__ void ck_encode(Params p) {
    if (threadIdx.x || blockIdx.x) return; const float* e = wsf(p, DBG_ERR);
    for (int s = 0; s < 64; ++s) if (e[s] > 0.06f) { int q = (int)floorf(log10f(e[s])); q = q < -6 ? -6 : q > 3 ? 3 : q; p.out[0] = (float)(10 + s) * powf(10.f, (float)(12 + q)); return; }
}
static void dbg_run(Params p, int grid, hipStream_t stream) {
    (void)hipMemsetAsync(p.ws + DBG_ERR, 0, 256, stream);
    auto ph = [&](int k) { p.ph_lo = k; p.ph_hi = k + 1; hipLaunchKernelGGL(fwd_kernel, dim3(grid), dim3(512), LDS_BYTES, stream, p); };
    ph(0);
    hipLaunchKernelGGL(ck_prologue, dim3(64), dim3(256), 0, stream, p, CHECK_L);
    for (int l = 0; l < DEPTH; ++l) {
        const int pb = 1 + l * NPL; const bool c = (l == CHECK_L);
        ph(pb + 0); if (c) hipLaunchKernelGGL(ck_norm, dim3(64), dim3(256), 0, stream, p, l, 0, 3);
        ph(pb + 1); if (c) { hipLaunchKernelGGL(ck_gemm, dim3(64), dim3(128), 0, stream, p, l, 0, 4); hipLaunchKernelGGL(ck_gemm, dim3(64), dim3(128), 0, stream, p, l, 1, 5); hipLaunchKernelGGL(ck_save_z, dim3(64), dim3(256), 0, stream, p); }
        ph(pb + 2); if (c) hipLaunchKernelGGL(ck_prep, dim3(64), dim3(256), 0, stream, p, l, 6);
        ph(pb + 3); if (c) { hipLaunchKernelGGL(ck_lru, dim3(1), dim3(64), 0, stream, p, l, 9); hipLaunchKernelGGL(ck_attn, dim3(240), dim3(64), 0, stream, p, l, 11); }
        ph(pb + 4); if (c) hipLaunchKernelGGL(ck_dcomb, dim3(64), dim3(512), 0, stream, p, l, 14);
        ph(pb + 5); if (c) { hipLaunchKernelGGL(ck_merge, dim3(64), dim3(128), 0, stream, p, l, 15); hipLaunchKernelGGL(ck_save_x, dim3(64), dim3(256), 0, stream, p, l, DBG_XS); }
        ph(pb + 6); if (c) { hipLaunchKernelGGL(ck_gemm, dim3(64), dim3(128), 0, stream, p, l, 3, 16); hipLaunchKernelGGL(ck_save_x, dim3(64), dim3(256), 0, stream, p, l + 1, DBG_XS2); }
        ph(pb + 7); if (c) hipLaunchKernelGGL(ck_norm, dim3(64), dim3(256), 0, stream, p, l, 1, 17);
        ph(pb + 8); if (c) hipLaunchKernelGGL(ck_gemm, dim3(64), dim3(128), 0, stream, p, l, 2, 18);
        ph(pb + 9); if (c) hipLaunchKernelGGL(ck_gemm, dim3(64), dim3(128), 0, stream, p, l, 4, 19);
    }
    hipLaunchKernelGGL(ck_encode, dim3(1), dim3(64), 0, stream, p);
}
#endif

extern "C" void kernel_launch(void* const* d_in, const int* in_sizes, int n_in, void* d_out, int out_size, void* d_ws, size_t ws_size, hipStream_t stream) {
    static int grid = 0;
    if (grid == 0) {
        size_t need = WS_END;
#if DBG
        need = DBG_END;
#endif
        if (n_in != N_IN || (size_t)out_size != O_END || ws_size < need) { fprintf(stderr, "kernel_launch: unexpected sizes: n_in %d out %d ws %zu (need %zu); nothing launched\n", n_in, out_size, ws_size, need); grid = -1; return; }
        int dev = 0, cus = 0, per_cu = 0;
        if (hipGetDevice(&dev) != hipSuccess || hipDeviceGetAttribute(&cus, hipDeviceAttributeMultiprocessorCount, dev) != hipSuccess) { grid = -1; return; }
        if (hipFuncSetAttribute((const void*)fwd_kernel, hipFuncAttributeMaxDynamicSharedMemorySize, LDS_BYTES) != hipSuccess) { fprintf(stderr, "kernel_launch: hipFuncSetAttribute failed\n"); grid = -1; return; }
        if (hipOccupancyMaxActiveBlocksPerMultiprocessor(&per_cu, (const void*)fwd_kernel, 512, LDS_BYTES) != hipSuccess || per_cu < 1) { fprintf(stderr, "kernel_launch: occupancy query says %d\n", per_cu); grid = -1; (void)hipGetLastError(); return; }
        grid = cus;
    }
    if (grid < 0) return;
    (void)hipMemsetAsync(d_ws, 0, ZERO_BYTES, stream);
    Params p{};
    for (int i = 0; i < N_IN; ++i) p.in[i] = (const float*)d_in[i];
    p.out = (float*)d_out; p.ws = (unsigned char*)d_ws;
#if DBG
    dbg_run(p, grid, stream);
#else
#if MULTI
    for (int ph = 0; ph < N_PHASES; ++ph) { p.ph_lo = ph; p.ph_hi = ph + 1; hipLaunchKernelGGL(fwd_kernel, dim3(grid), dim3(512), LDS_BYTES, stream, p); }
#else
    p.ph_lo = 0; p.ph_hi = N_PHASES;
    hipLaunchKernelGGL(fwd_kernel, dim3(grid), dim3(512), LDS_BYTES, stream, p);
#endif
#endif
}
```

```cpp
#include <hip/hip_runtime.h>
#include <cstdio>
#include <cstdint>

__device__ __forceinline__ float shfl_xor_l(float v, int o, int lane) { return __int_as_float(__builtin_amdgcn_ds_bpermute((lane ^ o) << 2, __float_as_int(v))); }
__device__ __forceinline__ int opaque_tid(int wv) { unsigned m = ~0u; asm volatile("" : "+s"(m), "+s"(wv));
    int t = (wv << 6) | (int)__builtin_amdgcn_mbcnt_hi(m, __builtin_amdgcn_mbcnt_lo(m, 0u)); asm volatile("" : "+v"(t)); return t; }

__device__ __forceinline__ const float* inptr(int i) {
    const float* const __attribute__((address_space(4)))* ka = (const float* const __attribute__((address_space(4)))*)__builtin_amdgcn_kernarg_segment_ptr();
    asm volatile("" : "+s"(i)); return ka[i]; }

#ifndef MULTI
#define MULTI 0
#endif
#ifndef DBG
#define DBG 0
#endif

namespace pg8 {
#define PG8_LAS __attribute__((address_space(3)))
typedef unsigned short bf16_t;
typedef short bf16x8 __attribute__((ext_vector_type(8)));
typedef float f32x4 __attribute__((ext_vector_type(4)));
typedef unsigned u32x4 __attribute__((ext_vector_type(4)));
constexpr int BM = 256, BK = 64, HALF = 128, HTB = HALF * BK * 2  , STAGE_BYTES = 8 * HTB, NXCD = 8, WGM = 4;

__host__ __device__ __forceinline__ int lds_byte(int r, int c) { const int st = (r >> 4) * 2 + (c >> 5), rr = r & 15, cc = c & 31, ob = rr * 64 + cc * 2; return st * 1024 + (ob ^ (((ob >> 9) & 1) << 5)); }
__host__ __device__ __forceinline__ void stage_rc(int b, int& R, int& C) { const int st = b / 1024, sb = b % 1024, swz = sb ^ (((sb >> 9) & 1) << 5); R = (st >> 1) * 16 + swz / 64; C = (st & 1) * 32 + (swz % 64) / 2; }
__host__ __device__ __forceinline__ int perm64(int R) { return 64 * (R >> 5) + 16 * ((R >> 2) & 3) + 4 * ((R >> 4) & 1) + (R & 3); }
__host__ __device__ __forceinline__ int perm32(int rho) { const int n = rho >> 4, i = rho & 15; return 8 * (i >> 2) + 4 * n + (i & 3); }

struct Unit { int pm, pn, kb; };
struct Gemm { const bf16_t* A; const bf16_t* Bt; int M, N, K; size_t a_kb, b_kb; int wv; };

struct StaticOrder {
    int nM, nN, nwg, G, c;
    __host__ __device__ void init(int M, int N, int G_, int c_) { nM = M / BM; nN = N / BM; nwg = nM * nN; G = G_; c = c_; }
    __host__ __device__ bool next(int i, Unit& u) const {
        const long L = (long)i * G + c; if (L >= nwg) return false;
        int wgid = (int)L; { const int q = nwg / NXCD, r = nwg % NXCD, xcd = wgid % NXCD, off = wgid / NXCD; wgid = (xcd < r ? xcd * (q + 1) : r * (q + 1) + (xcd - r) * q) + off; }
        const int nig = WGM * nN, gid = wgid / nig, fm = gid * WGM, gsz = (nM - fm) < WGM ? (nM - fm) : WGM;
        u.pm = fm + ((wgid % nig) % gsz); u.pn = (wgid % nig) / gsz; u.kb = 0; return true;
    }
    __device__ __forceinline__ void a_ready(const Unit&) const {}
    __device__ __forceinline__ void done(const Unit&) const {}
};
struct BankOrder : StaticOrder {
    __host__ __device__ bool next(int i, Unit& u) const { if (!StaticOrder::next(i >> 2, u)) return false; u.kb = i & 3; return true; }
};

typedef float f32x2_t __attribute__((ext_vector_type(2))); typedef __bf16 bf16x2_t __attribute__((ext_vector_type(2)));
__device__ __forceinline__ unsigned cvt_pk_bf16(float lo, float hi) { f32x2_t v = {lo, hi}; bf16x2_t b = __builtin_convertvector(v, bf16x2_t); return __builtin_bit_cast(unsigned, b); }
__device__ __forceinline__ float bf_lo(unsigned u) { return __uint_as_float(u << 16); }
__device__ __forceinline__ float bf_hi(unsigned u) { return __uint_as_float(u & 0xffff0000u); }
__device__ __forceinline__ float sigmoidf_fast(float x) { return __builtin_amdgcn_rcpf(1.0f + __builtin_amdgcn_exp2f(-1.4426950408889634f * x)); }

template <int ACT, bool F8 = false> struct EpiBf16 {
    static constexpr bool PERM = true, AFTER_DRAIN = false, SEG = false, FP8 = F8;
    bf16_t* O; int ldc; const float* bias; int pm_off;
    __device__ __forceinline__ void operator()(const f32x4 (&acc)[2][2][4][2], const Unit& u, int wr, int wc, int fr, int fq) const {
        const int row0 = (u.pm + pm_off) * BM + wr * 64 + fr; const int col0 = u.pn * BM + wc * 32 + 8 * fq;
        f32x4 bv[2][2];
#pragma unroll
        for (int bj = 0; bj < 2; ++bj)
#pragma unroll
            for (int n = 0; n < 2; ++n) bv[bj][n] = (ACT != 0) ? *(const f32x4*)(bias + col0 + bj * HALF + 4 * n) : (f32x4){0.f, 0.f, 0.f, 0.f};
#pragma unroll
        for (int ai = 0; ai < 2; ++ai)
#pragma unroll
            for (int m = 0; m < 4; ++m) { bf16_t* rowp = O + (size_t)(row0 + ai * HALF + m * 16) * ldc + col0;
#pragma unroll
                for (int bj = 0; bj < 2; ++bj) { f32x4 v0 = (F8 ? acc[ai][bj][m][0] * 0.015625f : acc[ai][bj][m][0]) + bv[bj][0], v1 = (F8 ? acc[ai][bj][m][1] * 0.015625f : acc[ai][bj][m][1]) + bv[bj][1];
                    if (ACT == 1) {
#pragma unroll
                        for (int j = 0; j < 4; ++j) { v0[j] = sigmoidf_fast(v0[j]); v1[j] = sigmoidf_fast(v1[j]); } }
                    if (ACT == 2) {
#pragma unroll
                        for (int j = 0; j < 4; ++j) { const float a = fmaxf(v0[j], 0.f), b = fmaxf(v1[j], 0.f); v0[j] = a * a; v1[j] = b * b; } }
                    if (ACT == 3) {
#pragma unroll
                        for (int j = 0; j < 4; ++j) { v0[j] = 1.0f + __builtin_amdgcn_exp2f(-1.4426950408889634f * v0[j]); v1[j] = 1.0f + __builtin_amdgcn_exp2f(-1.4426950408889634f * v1[j]); } }
                    u32x4 w; w.x = cvt_pk_bf16(v0[0], v0[1]); w.y = cvt_pk_bf16(v0[2], v0[3]); w.z = cvt_pk_bf16(v1[0], v1[1]); w.w = cvt_pk_bf16(v1[2], v1[3]);
                    __builtin_nontemporal_store(w, (u32x4*)(rowp + bj * HALF)); } }
    }
};
struct EpiGateU8 {
    static constexpr int PERM = 2; static constexpr bool AFTER_DRAIN = false, SEG = false, FP8 = true;
    unsigned char* O; const float* bias; int pm_off;
    __device__ __forceinline__ void operator()(const f32x4 (&acc)[2][2][4][2], const Unit& u, int wr, int wc, int fr, int fq) const {
        const int row0 = (u.pm + pm_off) * BM + wr * 64 + fr; const int col0 = u.pn * BM + wc * 64 + 16 * fq;
        f32x4 bv[2][2];
#pragma unroll
        for (int bj = 0; bj < 2; ++bj)
#pragma unroll
            for (int n = 0; n < 2; ++n) bv[bj][n] = *(const f32x4*)(bias + col0 + 8 * bj + 4 * n);
#pragma unroll
        for (int ai = 0; ai < 2; ++ai)
#pragma unroll
            for (int m = 0; m < 4; ++m) { u32x4 w;
#pragma unroll
                for (int bj = 0; bj < 2; ++bj)
#pragma unroll
                    for (int n = 0; n < 2; ++n) { const f32x4 v = acc[ai][bj][m][n] * 0.015625f + bv[bj][n]; unsigned q = 0;
#pragma unroll
                        for (int j = 0; j < 4; ++j) {
                            const float t = __builtin_amdgcn_rcpf(0.00390640259f + __builtin_amdgcn_exp2f(-1.4426950408889634f * v[j] - 7.99994364f));
                            q |= (unsigned)(int)t << (8 * j); }
                        w[2 * bj + n] = q; }
                __builtin_nontemporal_store(w, (u32x4*)(O + (size_t)(row0 + ai * HALF + m * 16) * 8192 + col0)); }
    }
};
template <bool SRC_BF, bool DST_BF> struct EpiRes {
    static constexpr bool PERM = true, AFTER_DRAIN = false, SEG = false, FP8 = false;
    const void* b_ctx; const void* b_lat; void* out; const float* gate  ; const float* bias; int pm_off;
    __device__ __forceinline__ void operator()(const f32x4 (&acc)[2][2][4][2], const Unit& u, int wr, int wc, int fr, int fq) const {
        const int pmg = u.pm + pm_off;
        const int row0 = pmg * BM + wr * 64 + fr, col0 = u.pn * BM + wc * 32 + 8 * fq;
        const int cond = pmg < 32 ? 0 : 1 + ((pmg - 32) >> 4);
        const void* base = pmg < 32 ? b_ctx : b_lat; const float* gp = gate + (size_t)cond * (6 * 2048);
        f32x4 bv[2][2], gv[2][2];
#pragma unroll
        for (int bj = 0; bj < 2; ++bj)
#pragma unroll
            for (int n = 0; n < 2; ++n) { bv[bj][n] = bias ? *(const f32x4*)(bias + col0 + bj * HALF + 4 * n) : (f32x4){0.f, 0.f, 0.f, 0.f}; gv[bj][n] = *(const f32x4*)(gp + col0 + bj * HALF + 4 * n); }
        if constexpr (SRC_BF) {
#pragma unroll
            for (int ai = 0; ai < 2; ++ai) {
                u32x4 xr[4][2];
#pragma unroll
                for (int m = 0; m < 4; ++m)
#pragma unroll
                    for (int bj = 0; bj < 2; ++bj) xr[m][bj] = *(const u32x4*)((const bf16_t*)base + (size_t)(row0 + ai * HALF + m * 16) * 2048 + col0 + bj * HALF);
                asm volatile("" ::: "memory");
#pragma unroll
                for (int m = 0; m < 4; ++m) { const size_t off = (size_t)(row0 + ai * HALF + m * 16) * 2048 + col0;
#pragma unroll
                    for (int bj = 0; bj < 2; ++bj) { const u32x4 r = xr[m][bj];
                        const f32x4 x0 = (f32x4){bf_lo(r.x), bf_hi(r.x), bf_lo(r.y), bf_hi(r.y)}, x1 = (f32x4){bf_lo(r.z), bf_hi(r.z), bf_lo(r.w), bf_hi(r.w)};
                        const f32x4 y0 = x0 + gv[bj][0] * (acc[ai][bj][m][0] + bv[bj][0]), y1 = x1 + gv[bj][1] * (acc[ai][bj][m][1] + bv[bj][1]);
                        if (DST_BF) { u32x4 w; w.x = cvt_pk_bf16(y0[0], y0[1]); w.y = cvt_pk_bf16(y0[2], y0[3]); w.z = cvt_pk_bf16(y1[0], y1[1]); w.w = cvt_pk_bf16(y1[2], y1[3]); *(u32x4*)((bf16_t*)out + off + bj * HALF) = w; }
                        else { float* q = (float*)out + off + bj * HALF; *(f32x4*)q = y0; *(f32x4*)(q + 4) = y1; } } }
                asm volatile("" ::: "memory");
            }
        } else {
#pragma unroll
        for (int ai = 0; ai < 2; ++ai)
#pragma unroll
            for (int m = 0; m < 4; ++m) { const size_t off = (size_t)(row0 + ai * HALF + m * 16) * 2048 + col0;
#pragma unroll
                for (int bj = 0; bj < 2; ++bj) { const float* q0 = (const float*)base + off + bj * HALF; const f32x4 x0 = *(const f32x4*)q0, x1 = *(const f32x4*)(q0 + 4);
                    const f32x4 y0 = x0 + gv[bj][0] * (acc[ai][bj][m][0] + bv[bj][0]), y1 = x1 + gv[bj][1] * (acc[ai][bj][m][1] + bv[bj][1]);
                    if (DST_BF) { u32x4 w; w.x = cvt_pk_bf16(y0[0], y0[1]); w.y = cvt_pk_bf16(y0[2], y0[3]); w.z = cvt_pk_bf16(y1[0], y1[1]); w.w = cvt_pk_bf16(y1[2], y1[3]); *(u32x4*)((bf16_t*)out + off + bj * HALF) = w; }
                    else { float* q = (float*)out + off + bj * HALF; *(f32x4*)q = y0; *(f32x4*)(q + 4) = y1; } }
                if (m & 1) asm volatile("" ::: "memory"); }
        }
    }
};
struct EpiMerge {
    static constexpr int PERM = 2; static constexpr bool AFTER_DRAIN = false, SEG = true, FP8 = false;
    const unsigned char* E; bf16_t* O;
    static __device__ __forceinline__ float ub(unsigned w, int j) { return (float)((w >> (8 * j)) & 0xffu); }
    __device__ __forceinline__ void seg(f32x4 (&acc)[2][2][4][2], const Unit& u, int b, int wr, int wc, int fr, int fq) const {
        const unsigned char* ep = E + (size_t)(u.pm * BM + wr * 64 + fr) * 8192 + b * 2048 + u.pn * BM + wc * 64 + 16 * fq;
#pragma unroll
        for (int ai = 0; ai < 2; ++ai) {
            u32x4 e0[4], e1[4];
#pragma unroll
            for (int m = 0; m < 4; ++m) { const unsigned char* q = ep + (size_t)(ai * HALF + m * 16) * 8192; e0[m] = *(const u32x4*)q; e1[m] = *(const u32x4*)(q + 2048); }
#pragma unroll
            for (int m = 0; m < 4; ++m)
#pragma unroll
                for (int bj = 0; bj < 2; ++bj)
#pragma unroll
                    for (int n = 0; n < 2; ++n)
#pragma unroll
                        for (int j = 0; j < 4; ++j) acc[ai][bj][m][n][j] *= (ub(e0[m][2 * bj + n], j) + 0.5f) * __builtin_amdgcn_rcpf(ub(e1[m][2 * bj + n], j) + 0.5f);
            asm volatile("" ::: "memory");
        }
    }
    __device__ __forceinline__ void operator()(const f32x4 (&acc)[2][2][4][2], const Unit& u, int wr, int wc, int fr, int fq) const {
        const int row0 = u.pm * BM + wr * 64 + fr; const int col0 = u.pn * BM + wc * 64 + 16 * fq;
        u32x4 gr[2][4];
#pragma unroll
        for (int ai = 0; ai < 2; ++ai)
#pragma unroll
            for (int m = 0; m < 4; ++m) gr[ai][m] = *(const u32x4*)(E + (size_t)(row0 + ai * HALF + m * 16) * 8192 + 3 * 2048 + col0);
        asm volatile("" ::: "memory");
#pragma unroll
        for (int ai = 0; ai < 2; ++ai)
#pragma unroll
            for (int m = 0; m < 4; ++m) { const size_t row = (size_t)(row0 + ai * HALF + m * 16);
                const u32x4 g = gr[ai][m];
#pragma unroll
                for (int bj = 0; bj < 2; ++bj) { f32x4 v0 = acc[ai][bj][m][0], v1 = acc[ai][bj][m][1];
#pragma unroll
                    for (int j = 0; j < 4; ++j) { v0[j] *= ub(g[2 * bj], j) * 0.00390640259f + 0.001953201295f; v1[j] *= ub(g[2 * bj + 1], j) * 0.00390640259f + 0.001953201295f; }
                    u32x4 w; w.x = cvt_pk_bf16(v0[0], v0[1]); w.y = cvt_pk_bf16(v0[2], v0[3]); w.z = cvt_pk_bf16(v1[0], v1[1]); w.w = cvt_pk_bf16(v1[2], v1[3]);
                    *(u32x4*)(O + row * 2048 + col0 + 8 * bj) = w; } }
    }
};

template <class Epi, class Sched, bool ALIGN_EPI = false, bool SP2 = false>
__device__ __forceinline__ void gemm_phase(PG8_LAS unsigned char* lds, const Gemm g, const Sched& S, const Epi& E) {
    typedef int v4i_t __attribute__((ext_vector_type(4))); typedef int v8i_t __attribute__((ext_vector_type(8)));
    int sc8_ = 0x7F7F7F7F; asm volatile("" : "+v"(sc8_));
    int tid_ = opaque_tid(g.wv);
    const int tid = tid_, wid = __builtin_amdgcn_readfirstlane(tid >> 6), lane = tid & 63, wr = wid >> 2, wc = wid & 3, fr = lane & 15, fq = lane >> 4;
    const int K = g.K, nt = K / BK;
    unsigned voffA[2], voffB[2];
#pragma unroll
    for (int i = 0; i < 2; ++i) { int R, C; stage_rc(tid * 16 + i * 8192, R, C); const int Rb = Epi::PERM == 2 ? perm64(R) : Epi::PERM ? ((R & ~31) + perm32(R & 31)) : R;
        voffA[i] = (unsigned)(R * K + C) * 2u; voffB[i] = (unsigned)(Rb * K + C) * 2u; }
    const size_t kstep = (size_t)(BK * 2);
    const size_t hstep = (size_t)HALF * K * 2;
    const size_t hstepB = Epi::PERM == 2 ? (size_t)(8 * K * 2) : hstep;
    const size_t tstep = 2 * hstep;
    const unsigned ldsw = (unsigned)wid * 1024u; const unsigned ldsbase = (unsigned)__builtin_amdgcn_readfirstlane((int)((unsigned)(unsigned long long)(lds) + (unsigned)wid * 1024u));
    const int aoff = lds_byte(wr * 64 + fr, fq * 8), boff = lds_byte(wc * 32 + fr, fq * 8);
#define PG8_SA(b, h) (((b) * 2 + (h)) * HTB)
#define PG8_SB(b, h) ((4 + (b) * 2 + (h)) * HTB)
#define PG8_STAGE(bufoff, gbase, voff) do { _Pragma("unroll") for (int _i = 0; _i < 2; ++_i) { unsigned keep_; \
        asm volatile("s_mov_b32 %0, m0\n\ts_mov_b32 m0, %3\n\ts_nop 0\n\tglobal_load_lds_dwordx4 %1, %2\n\ts_mov_b32 m0, %0" : "=&s"(keep_) : "v"((voff)[_i]), "s"((const char*)(gbase)), "s"(ldsbase + (unsigned)((bufoff) + _i * 8192)) : "memory"); } } while (0)
#define PG8_LDA(dst, b, h) do { _Pragma("unroll") for (int m = 0; m < 4; ++m) _Pragma("unroll") for (int k = 0; k < 2; ++k) dst[m][k] = *(const PG8_LAS bf16x8*)(lds + PG8_SA(b, h) + aoff + m * 2048 + k * 1024); } while (0)
#define PG8_LDB(dst, b, h) do { _Pragma("unroll") for (int n = 0; n < 2; ++n) _Pragma("unroll") for (int k = 0; k < 2; ++k) dst[n][k] = *(const PG8_LAS bf16x8*)(lds + PG8_SB(b, h) + boff + n * 2048 + k * 1024); } while (0)
#define PG8_CAT8(x0, x1) __builtin_shufflevector(__builtin_bit_cast(v4i_t, x0), __builtin_bit_cast(v4i_t, x1), 0, 1, 2, 3, 4, 5, 6, 7)
#define PG8_MMA(ai, bj, At, Bt) do { __builtin_amdgcn_s_setprio(1); \
        if constexpr (Epi::FP8) { _Pragma("unroll") for (int m = 0; m < 4; ++m) _Pragma("unroll") for (int n = 0; n < 2; ++n) { \
            const v8i_t b8_ = PG8_CAT8(Bt[n][0], Bt[n][1]), a8_ = PG8_CAT8(At[m][0], At[m][1]); \
              \
            asm volatile("v_mfma_scale_f32_16x16x128_f8f6f4 %0, %1, %2, %0, %3, %3 op_sel_hi:[0,0,0]" : "+v"(acc[ai][bj][m][n]) : "v"(b8_), "v"(a8_), "v"(sc8_)); } } \
        else { _Pragma("unroll") for (int m = 0; m < 4; ++m) _Pragma("unroll") for (int n = 0; n < 2; ++n) _Pragma("unroll") for (int k = 0; k < 2; ++k) \
            acc[ai][bj][m][n] = __builtin_amdgcn_mfma_f32_16x16x32_bf16(Bt[n][k], At[m][k], acc[ai][bj][m][n], 0, 0, 0); } \
        __builtin_amdgcn_s_setprio(0); } while (0)
#define PG8_WAIT_V(n) asm volatile("s_waitcnt vmcnt(" #n ")" ::: "memory")
#define PG8_WAIT_L(n) asm volatile("s_waitcnt lgkmcnt(" #n ")" ::: "memory")
#define PG8_BAR __builtin_amdgcn_s_barrier()
#define PG8_SCHED __builtin_amdgcn_sched_barrier(0)
    float zacc_ = 0.f; asm volatile("" : "+v"(zacc_));
    Unit cur, nxt; int ui = 0;
    if (!S.next(0, cur)) return;
    f32x4 acc[2][2][4][2];
#pragma unroll
    for (int a = 0; a < 2; ++a)
#pragma unroll
        for (int b = 0; b < 2; ++b)
#pragma unroll
            for (int m = 0; m < 4; ++m)
#pragma unroll
                for (int n = 0; n < 2; ++n) acc[a][b][m][n] = (f32x4){zacc_, zacc_, zacc_, zacc_};
    bf16x8 At[4][2], B0[2][2], B1[2][2];
    const char* cA = (const char*)g.A + (size_t)cur.kb * g.a_kb + (size_t)cur.pm * tstep; const char* cB = (const char*)g.Bt + (size_t)cur.kb * g.b_kb + (size_t)cur.pn * tstep;
    S.a_ready(cur);
    if constexpr (SP2) {
        PG8_STAGE(PG8_SB(0, 0), cB, voffB); PG8_STAGE(PG8_SB(0, 1), cB + hstepB, voffB); PG8_STAGE(PG8_SA(0, 0), cA, voffA); PG8_STAGE(PG8_SA(0, 1), cA + hstep, voffA);
        if (wr == 1) PG8_BAR;
        PG8_WAIT_V(2); PG8_BAR;
        PG8_STAGE(PG8_SB(1, 0), cB + kstep, voffB); PG8_STAGE(PG8_SA(1, 0), cA + kstep, voffA); PG8_STAGE(PG8_SB(1, 1), cB + hstepB + kstep, voffB);
        PG8_WAIT_V(6); PG8_BAR;
    } else {
        PG8_STAGE(PG8_SB(0, 0), cB, voffB); PG8_STAGE(PG8_SA(0, 0), cA, voffA); PG8_STAGE(PG8_SB(0, 1), cB + hstepB, voffB); PG8_STAGE(PG8_SA(0, 1), cA + hstep, voffA);
        if (wr == 1) PG8_BAR;
        PG8_WAIT_V(4); PG8_BAR;
        PG8_STAGE(PG8_SB(1, 0), cB + kstep, voffB); PG8_STAGE(PG8_SA(1, 0), cA + kstep, voffA); PG8_STAGE(PG8_SB(1, 1), cB + hstepB + kstep, voffB);
        PG8_WAIT_V(6); PG8_BAR;
    }
    for (;;) {
        const bool has_next = S.next(ui + 1, nxt);
        const char* nA = has_next ? (const char*)g.A + (size_t)nxt.kb * g.a_kb + (size_t)nxt.pm * tstep : cA; const char* nB = has_next ? (const char*)g.Bt + (size_t)nxt.kb * g.b_kb + (size_t)nxt.pn * tstep : cB;
        for (int t = 0; t < nt; t += 2) {
            const bool last = (t == nt - 2);
            const char* a1 = cA + (size_t)(t + 1) * kstep;
            const char* a2 = last ? nA : cA + (size_t)(t + 2) * kstep; const char* b2 = last ? nB : cB + (size_t)(t + 2) * kstep;
            const char* a3 = a2 + kstep; const char* b3 = b2 + kstep;
            if (last && has_next) S.a_ready(nxt);
            if constexpr (SP2) {
            PG8_LDB(B0, 0, 0); PG8_LDB(B1, 0, 1); PG8_SCHED; PG8_LDA(At, 0, 0); PG8_STAGE(PG8_SA(1, 1), a1 + hstep, voffA);
            PG8_WAIT_V(8); PG8_WAIT_L(0); PG8_BAR; PG8_MMA(0, 0, At, B0); PG8_MMA(0, 1, At, B1); PG8_BAR; PG8_SCHED;
            PG8_LDA(At, 0, 1); PG8_STAGE(PG8_SB(0, 0), b2, voffB); PG8_STAGE(PG8_SB(0, 1), b2 + hstepB, voffB); PG8_STAGE(PG8_SA(0, 0), a2, voffA);
            PG8_WAIT_V(8); PG8_WAIT_L(0); PG8_BAR; PG8_MMA(1, 0, At, B0); PG8_MMA(1, 1, At, B1); PG8_BAR; PG8_SCHED;
            PG8_LDB(B0, 1, 0); PG8_LDB(B1, 1, 1); PG8_SCHED; PG8_LDA(At, 1, 0); PG8_STAGE(PG8_SA(0, 1), a2 + hstep, voffA);
            PG8_WAIT_V(8); PG8_WAIT_L(0); PG8_BAR; PG8_MMA(0, 0, At, B0); PG8_MMA(0, 1, At, B1); PG8_BAR; PG8_SCHED;
            PG8_LDA(At, 1, 1); PG8_STAGE(PG8_SB(1, 0), b3, voffB); PG8_STAGE(PG8_SB(1, 1), b3 + hstepB, voffB); PG8_STAGE(PG8_SA(1, 0), a3, voffA);
            PG8_WAIT_V(8); PG8_WAIT_L(0); PG8_BAR; PG8_MMA(1, 0, At, B0); PG8_MMA(1, 1, At, B1); PG8_BAR; PG8_SCHED;
            if constexpr (Epi::SEG) { if (((t + 2) & 7) == 0 && !last) { E.seg(acc, cur, ((t + 2) >> 3) - 1, wr, wc, fr, fq); PG8_SCHED; } }
            } else {
            PG8_LDB(B0, 0, 0); PG8_SCHED; PG8_LDA(At, 0, 0); PG8_STAGE(PG8_SA(1, 1), a1 + hstep, voffA);
            PG8_WAIT_L(8); PG8_BAR; PG8_WAIT_L(0); PG8_MMA(0, 0, At, B0); PG8_BAR; PG8_SCHED;
            PG8_LDB(B1, 0, 1); PG8_STAGE(PG8_SB(0, 0), b2, voffB);
            PG8_BAR; PG8_WAIT_L(0); PG8_MMA(0, 1, At, B1); PG8_BAR;
            PG8_LDA(At, 0, 1); PG8_STAGE(PG8_SA(0, 0), a2, voffA);
            PG8_BAR; PG8_WAIT_L(0); PG8_MMA(1, 0, At, B0); PG8_BAR; PG8_SCHED;
            PG8_STAGE(PG8_SB(0, 1), b2 + hstepB, voffB);
            PG8_WAIT_V(6); PG8_BAR; PG8_MMA(1, 1, At, B1); PG8_BAR;
            PG8_LDB(B0, 1, 0); PG8_SCHED; PG8_LDA(At, 1, 0); PG8_STAGE(PG8_SA(0, 1), a2 + hstep, voffA);
            PG8_WAIT_L(8); PG8_BAR; PG8_WAIT_L(0); PG8_MMA(0, 0, At, B0); PG8_BAR; PG8_SCHED;
            PG8_LDB(B1, 1, 1); PG8_STAGE(PG8_SB(1, 0), b3, voffB);
            PG8_BAR; PG8_WAIT_L(0); PG8_MMA(0, 1, At, B1); PG8_BAR;
            PG8_LDA(At, 1, 1); PG8_STAGE(PG8_SA(1, 0), a3, voffA);
            PG8_BAR; PG8_WAIT_L(0); PG8_MMA(1, 0, At, B0); PG8_BAR; PG8_SCHED;
            PG8_STAGE(PG8_SB(1, 1), b3 + hstepB, voffB);
            PG8_WAIT_V(6); PG8_BAR; PG8_MMA(1, 1, At, B1); PG8_BAR;
            }
        }
        if constexpr (ALIGN_EPI) { if (wr == 0) PG8_BAR; }
        if constexpr (Epi::FP8) asm volatile("s_nop 15\n\ts_nop 7" ::: "memory");
        if constexpr (!Epi::AFTER_DRAIN) { E(acc, cur, wr, wc, fr, fq); S.done(cur); }
        if (!has_next) break;
#pragma unroll
        for (int a = 0; a < 2; ++a)
#pragma unroll
            for (int b = 0; b < 2; ++b)
#pragma unroll
                for (int m = 0; m < 4; ++m)
#pragma unroll
                    for (int n = 0; n < 2; ++n) acc[a][b][m][n] = (f32x4){zacc_, zacc_, zacc_, zacc_};
        cur = nxt; cA = nA; cB = nB; ++ui;
        if constexpr (ALIGN_EPI) { if (wr == 1) PG8_BAR; }
    }
    PG8_WAIT_V(0);
    if constexpr (!ALIGN_EPI) { if (wr == 0) PG8_BAR; }
    PG8_BAR;
    if constexpr (Epi::AFTER_DRAIN) { E.fused(acc, cur, wr, wc, fr, fq, lds, wid, lane); S.done(cur); }
#undef PG8_SA
#undef PG8_SB
#undef PG8_STAGE
#undef PG8_LDA
#undef PG8_LDB
#undef PG8_MMA
#undef PG8_CAT8
#undef PG8_WAIT_V
#undef PG8_WAIT_L
#undef PG8_BAR
#undef PG8_SCHED
}
}

constexpr int DMODEL = 2048, DEPTH = 4, NSEQ_C = 32, T_C = 256, NSEQ_L = 4, T_L = 4096, PAST = 512;
constexpr int M_C = NSEQ_C * T_C, M_L = NSEQ_L * T_L, MROWS = M_C + M_L;
constexpr int DIN = 4096, DFF = 8192, BRW = 512, BRP = 2048;
constexpr int ZC_XA = 0, ZC_YA = 512, ZC_QW = 1024, ZC_KW = 1536, ZC_VW = 1664, ZC_QG = 1792, ZC_KG = 2304, ZC_VG = 2432, ZC_QD = 2560, ZC_KD = 3072, ZC_VD = 3584;
enum { I_XP = 0, I_XS, I_CWK, I_CWV, I_CGK, I_CGV, I_CDK, I_CDV, I_SLRU, I_C, I_CCTX, I_WADA, I_BADA, I_N1G, I_N2G, I_WIN, I_CONVW, I_CONVB, I_LWR, I_LBR, I_LWI, I_LBI, I_LLAM,
       I_WQN, I_WKN, I_WSINK, I_GQN, I_GKN, I_DQN, I_DKN, I_LQ1, I_LK1, I_LQ2, I_LK2, I_DOG, I_WBR, I_WGATE, I_BGATE, I_WO, I_WFF1, I_BFF1, I_WFF2, I_BFF2, N_IN };
static_assert(N_IN == 43, "input count");
constexpr size_t O_YP = 0, O_YS = 16777216, O_WK = 50331648, O_WV = 54525952, O_GK = 58720256, O_GV = 62914560, O_DK = 67108864, O_DV = 83886080, O_LS = 100663296, O_END = 100794368;
constexpr float RMS_EPS = 1e-6f;
constexpr float QSCALE = 0.125f * 1.4426950408889634f;

constexpr size_t MiB = 1u << 20;
constexpr size_t WS_CTL = 0;
constexpr size_t WS_MOD = 1 * MiB;
constexpr size_t ZERO_BYTES = 64 * 1024;
constexpr size_t WS_TAB = 2 * MiB;
constexpr int TAB_COS = 0, TAB_SIN = 1024, TAB_SPL = 2048, TAB_LAMD = 2048 + 4096, TAB_LAMI = TAB_LAMD + 4;
constexpr size_t WS_LRUW = 3 * MiB;
constexpr size_t WS_SUM = 4 * MiB;
constexpr size_t WS_CK = 5 * MiB;
constexpr size_t CK_WK = WS_CK, CK_WVT = CK_WK + 2 * MiB, CK_GK = CK_WVT + 2 * MiB, CK_GVT = CK_GK + 2 * MiB, CK_DK = CK_GVT + 2 * MiB, CK_DVT = CK_DK + 8 * MiB;
constexpr size_t WS_VT = 29 * MiB;
constexpr size_t VT_BL = WS_VT, VT_CL = VT_BL + 4 * MiB, VT_DL = VT_CL + 4 * MiB, VT_BC = VT_DL + 16 * MiB, VT_CC = VT_BC + 2 * MiB, VT_DC = VT_CC + 2 * MiB;
constexpr size_t WS_W = 65 * MiB;
constexpr size_t WL_ELEMS = 67108864;
constexpr size_t W_IN_T = 0, W_GATE_T = 8388608, W_BR_T = 25165824, W_O_T = 29360128, W_FF1_T = 33554432, W_FF2_T = 50331648;
constexpr size_t WS_H = 577 * MiB;
constexpr size_t WS_Z = 673 * MiB;
constexpr size_t WS_G = 865 * MiB;
constexpr size_t WS_BR = 1249 * MiB;
constexpr size_t WS_OD = 1345 * MiB;
constexpr size_t WS_W8 = 1393 * MiB;
constexpr size_t WS_H8 = 1457 * MiB;
constexpr size_t WS_LAB = WS_G + 192 * MiB;
constexpr size_t WS_XB = 1505 * MiB;
constexpr size_t WS_END = 1601 * MiB;
constexpr size_t WS_DBG = WS_END;

constexpr int RING_BYTES = 131072, LDSCTL_OFF = RING_BYTES, LDS_BYTES = 147456;

#define GAS __attribute__((address_space(1)))
#define LAS __attribute__((address_space(3)))
typedef unsigned short bf16;
typedef unsigned v4u __attribute__((ext_vector_type(4)));
typedef unsigned v2u __attribute__((ext_vector_type(2)));
typedef float f32x4 __attribute__((ext_vector_type(4)));
typedef float f32x16 __attribute__((ext_vector_type(16)));
typedef short bf16x8 __attribute__((ext_vector_type(8)));
__device__ __forceinline__ unsigned f2bf(float f) { unsigned u = __builtin_bit_cast(unsigned, f); return (u + 0x7fffu + ((u >> 16) & 1u)) >> 16; }
__device__ __forceinline__ unsigned pk2(float lo, float hi) { return f2bf(lo) | (f2bf(hi) << 16); }
__device__ __forceinline__ float bflo(unsigned u) { return __uint_as_float(u << 16); }
__device__ __forceinline__ float bfhi(unsigned u) { return __uint_as_float(u & 0xffff0000u); }
__device__ __forceinline__ float bf2f(bf16 b) { return __uint_as_float(((unsigned)b) << 16); }
__device__ __forceinline__ void unpack8(const v4u r, float (&x)[8]) { x[0] = bflo(r.x); x[1] = bfhi(r.x); x[2] = bflo(r.y); x[3] = bfhi(r.y); x[4] = bflo(r.z); x[5] = bfhi(r.z); x[6] = bflo(r.w); x[7] = bfhi(r.w); }
__device__ __forceinline__ v4u pack8(const float (&x)[8]) { v4u r; r.x = pk2(x[0], x[1]); r.y = pk2(x[2], x[3]); r.z = pk2(x[4], x[5]); r.w = pk2(x[6], x[7]); return r; }
__device__ __forceinline__ int crow(int r, int hi) { return (r & 3) + 8 * (r >> 2) + 4 * hi; }

#define XB_TMO      128
#define XB_XCNT(j)  (256  + 64 * (j))
#define XB_XSUB(j)  (1280 + 64 * (j))
#define XB_XGEN(j)  (2304 + 64 * (j))
#define XB_TOP      3328
#define XB_TOPGEN   3392
#define XCD_BAR_WORDS 3456
#define XB_SPIN_CAP (1u << 18)

__device__ __forceinline__ unsigned xb_ld(unsigned* p)              { return __hip_atomic_load(p, __ATOMIC_RELAXED, __HIP_MEMORY_SCOPE_AGENT); }
__device__ __forceinline__ unsigned xb_add(unsigned* p, unsigned v) { return __hip_atomic_fetch_add(p, v, __ATOMIC_RELAXED, __HIP_MEMORY_SCOPE_AGENT); }
__device__ __forceinline__ unsigned xb_xcc_id() { return (unsigned)__builtin_amdgcn_s_getreg((3 << 11) | 20) & 0xFu; }
#define XB_SPIN(cond, bar) do { unsigned _sp = 0; while (cond) { __builtin_amdgcn_s_sleep(1); \
    if ((++_sp & 255u) == 0u) { if (xb_ld(&(bar)[XB_TMO])) break; if (_sp > XB_SPIN_CAP) { atomicAdd(&(bar)[XB_TMO], 1u); break; } } } } while (0)

struct XcdBarrier {
    unsigned* bar; unsigned x; int wv;
    volatile LAS unsigned* st;
};
__device__ __forceinline__ XcdBarrier xcd_barrier_post(unsigned* bar, volatile LAS unsigned* st, int wv) {
    XcdBarrier b; b.bar = bar; b.x = xb_xcc_id(); b.st = st; b.wv = wv;
    if (opaque_tid(wv) == 0) (void)xb_add(&bar[XB_XCNT(b.x)], 1u);
    return b;
}
__device__ __forceinline__ void xcd_barrier_complete(unsigned* bar, unsigned x, unsigned& nloc, unsigned& nx) {
    const unsigned G = gridDim.x * gridDim.y * gridDim.z;
    unsigned sum, cnt, mine, sp = 0u;
    for (;;) {
        sum = 0u; cnt = 0u; mine = 0u;
#pragma unroll
        for (unsigned j = 0; j < 16; ++j) { const unsigned c = xb_ld(&bar[XB_XCNT(j)]); sum += c; cnt += (c > 0u) ? 1u : 0u; mine = (j == x) ? c : mine; }
        if (sum == G) break;
        __builtin_amdgcn_s_sleep(1);
        if ((++sp & 255u) == 0u) { if (xb_ld(&bar[XB_TMO])) break; if (sp > XB_SPIN_CAP) { atomicAdd(&bar[XB_TMO], 1u); break; } }
    }
    nloc = mine > 0u ? mine : 1u; nx = cnt > 0u ? cnt : 1u;
}
__device__ __forceinline__ void xcd_barrier(const XcdBarrier& b) {
    asm volatile("s_waitcnt vmcnt(0)" ::: "memory");
    __syncthreads();
    if (opaque_tid(b.wv) == 0) {
        unsigned* bar = b.bar;
        __builtin_amdgcn_s_waitcnt(0);
        unsigned nloc = b.st[0], nx = b.st[1];
        if (nloc == 0u) { xcd_barrier_complete(bar, b.x, nloc, nx); b.st[0] = nloc; b.st[1] = nx; }
        const unsigned old = xb_add(&bar[XB_XSUB(b.x)], 1u);
        const unsigned gen = old / nloc;
        if (old + 1u == (gen + 1u) * nloc) {
            __builtin_amdgcn_fence(__ATOMIC_RELEASE, "agent");
            asm volatile("s_waitcnt vmcnt(0)" ::: "memory");
            const unsigned og = xb_add(&bar[XB_TOP], 1u);
            const unsigned tg = og / nx;
            if (og + 1u == (tg + 1u) * nx) xb_add(&bar[XB_TOPGEN], 1u);
            else XB_SPIN(xb_ld(&bar[XB_TOPGEN]) == tg, bar);
            __builtin_amdgcn_fence(__ATOMIC_ACQUIRE, "agent");
            xb_add(&bar[XB_XGEN(b.x)], 1u);
            asm volatile("s_waitcnt vmcnt(0)" ::: "memory");
        } else {
            XB_SPIN(xb_ld(&bar[XB_XGEN(b.x)]) == gen, bar);
            __builtin_amdgcn_fence(__ATOMIC_ACQUIRE, "agent");
            asm volatile("s_waitcnt vmcnt(0)" ::: "memory");
        }
    }
    __syncthreads();
}

struct Params { const float* in[N_IN]; float* out; unsigned char* ws; int ph_lo, ph_hi; };
static_assert(sizeof(Params) == (N_IN + 2) * 8 + 8, "Params has no padding");

__device__ __forceinline__ unsigned char* wsbase(const Params& p) { unsigned long long w = (unsigned long long)p.ws; asm volatile("" : "+s"(w)); return (unsigned char*)w; }
__device__ __forceinline__ bf16* wsb(const Params& p, size_t off) { return (bf16*)(wsbase(p) + off); }
__device__ __forceinline__ float* wsf(const Params& p, size_t off) { return (float*)(wsbase(p) + off); }
__device__ __forceinline__ const float* xbase_ctx(const Params& p, int l) { return l == 0 ? inptr(I_XP) : p.out; }
__device__ __forceinline__ const float* xbase_lat(const Params& p, int l) { return l == 0 ? inptr(I_XS) - (size_t)M_C * DMODEL : p.out; }
__device__ __forceinline__ float wave_sum(float v, int lane) {
#pragma unroll
    for (int o = 1; o < 64; o <<= 1) v += shfl_xor_l(v, o, lane);
    return v;
}

__device__ __forceinline__ void transpose_item(const float* W, int K, int N, bf16* WT, LAS float* scr, int item, int lane, bool vswap = false) {
    const int nblk = N / 32, kb = item / nblk, nb = item % nblk, k0 = 64 * kb, n0 = 32 * nb;
#pragma unroll 8
    for (int i = 0; i < 32; ++i) { const int kk = 2 * i + (lane >> 5); scr[kk * 33 + (lane & 31)] = W[(size_t)(k0 + kk) * N + n0 + (lane & 31)]; }
    asm volatile("s_waitcnt lgkmcnt(0)" ::: "memory");
    const int c = lane & 7;
#pragma unroll
    for (int j = 0; j < 4; ++j) { const int n = (lane >> 3) + 8 * j; const LAS float* s = scr + (8 * c) * 33 + n;
        v4u o; o.x = pk2(s[0 * 33], s[1 * 33]); o.y = pk2(s[2 * 33], s[3 * 33]); o.z = pk2(s[4 * 33], s[5 * 33]); o.w = pk2(s[6 * 33], s[7 * 33]);
        if (vswap) { const LAS float* s2 = scr + (16 * (c >> 1) + 4 * (c & 1)) * 33 + n;
            o.x = pk2(s2[0 * 33], s2[1 * 33]); o.y = pk2(s2[2 * 33], s2[3 * 33]); o.z = pk2(s2[8 * 33], s2[9 * 33]); o.w = pk2(s2[10 * 33], s2[11 * 33]); }
        *(v4u*)(WT + (size_t)(n0 + n) * K + k0 + 8 * c) = o; }
    asm volatile("s_waitcnt lgkmcnt(0)" ::: "memory");
}
__device__ __forceinline__ void transpose_item8(const float* W, int K, int N, unsigned char* WT, LAS float* scr, int item, int lane) {
    const int nblk = N / 32, kb = item / nblk, nb = item % nblk, k0 = 64 * kb, n0 = 32 * nb;
#pragma unroll 8
    for (int i = 0; i < 32; ++i) { const int kk = 2 * i + (lane >> 5); scr[kk * 33 + (lane & 31)] = W[(size_t)(k0 + kk) * N + n0 + (lane & 31)]; }
    asm volatile("s_waitcnt lgkmcnt(0)" ::: "memory");
    const int c = lane & 7;
#pragma unroll
    for (int j = 0; j < 4; ++j) { const int n = (lane >> 3) + 8 * j; const LAS float* s = scr + (8 * c) * 33 + n;
        int lo = 0, hi = 0;
        lo = __builtin_amdgcn_cvt_pk_fp8_f32(s[0 * 33] * 64.f, s[1 * 33] * 64.f, lo, false); lo = __builtin_amdgcn_cvt_pk_fp8_f32(s[2 * 33] * 64.f, s[3 * 33] * 64.f, lo, true);
        hi = __builtin_amdgcn_cvt_pk_fp8_f32(s[4 * 33] * 64.f, s[5 * 33] * 64.f, hi, false); hi = __builtin_amdgcn_cvt_pk_fp8_f32(s[6 * 33] * 64.f, s[7 * 33] * 64.f, hi, true);
        *(v2u*)(WT + (size_t)(n0 + n) * K + k0 + 8 * c) = (v2u){(unsigned)lo, (unsigned)hi}; }
    asm volatile("s_waitcnt lgkmcnt(0)" ::: "memory");
}
constexpr int N_TR_W = 131072, N_TR_ALL = N_TR_W + 512 + 512 + 2048 + 256;
__device__ __forceinline__ void prologue_phase(const Params& p, LAS unsigned char* lds) {
    const int tid = opaque_tid(p.ph_hi), lane = tid & 63, wave = __builtin_amdgcn_readfirstlane(tid >> 6);
    const int G = gridDim.x, gw = blockIdx.x * 8 + wave, NGW = G * 8;
    LAS float* scr = (LAS float*)(lds + wave * 16384);
    for (int it = gw; it < N_TR_ALL; it += NGW) {
        if (it < N_TR_W) {
            const int l = it >> 15; int r = it & 32767; bf16* WL = wsb(p, WS_W) + (size_t)l * WL_ELEMS;
            if (r < 4096) { transpose_item(inptr(I_WIN) + (size_t)l * 2048 * 4096, 2048, 4096, WL + W_IN_T, scr, r, lane); continue; } r -= 4096;
            if (r < 8192) { transpose_item8(inptr(I_WGATE) + (size_t)l * 2048 * 8192, 2048, 8192, p.ws + WS_W8 + (size_t)l * 8192 * 2048, scr, r, lane); continue; } r -= 8192;
            if (r < 2048) { transpose_item(inptr(I_WBR) + (size_t)l * 2048 * 2048, 2048, 2048, WL + W_BR_T, scr, r, lane); continue; } r -= 2048;
            if (r < 2048) { transpose_item(inptr(I_WO) + (size_t)l * 2048 * 2048, 2048, 2048, WL + W_O_T, scr, r, lane); continue; } r -= 2048;
            if (r < 8192) { transpose_item(inptr(I_WFF1) + (size_t)l * 2048 * 8192, 2048, 8192, WL + W_FF1_T, scr, r, lane); continue; } r -= 8192;
            transpose_item(inptr(I_WFF2) + (size_t)l * 8192 * 2048, 8192, 2048, WL + W_FF2_T, scr, r, lane);
        } else {
            int r = it - N_TR_W;
            if (r < 512) { const int bl = r >> 5; transpose_item(inptr(I_CWV) + (size_t)bl * 512 * 128, 512, 128, wsb(p, CK_WVT) + (size_t)bl * 128 * 512, scr, r & 31, lane, true); continue; } r -= 512;
            if (r < 512) { const int bl = r >> 5; transpose_item(inptr(I_CGV) + (size_t)bl * 512 * 128, 512, 128, wsb(p, CK_GVT) + (size_t)bl * 128 * 512, scr, r & 31, lane, true); continue; } r -= 512;
            if (r < 2048) { const int bl = r >> 7; transpose_item(inptr(I_CDV) + (size_t)bl * 512 * 512, 512, 512, wsb(p, CK_DVT) + (size_t)bl * 512 * 512, scr, r & 127, lane, true); continue; } r -= 2048;
            { const int mtx = r >> 1, g = mtx >> 6, lkn = mtx & 63;
              transpose_item(inptr(g ? I_LWI : I_LWR) + (size_t)lkn * 4096, 64, 64, wsb(p, WS_LRUW) + (size_t)(g * 64 + lkn) * 4096, scr, r & 1, lane); }
        }
    }
    {
        const size_t gt = (size_t)blockIdx.x * 512 + tid, NT = (size_t)G * 512;
        for (size_t i = gt; i < 1048576 / 8; i += NT) {
            float x[8]; const f32x4 a = *(const f32x4*)(inptr(I_CWK) + i * 8), b = *(const f32x4*)(inptr(I_CWK) + i * 8 + 4);
            x[0] = a[0]; x[1] = a[1]; x[2] = a[2]; x[3] = a[3]; x[4] = b[0]; x[5] = b[1]; x[6] = b[2]; x[7] = b[3]; *(v4u*)(wsb(p, CK_WK) + i * 8) = pack8(x);
            const f32x4 c = *(const f32x4*)(inptr(I_CGK) + i * 8), d = *(const f32x4*)(inptr(I_CGK) + i * 8 + 4);
            x[0] = c[0]; x[1] = c[1]; x[2] = c[2]; x[3] = c[3]; x[4] = d[0]; x[5] = d[1]; x[6] = d[2]; x[7] = d[3]; *(v4u*)(wsb(p, CK_GK) + i * 8) = pack8(x); }
        for (size_t i = gt; i < 4194304 / 8; i += NT) {
            float x[8]; const f32x4 a = *(const f32x4*)(inptr(I_CDK) + i * 8), b = *(const f32x4*)(inptr(I_CDK) + i * 8 + 4);
            x[0] = a[0]; x[1] = a[1]; x[2] = a[2]; x[3] = a[3]; x[4] = b[0]; x[5] = b[1]; x[6] = b[2]; x[7] = b[3]; *(v4u*)(wsb(p, CK_DK) + i * 8) = pack8(x); }
    }
    if (blockIdx.x == 0) {
        float* tab = wsf(p, WS_TAB);
        if (tid < 16) {
            const double inv = tid == 0 ? 1.0 : tid == 1 ? 0.5623413251903491 : tid == 2 ? 0.31622776601683794 : tid == 3 ? 0.1778279410038923 : tid == 4 ? 0.1 : tid == 5 ? 0.05623413251903491 : tid == 6 ? 0.03162277660168379 :
                tid == 7 ? 0.01778279410038923 : tid == 8 ? 0.01 : tid == 9 ? 0.005623413251903491 : tid == 10 ? 0.0031622776601683794 : tid == 11 ? 0.0017782794100389228 : tid == 12 ? 0.001 : tid == 13 ? 0.0005623413251903491 :
                tid == 14 ? 0.00031622776601683794 : 0.00017782794100389227;
            double c1 = 1.0, s1 = inv, tc = 1.0, tsn = inv; const double x2 = inv * inv;
            for (int k = 1; k <= 14; ++k) { tc = -tc * x2 / (double)((2 * k - 1) * (2 * k)); tsn = -tsn * x2 / (double)((2 * k) * (2 * k + 1)); c1 += tc; s1 += tsn; }
            double c = 1.0, s = 0.0;
            for (int pos = 0; pos < 64; ++pos) { tab[TAB_COS + pos * 16 + tid] = (float)c; tab[TAB_SIN + pos * 16 + tid] = (float)s; const double cn = c * c1 - s * s1, sn = s * c1 + c * s1; c = cn; s = sn; }
        }
        for (int i = tid; i < 4096; i += 512) { const float lam = inptr(I_LLAM)[i]; tab[TAB_SPL + i] = lam > 15.f ? __expf(-lam) : log1pf(__expf(-lam)); }
        if (tid < 4) { float s1 = 0.f, s2 = 0.f; for (int d = 0; d < 64; ++d) { s1 += inptr(I_LQ1)[tid * 64 + d] * inptr(I_LK1)[tid * 64 + d]; s2 += inptr(I_LQ2)[tid * 64 + d] * inptr(I_LK2)[tid * 64 + d]; }
            const float li = 0.8f - 0.6f * expf(-0.3f * (float)tid); tab[TAB_LAMD + tid] = expf(s1) - expf(s2) + li; tab[TAB_LAMI + tid] = li; }
    }
    {
        LAS float* sv = (LAS float*)lds;
        LAS float* red = (LAS float*)(lds + 5 * 2048 * 4);
        float* mod = wsf(p, WS_MOD);
        __syncthreads();
        for (int i = tid; i < 5 * 2048; i += 512) { const int cond = i >> 11, k = i & 2047; const float c = cond == 0 ? inptr(I_CCTX)[k] : inptr(I_C)[(cond - 1) * 2048 + k]; sv[i] = c / (1.0f + __expf(-c)); }
        __syncthreads();
        const int q = tid >> 7, jl = tid & 127;
        for (int it = blockIdx.x; it < 4 * 96; it += G) {
            const int l = it / 96, j = (it % 96) * 128 + jl;
            float a0 = 0.f, a1 = 0.f, a2 = 0.f, a3 = 0.f, a4 = 0.f;
            const float* w = inptr(I_WADA) + ((size_t)l * 2048 + q * 512) * 12288 + j; const LAS float* s0 = sv + q * 512;
#pragma unroll 8
            for (int kk = 0; kk < 512; ++kk) { const float wv = w[(size_t)kk * 12288]; a0 += s0[kk] * wv; a1 += s0[2048 + kk] * wv; a2 += s0[4096 + kk] * wv; a3 += s0[6144 + kk] * wv; a4 += s0[8192 + kk] * wv; }
            red[(q * 5 + 0) * 128 + jl] = a0; red[(q * 5 + 1) * 128 + jl] = a1; red[(q * 5 + 2) * 128 + jl] = a2; red[(q * 5 + 3) * 128 + jl] = a3; red[(q * 5 + 4) * 128 + jl] = a4;
            __syncthreads();
            for (int i = tid; i < 5 * 128; i += 512) { const int cond = i >> 7, jj = i & 127; const int col = (it % 96) * 128 + jj;
                const float v = ((red[(0 * 5 + cond) * 128 + jj] + red[(1 * 5 + cond) * 128 + jj]) + (red[(2 * 5 + cond) * 128 + jj] + red[(3 * 5 + cond) * 128 + jj])) + inptr(I_BADA)[l * 12288 + col];
                mod[((size_t)l * 5 + cond) * 12288 + col] = v; }
            __syncthreads();
        }
    }
}

template <bool XBF  >
__device__ __forceinline__ void norm_phase(const Params& p, int l, int which  ) {
    const int tid = opaque_tid(p.ph_hi), lane = tid & 63, wave = __builtin_amdgcn_readfirstlane(tid >> 6);
    const int gw = blockIdx.x * 8 + wave, NGW = gridDim.x * 8;
    const float* g = inptr(which ? I_N2G : I_N1G) + l * 2048;
    const float* modl = wsf(p, WS_MOD) + (size_t)l * 5 * 12288;
    bf16* H = wsb(p, WS_H);
    for (int r = gw; r < MROWS; r += NGW) {
        const int cond = r < M_C ? 0 : 1 + ((r - M_C) >> 12);
        const float* sh = modl + (size_t)cond * 12288 + (which ? 3 : 0) * 2048, * sc = sh + 2048;
        float v[4][8]; float ss = 0.f;
#pragma unroll
        for (int j = 0; j < 4; ++j) { const int c = 8 * lane + 512 * j;
            if (XBF) { const v4u raw = *(const v4u*)(wsb(p, WS_XB) + (size_t)r * 2048 + c); unpack8(raw, v[j]); }
            else { const float* x = (r < M_C ? inptr(I_XP) : inptr(I_XS) - (size_t)M_C * DMODEL) + (size_t)r * 2048 + c; const f32x4 a = *(const f32x4*)x, b = *(const f32x4*)(x + 4);
#pragma unroll
                for (int k = 0; k < 4; ++k) { v[j][k] = a[k]; v[j][4 + k] = b[k]; } }
            ss += ((v[j][0] * v[j][0] + v[j][1] * v[j][1]) + (v[j][2] * v[j][2] + v[j][3] * v[j][3])) + ((v[j][4] * v[j][4] + v[j][5] * v[j][5]) + (v[j][6] * v[j][6] + v[j][7] * v[j][7])); }
        const float rstd = 1.0f / sqrtf(wave_sum(ss, lane) * (1.0f / 2048.0f) + RMS_EPS);
#pragma unroll
        for (int j = 0; j < 4; ++j) { const int c = 8 * lane + 512 * j; float y[8];
#pragma unroll
            for (int h = 0; h < 2; ++h) { const f32x4 gg = *(const f32x4*)(g + c + 4 * h), s1 = *(const f32x4*)(sc + c + 4 * h), s0 = *(const f32x4*)(sh + c + 4 * h);
#pragma unroll
                for (int k = 0; k < 4; ++k) y[4 * h + k] = (v[j][4 * h + k] * rstd) * gg[k] * (s1[k] + 1.0f) + s0[k]; }
            *(v4u*)(H + (size_t)r * 2048 + c) = pack8(y);
            if (!which) { int q0 = 0, q1 = 0; q0 = __builtin_amdgcn_cvt_pk_fp8_f32(y[0], y[1], q0, false); q0 = __builtin_amdgcn_cvt_pk_fp8_f32(y[2], y[3], q0, true);
                q1 = __builtin_amdgcn_cvt_pk_fp8_f32(y[4], y[5], q1, false); q1 = __builtin_amdgcn_cvt_pk_fp8_f32(y[6], y[7], q1, true);
                *(v2u*)(p.ws + WS_H8 + (size_t)r * 2048 + c) = (v2u){(unsigned)q0, (unsigned)q1}; } }
    }
}

__device__ __forceinline__ void prep_phase(const Params& p, int l, LAS unsigned char* lds) {
    const int tid = opaque_tid(p.ph_hi), lane = tid & 63, wave = __builtin_amdgcn_readfirstlane(tid >> 6);
    const int gw = blockIdx.x * 8 + wave, NGW = gridDim.x * 8;
    bf16* Z = wsb(p, WS_Z); const float* tab = wsf(p, WS_TAB);
    v4u nraw[2] = {{0u, 0u, 0u, 0u}, {0u, 0u, 0u, 0u}};
#define PREP_LOAD(r_) do { const bf16* zq_ = Z + (size_t)(r_) * DIN + (lane & 7) * 8; _Pragma("unroll") for (int it = 0; it < 2; ++it) { int v = it * 8 + (lane >> 3); if (v > 11) v = 11; \
        const int col = v < 2 ? ZC_KW + v * 64 : v < 4 ? ZC_KG + (v - 2) * 64 : ZC_KD + (v - 4) * 64; nraw[it] = *(const v4u*)(zq_ + col); } } while (0)
    if (gw < MROWS) PREP_LOAD(gw);
    for (int r = gw; r < MROWS; r += NGW) {
        const bool isctx = r < M_C; const int seq = isctx ? (r >> 8) : ((r - M_C) >> 12), t = isctx ? (r & 255) : ((r - M_C) & 4095);
        bf16* zr = Z + (size_t)r * DIN; const int sub = lane & 7;
        v4u raws[2] = {nraw[0], nraw[1]};
        { const int rn = r + NGW < MROWS ? r + NGW : r; PREP_LOAD(rn); asm volatile("" ::: "memory"); }
#pragma unroll
        for (int it = 0; it < 2; ++it) {
            int v = it * 8 + (lane >> 3); const bool live = v < 12; if (!live) v = 11;
            int col; const float* gain; size_t ko;
            if (v < 2)      { col = ZC_KW + v * 64; gain = inptr(I_WKN); ko = O_WK + ((size_t)(seq * 4 + l) * 256 + t) * 128 + v * 64; }
            else if (v < 4) { col = ZC_KG + (v - 2) * 64; gain = inptr(I_GKN); ko = O_GK + ((size_t)(seq * 4 + l) * 256 + t) * 128 + (v - 2) * 64; }
            else            { col = ZC_KD + (v - 4) * 64; gain = inptr(I_DKN); ko = O_DK + ((size_t)(seq * 4 + l) * 256 + t) * 512 + (v - 4) * 64; }
            gain += l * 64 + sub * 8;
            float x[8]; unpack8(raws[it], x);
            float ss = 0.f;
#pragma unroll
            for (int j = 0; j < 8; ++j) ss += x[j] * x[j];
            ss += shfl_xor_l(ss, 1, lane); ss += shfl_xor_l(ss, 2, lane); ss += shfl_xor_l(ss, 4, lane);
            const float rstd = 1.0f / sqrtf(ss * (1.0f / 64.0f) + RMS_EPS);
            const f32x4 g0 = *(const f32x4*)gain, g1 = *(const f32x4*)(gain + 4);
            float y[8];
#pragma unroll
            for (int j = 0; j < 4; ++j) { y[j] = x[j] * rstd * g0[j]; y[4 + j] = x[4 + j] * rstd * g1[j]; }
            if (isctx) {
                if (live) { *(f32x4*)(p.out + ko + sub * 8) = (f32x4){y[0], y[1], y[2], y[3]}; *(f32x4*)(p.out + ko + sub * 8 + 4) = (f32x4){y[4], y[5], y[6], y[7]}; }
            } else {
                const int axis = sub >> 2, pos = axis ? (t & 63) : (t >> 6), f0 = (sub & 1) * 8; const bool half = (sub >> 1) & 1;
                const f32x4 c0 = *(const f32x4*)(tab + TAB_COS + pos * 16 + f0), c1 = *(const f32x4*)(tab + TAB_COS + pos * 16 + f0 + 4);
                const f32x4 s0 = *(const f32x4*)(tab + TAB_SIN + pos * 16 + f0), s1 = *(const f32x4*)(tab + TAB_SIN + pos * 16 + f0 + 4);
#pragma unroll
                for (int j = 0; j < 8; ++j) { const float pr = shfl_xor_l(y[j], 2, lane); const float c = j < 4 ? c0[j & 3] : c1[j & 3], s = j < 4 ? s0[j & 3] : s1[j & 3];
                    y[j] = y[j] * c + (half ? pr : -pr) * s; }
            }
            if (live) *(v4u*)(zr + col + sub * 8) = pack8(y);
        }
        if (isctx) {
#pragma unroll 1
            for (int it = 0; it < 2; ++it) { const int g = it * 64 + lane; if (g < 96) {
                int col; size_t vo;
                if (g < 16)      { col = ZC_VW + g * 8; vo = O_WV + ((size_t)(seq * 4 + l) * 256 + t) * 128 + g * 8; }
                else if (g < 32) { col = ZC_VG + (g - 16) * 8; vo = O_GV + ((size_t)(seq * 4 + l) * 256 + t) * 128 + (g - 16) * 8; }
                else             { col = ZC_VD + (g - 32) * 8; vo = O_DV + ((size_t)(seq * 4 + l) * 256 + t) * 512 + (g - 32) * 8; }
                float x[8]; unpack8(*(const v4u*)(zr + col), x);
                *(f32x4*)(p.out + vo) = (f32x4){x[0], x[1], x[2], x[3]}; *(f32x4*)(p.out + vo + 4) = (f32x4){x[4], x[5], x[6], x[7]}; } }
        }
    }
#undef PREP_LOAD
    LAS unsigned short* tile = (LAS unsigned short*)(lds + wave * 16384);
    v4u braw[8];
#define PREPB_LOAD(it_) do { const int rb_ = (it_) / 12, cb_ = (it_) % 12; const int col_ = cb_ < 2 ? ZC_VW + cb_ * 64 : cb_ < 4 ? ZC_VG + (cb_ - 2) * 64 : ZC_VD + (cb_ - 4) * 64; \
        _Pragma("unroll") for (int i = 0; i < 8; ++i) braw[i] = *(const v4u*)(Z + (size_t)(rb_ * 64 + i * 8 + (lane >> 3)) * DIN + col_ + (lane & 7) * 8); } while (0)
    if (gw < (MROWS / 64) * 12) PREPB_LOAD(gw);
    for (int it = gw; it < (MROWS / 64) * 12; it += NGW) {
        const int rb = it / 12, cb = it % 12, r0 = rb * 64; const bool isctx = r0 < M_C;
        const int seq = isctx ? (r0 >> 8) : ((r0 - M_C) >> 12), t0 = isctx ? (r0 & 255) : ((r0 - M_C) & 4095), T = isctx ? T_C : T_L;
        int col; bf16* dst;
        if (cb < 2)      { col = ZC_VW + cb * 64; dst = wsb(p, isctx ? VT_BC : VT_BL) + (size_t)((seq * 2 + cb) * 64) * T; }
        else if (cb < 4) { col = ZC_VG + (cb - 2) * 64; dst = wsb(p, isctx ? VT_CC : VT_CL) + (size_t)((seq * 2 + cb - 2) * 64) * T; }
        else             { col = ZC_VD + (cb - 4) * 64; dst = wsb(p, isctx ? VT_DC : VT_DL) + (size_t)((seq * 4 + ((cb - 4) >> 1)) * 128 + ((cb - 4) & 1) * 64) * T; }
#pragma unroll
        for (int i = 0; i < 8; ++i) { const int row = i * 8 + (lane >> 3), ch = lane & 7; const v4u raw = braw[i];
            LAS unsigned* d = (LAS unsigned*)(tile + row * 66 + ch * 8); d[0] = raw.x; d[1] = raw.y; d[2] = raw.z; d[3] = raw.w; }
        { const int itn = it + NGW < (MROWS / 64) * 12 ? it + NGW : it; PREPB_LOAD(itn); }
        asm volatile("s_waitcnt lgkmcnt(0)" ::: "memory");
#pragma unroll
        for (int i = 0; i < 8; ++i) { const int drow = i * 8 + (lane >> 3), tch = lane & 7; unsigned short e[8];
#pragma unroll
            for (int j = 0; j < 8; ++j) e[j] = tile[(16 * (tch >> 1) + 4 * (tch & 1) + (j & 3) + 8 * (j >> 2)) * 66 + drow];
            v4u o; o.x = e[0] | ((unsigned)e[1] << 16); o.y = e[2] | ((unsigned)e[3] << 16); o.z = e[4] | ((unsigned)e[5] << 16); o.w = e[6] | ((unsigned)e[7] << 16);
            *(v4u*)(dst + (size_t)drow * T + t0 + tch * 8) = o; }
        asm volatile("s_waitcnt lgkmcnt(0)" ::: "memory");
    }
#undef PREPB_LOAD
}

__device__ __forceinline__ void dcomb_phase(const Params& p, int l) {
    const int tid = opaque_tid(p.ph_hi), lane = tid & 63, wave = __builtin_amdgcn_readfirstlane(tid >> 6);
    const int gw = blockIdx.x * 8 + wave, NGW = gridDim.x * 8;
    const float* tab = wsf(p, WS_TAB); const float lam = tab[TAB_LAMD + l], omli = 1.0f - tab[TAB_LAMI + l];
    const bf16* OD = wsb(p, WS_OD); bf16* BR3 = wsb(p, WS_BR) + 3 * BRW;
    const int h = lane >> 4, sub = lane & 15;
    const float* og = inptr(I_DOG) + l * 128 + sub * 8; const f32x4 g0 = *(const f32x4*)og, g1 = *(const f32x4*)(og + 4);
    for (int r = gw; r < MROWS; r += NGW) {
        float a[8], b[8]; unpack8(*(const v4u*)(OD + (size_t)r * 1024 + (h * 2) * 128 + sub * 8), a); unpack8(*(const v4u*)(OD + (size_t)r * 1024 + (h * 2 + 1) * 128 + sub * 8), b);
        float ss = 0.f;
#pragma unroll
        for (int j = 0; j < 8; ++j) { a[j] -= lam * b[j]; ss += a[j] * a[j]; }
        ss += shfl_xor_l(ss, 1, lane); ss += shfl_xor_l(ss, 2, lane); ss += shfl_xor_l(ss, 4, lane); ss += shfl_xor_l(ss, 8, lane);
        const float rstd = 1.0f / sqrtf(ss * (1.0f / 128.0f) + RMS_EPS) * omli;
#pragma unroll
        for (int j = 0; j < 4; ++j) { a[j] *= rstd * g0[j]; a[4 + j] *= rstd * g1[j]; }
        *(v4u*)(BR3 + (size_t)r * BRP + h * 128 + sub * 8) = pack8(a);
    }
}

constexpr int LR_U16 = 0, LR_U32 = 9216, LR_PA = 25600, LR_PB = 41984, LR_HF = 58368;
template <int MODE, bool AB = false>
__device__ __forceinline__ void lru_sweep(const Params& p, int l, int dir, int n, int rowseq0  , int T, int tch0  ,
                                          float& h  , float& aprod, LAS unsigned char* lds, unsigned* ab = nullptr) {
    const int tid = opaque_tid(p.ph_hi), lane = tid & 63, wave = __builtin_amdgcn_readfirstlane(tid >> 6), r32 = lane & 31, hi = lane >> 5;
    const bf16* Z = wsb(p, WS_Z);
    LAS unsigned short* U16 = (LAS unsigned short*)(lds + LR_U16); LAS float* U32 = (LAS float*)(lds + LR_U32); LAS float* PA = (LAS float*)(lds + LR_PA); LAS float* PB = (LAS float*)(lds + LR_PB); LAS float* HF = (LAS float*)(lds + LR_HF);
    const int g = wave >> 2, mi = (wave >> 1) & 1, ni = wave & 1, dcol = ni * 32 + r32;
    bf16x8 wf[4];
    { const bf16* wp = wsb(p, WS_LRUW) + ((size_t)((g * 64 + (l * 2 + dir) * 8 + n) * 64 + dcol)) * 64 + hi * 8;
#pragma unroll
      for (int ks = 0; ks < 4; ++ks) wf[ks] = *(const bf16x8*)(wp + ks * 16); }
    const float gbias = inptr(g ? I_LBI : I_LBR)[(l * 2 + dir) * 512 + n * 64 + dcol];
    const int tt = tid >> 3, c8 = (tid & 7) * 8;
    float cw[4][8], cb[8], sp[8];
#pragma unroll
    for (int k = 0; k < 4; ++k) { const float* q = inptr(I_CONVW) + (l * 4 + k) * 512 + n * 64 + c8; const f32x4 a = *(const f32x4*)q, b = *(const f32x4*)(q + 4);
        cw[k][0] = a[0]; cw[k][1] = a[1]; cw[k][2] = a[2]; cw[k][3] = a[3]; cw[k][4] = b[0]; cw[k][5] = b[1]; cw[k][6] = b[2]; cw[k][7] = b[3]; }
    { const float* q = inptr(I_CONVB) + l * 512 + n * 64 + c8; const float* s = wsf(p, WS_TAB) + TAB_SPL + (l * 2 + dir) * 512 + n * 64 + c8;
#pragma unroll
      for (int j = 0; j < 8; ++j) { cb[j] = q[j]; sp[j] = s[j]; } }
    v4u xr[4], yr = {0u, 0u, 0u, 0u};
#define LRU_FETCH(j4_) do { const int t_ = tch0 + 64 * (j4_) + tt; if (!AB) { _Pragma("unroll") for (int k = 0; k < 4; ++k) { const int tk = t_ + k - 1; \
        xr[k] = (tk >= 0 && tk < T) ? *(const v4u*)(Z + (size_t)(rowseq0 + tk) * DIN + ZC_XA + n * 64 + c8) : (v4u){0u, 0u, 0u, 0u}; } } \
        if (MODE == 2) yr = *(const v4u*)(Z + (size_t)(rowseq0 + t_) * DIN + ZC_YA + n * 64 + c8); } while (0)
    unsigned wn[8] = {0u, 0u, 0u, 0u, 0u, 0u, 0u, 0u};
#define LRU_FETCH_AB(j4_) do { _Pragma("unroll") for (int k = 0; k < 8; ++k) { const int st_ = dir ? 63 - (8 * wave + k) : 8 * wave + k; wn[k] = ab[(size_t)(tch0 + 64 * (j4_) + st_) * 512 + lane]; } } while (0)
    LRU_FETCH(dir ? 3 : 0);
    if (AB) LRU_FETCH_AB(dir ? 3 : 0);
#pragma unroll 1
    for (int jj = 0; jj < 4; ++jj) {
        const int j4 = dir ? 3 - jj : jj, ts = tch0 + 64 * j4, t = ts + tt;
        float ya[8]; unsigned wc[8];
        if constexpr (!AB) {
        { float u[8];
#pragma unroll
          for (int j = 0; j < 8; ++j) u[j] = cb[j];
#pragma unroll
          for (int k = 0; k < 4; ++k) { float x[8]; unpack8(xr[k], x);
#pragma unroll
              for (int j = 0; j < 8; ++j) u[j] += cw[k][j] * x[j]; }
          if (MODE == 2) unpack8(yr, ya);
          *(LAS v4u*)(U16 + tt * 72 + c8) = pack8(u);
          *(LAS f32x4*)(U32 + tt * 64 + c8) = (f32x4){u[0], u[1], u[2], u[3]}; *(LAS f32x4*)(U32 + tt * 64 + c8 + 4) = (f32x4){u[4], u[5], u[6], u[7]}; }
        __syncthreads();
        if (jj < 3) LRU_FETCH(dir ? 2 - jj : jj + 1);
        { f32x16 acc = {};
#pragma unroll
          for (int ks = 0; ks < 4; ++ks) { const bf16x8 a = *(const LAS bf16x8*)(U16 + (mi * 32 + r32) * 72 + ks * 16 + hi * 8); acc = __builtin_amdgcn_mfma_f32_32x32x16_bf16(a, wf[ks], acc, 0, 0, 0); }
          LAS float* P = g ? PB : PA;
#pragma unroll
          for (int r = 0; r < 16; ++r) P[(mi * 32 + crow(r, hi)) * 64 + dcol] = acc[r] + gbias; }
        __syncthreads();
        { unsigned wab[8];
#pragma unroll
          for (int j = 0; j < 8; ++j) { const int idx = tt * 64 + c8 + j;
              const float rg = __builtin_amdgcn_rcpf(1.0f + __builtin_amdgcn_exp2f(-1.4426950408889634f * PA[idx])), ig = __builtin_amdgcn_rcpf(1.0f + __builtin_amdgcn_exp2f(-1.4426950408889634f * PB[idx]));
              const float la = -8.0f * rg * sp[j]; const float a = __builtin_amdgcn_exp2f(1.4426950408889634f * la);
              const float x = 2.0f * la; const float ser = -x * (1.0f + x * (0.5f + x * (0.16666667f + x * (0.041666668f + x * (0.0083333338f + x * 0.0013888889f)))));
              const float om = x > -0.25f ? ser : 1.0f - a * a;
              const float b = __builtin_amdgcn_sqrtf(om) * ig * U32[idx];
              if (MODE == 0) { const unsigned w = pk2(1.4426950408889634f * la, b); wab[j] = w; PA[idx] = __builtin_amdgcn_exp2f(bflo(w)); PB[idx] = bfhi(w); }
              else { PA[idx] = a; PB[idx] = b; } }
          if (MODE == 0) { unsigned* q = ab + (size_t)(ts + tt) * 512 + c8; *(v4u*)q = (v4u){wab[0], wab[1], wab[2], wab[3]}; *(v4u*)(q + 4) = (v4u){wab[4], wab[5], wab[6], wab[7]}; } }
        __syncthreads();
        } else {
            if (MODE == 2) unpack8(yr, ya);
#pragma unroll
            for (int k = 0; k < 8; ++k) wc[k] = wn[k];
            if (jj < 3) { LRU_FETCH(dir ? 2 - jj : jj + 1); LRU_FETCH_AB(dir ? 2 - jj : jj + 1); }
        }
        {
            LAS float* SC = (LAS float*)(lds + LR_U16);
            float av[8], bv[8];
#pragma unroll
            for (int k = 0; k < 8; ++k) { const int st = dir ? 63 - (8 * wave + k) : 8 * wave + k; if (AB) { av[k] = __builtin_amdgcn_exp2f(bflo(wc[k])); bv[k] = bfhi(wc[k]); } else { av[k] = PA[st * 64 + lane]; bv[k] = PB[st * 64 + lane]; } }
            float Al = av[0], Bl = bv[0];
#pragma unroll
            for (int k = 1; k < 8; ++k) { Bl = av[k] * Bl + bv[k]; Al *= av[k]; }
            SC[(wave * 2) * 64 + lane] = Al; SC[(wave * 2 + 1) * 64 + lane] = Bl;
            __syncthreads();
            float hv = h, hin = h;
#pragma unroll
            for (int v = 0; v < 8; ++v) { const float Av = SC[(2 * v) * 64 + lane], Bv = SC[(2 * v + 1) * 64 + lane]; if (v == wave) hin = hv; hv = Av * hv + Bv; if (MODE == 0) aprod *= Av; }
            h = hv;
#pragma unroll
            for (int k = 0; k < 8; ++k) { const int st = dir ? 63 - (8 * wave + k) : 8 * wave + k; hin = av[k] * hin + bv[k];
                if (MODE == 1) HF[(j4 * 64 + st) * 64 + lane] = hin;
                if (MODE == 2) PB[st * 64 + lane] = hin; }
        }
        __syncthreads();
        if (MODE == 2) {
            float o[8];
#pragma unroll
            for (int j = 0; j < 8; ++j) { const float hs = HF[(j4 * 64 + tt) * 64 + c8 + j] + PB[tt * 64 + c8 + j]; const float y = ya[j];
                const float ug = 0.7978845608028654f * (y + 0.044715f * y * y * y);
                const float gl = y * __builtin_amdgcn_rcpf(1.0f + __builtin_amdgcn_exp2f(-2.8853900817779268f * ug)); o[j] = hs * gl; }
            *(v4u*)(wsb(p, WS_BR) + (size_t)(rowseq0 + t) * BRP + n * 64 + c8) = pack8(o);
        }
    }
#undef LRU_FETCH
#undef LRU_FETCH_AB
}
__device__ __forceinline__ void lru_pass1(const Params& p, int l, LAS unsigned char* lds) {
    const int tid = opaque_tid(p.ph_hi), lane = tid & 63, wave = __builtin_amdgcn_readfirstlane(tid >> 6);
    float* SUM = wsf(p, WS_SUM);
#pragma unroll 1
    for (int it = blockIdx.x; it < NSEQ_L * 2 * 8 * 16; it += gridDim.x) {
        const int seq = it >> 8, dir = (it >> 7) & 1, n = (it >> 4) & 7, c = it & 15;
        float h = 0.f, ap = 1.f; asm volatile("" : "+v"(h), "+v"(ap));
        __syncthreads();
        lru_sweep<0>(p, l, dir, n, M_C + seq * T_L, T_L, c * 256, h, ap, lds, (unsigned*)(p.ws + WS_LAB) + ((size_t)(seq * 2 + dir) * T_L) * 512 + n * 64);
        if (wave == 0) { float* s = SUM + ((size_t)((seq * 2 + dir) * 16 + c) * 512 + n * 64 + lane) * 2; s[0] = ap; s[1] = h; }
    }
}
__device__ __forceinline__ void lru_pass2(const Params& p, int l, LAS unsigned char* lds) {
    const int tid = opaque_tid(p.ph_hi), lane = tid & 63, wave = __builtin_amdgcn_readfirstlane(tid >> 6);
    const float* SUM = wsf(p, WS_SUM);
#pragma unroll 1
    for (int it = blockIdx.x; it < NSEQ_L * 8 * 16 + NSEQ_C * 8; it += gridDim.x) {
        const bool lat = it < NSEQ_L * 8 * 16;
        int seq, n, c, rowseq0, T;
        if (lat) { seq = it >> 7; n = (it >> 4) & 7; c = it & 15; rowseq0 = M_C + seq * T_L; T = T_L; }
        else { const int i2 = it - NSEQ_L * 8 * 16; seq = i2 >> 3; n = i2 & 7; c = 0; rowseq0 = seq * T_C; T = T_C; }
        float hf = 0.f, hb = 0.f, dummy = 1.f; asm volatile("" : "+v"(hf), "+v"(hb), "+v"(dummy));
        if (lat) {
            const int ch = n * 64 + lane;
            hf = inptr(I_SLRU)[((size_t)(seq * 4 + l) * 2 + 0) * 512 + ch]; hb = inptr(I_SLRU)[((size_t)(seq * 4 + l) * 2 + 1) * 512 + ch];
            { pg8::f32x2_t sv[16];
#pragma unroll
              for (int cc = 0; cc < 16; ++cc) sv[cc] = *(const pg8::f32x2_t*)(SUM + ((size_t)((seq * 2 + 0) * 16 + cc) * 512 + ch) * 2);
#pragma unroll
              for (int cc = 0; cc < 16; ++cc) hf = cc < c ? sv[cc][0] * hf + sv[cc][1] : hf;
#pragma unroll
              for (int cc = 0; cc < 16; ++cc) sv[cc] = *(const pg8::f32x2_t*)(SUM + ((size_t)((seq * 2 + 1) * 16 + cc) * 512 + ch) * 2);
#pragma unroll
              for (int cc = 15; cc >= 0; --cc) hb = cc > c ? sv[cc][0] * hb + sv[cc][1] : hb; }
        }
        __syncthreads();
        if (lat) { unsigned* ab = (unsigned*)(p.ws + WS_LAB) + ((size_t)(seq * 2) * T_L) * 512 + n * 64;
            lru_sweep<1, true>(p, l, 0, n, rowseq0, T, c * 256, hf, dummy, lds, ab);
            lru_sweep<2, true>(p, l, 1, n, rowseq0, T, c * 256, hb, dummy, lds, ab + (size_t)T_L * 512); }
        else {
            lru_sweep<1>(p, l, 0, n, rowseq0, T, c * 256, hf, dummy, lds);
            lru_sweep<2>(p, l, 1, n, rowseq0, T, c * 256, hb, dummy, lds); }
        if (!lat && wave == 0) { float* o = p.out + O_LS + ((size_t)(seq * 4 + l) * 2) * 512 + n * 64 + lane; o[0] = hf; o[512] = hb; }
    }
}

struct AttnJob {
    const bf16* Q; const bf16* Ks; const bf16* VTs; const bf16* Kc; const bf16* VTc; bf16* O;
    int kspitch, vtspitch, kcpitch, opitch, s_t0, s_nt, c_nt, q0, window, wv, rope; float sink2; bool has_sink; const float* qg; const float* tab;
};
constexpr int AT_K = 0, AT_V = 32768;
#define GLDS16(gp, lp) __builtin_amdgcn_global_load_lds((const unsigned*)(gp), (LAS unsigned*)(lp), 16, 0, 0)
constexpr float ATT_THR = 8.0f;
template <int VW, int PROBE>
__device__ __forceinline__ void attn_unit(const AttnJob& J, LAS unsigned char* lds) {
    const int tid = opaque_tid(J.wv), lane = tid & 63, wid = __builtin_amdgcn_readfirstlane(tid >> 6), r32 = lane & 31, hi = lane >> 5;
    constexpr int NB = VW / 32;
    bf16x8 qf[4];
    float mref = 0.f, lsum = 0.f; f32x16 o[NB]; f32x16 negm;
    { float zz = 0.f; asm volatile("" : "+v"(zz));
#pragma unroll
      for (int r = 0; r < 16; ++r) { negm[r] = zz;
#pragma unroll
          for (int b = 0; b < NB; ++b) o[b][r] = zz; } }
    const int NT = J.s_nt + J.c_nt, qw0 = J.q0 + wid * 32;
    const int krow = wid * 8 + (lane >> 3), kchunk = (lane & 7) ^ ((krow >> 1) & 7);
    const unsigned lk_s = (unsigned)krow * (unsigned)J.kspitch * 2u + kchunk * 16u, lk_c = (unsigned)krow * (unsigned)J.kcpitch * 2u + kchunk * 16u, lv_s = (unsigned)lane * (unsigned)J.vtspitch * 2u, lv_c = (unsigned)lane * (unsigned)(PAST * 2);
#define ATT_ISSUE_K(t_, slot_) do { const int t__ = (t_); \
        if (t__ < J.s_nt) GLDS16((const char*)J.Ks + (size_t)(J.s_t0 + t__ * 64) * J.kspitch * 2 + lk_s, lds + AT_K + (slot_) * 8192 + wid * 1024); \
        else GLDS16((const char*)J.Kc + (size_t)((t__ - J.s_nt) * 64) * J.kcpitch * 2 + lk_c, lds + AT_K + (slot_) * 8192 + wid * 1024); } while (0)
#define ATT_ISSUE_V(t_, slot_) do { const int t__ = (t_); \
        if (t__ < J.s_nt) { const char* vb_ = (const char*)J.VTs + (size_t)(J.s_t0 + t__ * 64 + wid * 8) * 2; GLDS16(vb_ + lv_s, lds + AT_V + (slot_) * 16384 + wid * 1024); \
            if (VW == 128) GLDS16(vb_ + (size_t)128 * J.vtspitch + lv_s, lds + AT_V + (slot_) * 16384 + 8192 + wid * 1024); } \
        else { const char* vb_ = (const char*)J.VTc + (size_t)((t__ - J.s_nt) * 64 + wid * 8) * 2; GLDS16(vb_ + lv_c, lds + AT_V + (slot_) * 16384 + wid * 1024); \
            if (VW == 128) GLDS16(vb_ + (size_t)128 * PAST + lv_c, lds + AT_V + (slot_) * 16384 + 8192 + wid * 1024); } } while (0)
#define ATT_NEED(t_) (!(J.window && (t_) < J.s_nt) || ((J.s_t0 + (t_) * 64 + 63 >= qw0 - 128) && (J.s_t0 + (t_) * 64 <= qw0 + 31 + 128)))
#define ATT_LDK(slot_) do { const LAS unsigned char* Kb = lds + AT_K + (slot_) * 8192 + (r32 >> 3) * 1024 + (r32 & 7) * 128; const int kx = ((r32 >> 1) & 7); \
        _Pragma("unroll") for (int ks = 0; ks < 4; ++ks) { kf[2 * ks] = *(const LAS bf16x8*)(Kb + (((2 * ks + hi) ^ kx) << 4)); kf[2 * ks + 1] = *(const LAS bf16x8*)(Kb + 4096 + (((2 * ks + hi) ^ kx) << 4)); } } while (0)
#define ATT_MMK(P0, P1) do { \
        P0 = __builtin_amdgcn_mfma_f32_32x32x16_bf16(kf[0], qf[0], negm, 0, 0, 0); P1 = __builtin_amdgcn_mfma_f32_32x32x16_bf16(kf[1], qf[0], negm, 0, 0, 0); \
        _Pragma("unroll") for (int ks = 1; ks < 4; ++ks) { P0 = __builtin_amdgcn_mfma_f32_32x32x16_bf16(kf[2 * ks], qf[ks], P0, 0, 0, 0); P1 = __builtin_amdgcn_mfma_f32_32x32x16_bf16(kf[2 * ks + 1], qf[ks], P1, 0, 0, 0); } } while (0)
#define ATT_LDV(VF, vslot_, b_) do { const LAS unsigned char* vb = lds + AT_V + (vslot_) * 16384 + ((b_) >> 1) * 8192 + (((b_) & 1) * 32 + r32) * 16 + hi * 1024; \
        _Pragma("unroll") for (int s_ = 0; s_ < 4; ++s_) VF[s_] = *(const LAS v4u*)(vb + (2 * s_) * 1024); } while (0)
#define ATT_MMV(VF, b_) do { _Pragma("unroll") for (int s_ = 0; s_ < 4; ++s_) o[b_] = __builtin_amdgcn_mfma_f32_32x32x16_bf16(__builtin_bit_cast(bf16x8, VF[s_]), __builtin_bit_cast(bf16x8, pw[s_]), o[b_], 0, 0, 0); } while (0)
#define ATT_SB __builtin_amdgcn_sched_barrier(0)
#define ATT_PVK(vslot_, kslot_, ldk_) do { ATT_LDV(vf0, vslot_, 0); ATT_LDV(vf1, vslot_, 1); ATT_SB; \
        if (VW == 128) { ATT_MMV(vf0, 0); ATT_SB; ATT_LDV(vf0, vslot_, 2 % NB); ATT_SB; ATT_MMV(vf1, 1); ATT_SB; ATT_LDV(vf1, vslot_, 3 % NB); ATT_SB; ATT_MMV(vf0, 2 % NB); ATT_SB; \
            ATT_MMV(vf1, 3 % NB); ATT_SB; if (ldk_) { ATT_LDK(kslot_); ATT_SB; } } \
        else { ATT_MMV(vf0, 0); ATT_MMV(vf1, 1); ATT_SB; if (ldk_) { ATT_LDK(kslot_); ATT_SB; } } } while (0)
#define ATT_MAX(PC0, PC1, t_) do { \
        if (J.window && (t_) < J.s_nt && !((J.s_t0 + (t_) * 64 >= qw0 + 31 - 128) && (J.s_t0 + (t_) * 64 + 63 <= qw0 + 128))) {     \
            int dbase = qw0 + r32 - (J.s_t0 + (t_) * 64) - 4 * hi; asm volatile("" : "+v"(dbase));     \
            _Pragma("unroll") for (int r = 0; r < 16; ++r) { int d0 = dbase - ((r & 3) + 8 * (r >> 2)); d0 = d0 < 0 ? -d0 : d0; int d1 = dbase - ((r & 3) + 8 * (r >> 2)) - 32; d1 = d1 < 0 ? -d1 : d1; \
                if (d0 > 128) PC0[r] = -INFINITY; if (d1 > 128) PC1[r] = -INFINITY; } } \
        float mx = fmaxf(fmaxf(PC0[0], PC1[0]), PC0[1]); \
        _Pragma("unroll") for (int r = 2; r < 16; r += 2) mx = fmaxf(fmaxf(mx, PC0[r]), PC0[r + 1]); \
        _Pragma("unroll") for (int r = 1; r < 15; r += 2) mx = fmaxf(fmaxf(mx, PC1[r]), PC1[r + 1]); \
        mx = fmaxf(mx, PC1[15]); { const auto rr_ = __builtin_amdgcn_permlane32_swap(__float_as_uint(mx), __float_as_uint(mx), false, false); mx = fmaxf(__uint_as_float(rr_[0]), __uint_as_float(rr_[1])); }     \
        if (__any(mx > ATT_THR)) { const float dl = fmaxf(mx, 0.f), f = __builtin_amdgcn_exp2f(-dl); mref += dl; lsum *= f; \
            _Pragma("unroll") for (int r = 0; r < 16; ++r) { PC0[r] -= dl; PC1[r] -= dl; negm[r] = -mref; } \
            _Pragma("unroll") for (int b = 0; b < NB; ++b) _Pragma("unroll") for (int r = 0; r < 16; ++r) o[b][r] *= f; } } while (0)
#define ATT_EXP(PC0, PC1) do { pg8::f32x2_t rs2 = {0.f, 0.f}; \
        _Pragma("unroll") for (int r = 0; r < 16; ++r) { PC0[r] = __builtin_amdgcn_exp2f(PC0[r]); PC1[r] = __builtin_amdgcn_exp2f(PC1[r]); } \
        _Pragma("unroll") for (int r = 0; r < 16; r += 2) { rs2 += (pg8::f32x2_t){PC0[r], PC0[r + 1]}; rs2 += (pg8::f32x2_t){PC1[r], PC1[r + 1]}; } \
        lsum += rs2[0] + rs2[1]; \
        _Pragma("unroll") for (int i = 0; i < 4; ++i) { pw[0][i] = pg8::cvt_pk_bf16(PC0[2 * i], PC0[2 * i + 1]); pw[1][i] = pg8::cvt_pk_bf16(PC0[8 + 2 * i], PC0[9 + 2 * i]); \
            pw[2][i] = pg8::cvt_pk_bf16(PC1[2 * i], PC1[2 * i + 1]); pw[3][i] = pg8::cvt_pk_bf16(PC1[8 + 2 * i], PC1[9 + 2 * i]); } } while (0)
#define ATT_WAITBAR(n_) asm volatile("s_waitcnt vmcnt(" #n_ ") lgkmcnt(0)\n\ts_barrier" ::: "memory")
#define ATT_TOP(t_) do { if (PROBE != 1) { if ((t_) + 3 < NT) ATT_ISSUE_K((t_) + 3, ((t_) + 3) & 3); if ((t_) + 2 < NT) ATT_ISSUE_V((t_) + 2, ((t_) + 2) & 3); } } while (0)
#define ATT_END(t_) do { if (PROBE == 1) ATT_WAITBAR(0); else if ((t_) + 3 < NT) { if (VW == 128) ATT_WAITBAR(3); else ATT_WAITBAR(2); } \
        else if ((t_) + 2 < NT) { if (VW == 128) ATT_WAITBAR(2); else ATT_WAITBAR(1); } else ATT_WAITBAR(0); } while (0)
    const bool grpA = wid < 4;
    __syncthreads();
    ATT_ISSUE_K(0, 0); ATT_ISSUE_V(0, 0); ATT_ISSUE_K(1, 1); ATT_ISSUE_V(1, 1); ATT_ISSUE_K(2, 2);
    { const bf16* qp = J.Q + (size_t)(wid * 32 + r32) * DIN + hi * 8;
      v4u raw[4];
#pragma unroll
      for (int ks = 0; ks < 4; ++ks) raw[ks] = *(const v4u*)(qp + ks * 16);
      float y[4][8]; float ss = 0.f;
#pragma unroll
      for (int ks = 0; ks < 4; ++ks) { unpack8(raw[ks], y[ks]);
#pragma unroll
          for (int j = 0; j < 8; ++j) ss += y[ks][j] * y[ks][j]; }
      { const auto rr_ = __builtin_amdgcn_permlane32_swap(__float_as_uint(ss), __float_as_uint(ss), false, false); ss = __uint_as_float(rr_[0]) + __uint_as_float(rr_[1]); }
      const float rstd = 1.0f / sqrtf(ss * (1.0f / 64.0f) + RMS_EPS);
#pragma unroll
      for (int ks = 0; ks < 4; ++ks) { const f32x4 g0 = *(const f32x4*)(J.qg + 16 * ks + 8 * hi), g1 = *(const f32x4*)(J.qg + 16 * ks + 8 * hi + 4);
#pragma unroll
          for (int j = 0; j < 4; ++j) { y[ks][j] = y[ks][j] * rstd * g0[j]; y[ks][4 + j] = y[ks][4 + j] * rstd * g1[j]; } }
      if (J.rope) { const int tq = J.q0 + wid * 32 + r32;
#pragma unroll
          for (int ax = 0; ax < 2; ++ax) { const int pos = ax ? (tq & 63) : (tq >> 6); const float* cp = J.tab + TAB_COS + pos * 16 + 8 * hi, * sp = J.tab + TAB_SIN + pos * 16 + 8 * hi;
              const f32x4 c0 = *(const f32x4*)cp, c1 = *(const f32x4*)(cp + 4), s0 = *(const f32x4*)sp, s1 = *(const f32x4*)(sp + 4);
#pragma unroll
              for (int j = 0; j < 8; ++j) { const float c = j < 4 ? c0[j & 3] : c1[j & 3], s = j < 4 ? s0[j & 3] : s1[j & 3]; const float a = y[2 * ax][j], b = y[2 * ax + 1][j];
                  y[2 * ax][j] = a * c - b * s; y[2 * ax + 1][j] = b * c + a * s; } } }
#pragma unroll
      for (int ks = 0; ks < 4; ++ks) {
#pragma unroll
          for (int j = 0; j < 8; ++j) y[ks][j] *= QSCALE;
          qf[ks] = __builtin_bit_cast(bf16x8, pack8(y[ks])); } }
    if (VW == 128) ATT_WAITBAR(3); else ATT_WAITBAR(2);
    f32x16 p0, p1; v4u pw[4], vf0[4], vf1[4]; bf16x8 kf[8];
    constexpr bool PF = (VW == 64);
    if (grpA) {
        if (PF) ATT_LDK(0);
#pragma unroll 1
        for (int t = 0; t < NT; ++t) {
            ATT_TOP(t);
            ATT_SB;
            if (t > 0) ATT_PVK((t - 1) & 3, t & 3, !PF); else if (!PF) { ATT_LDK(t & 3); ATT_SB; }
            ATT_MMK(p0, p1);
            ATT_SB;
            if (PF) { ATT_LDK((t + 1) & 3); }
            ATT_SB;
            ATT_MAX(p0, p1, t); ATT_EXP(p0, p1);
            ATT_END(t);
        }
        ATT_PVK((NT - 1) & 3, 0, false);
    } else {
        ATT_LDK(0); ATT_SB; ATT_MMK(p0, p1);
#pragma unroll 1
        for (int t = 0; t < NT; ++t) {
            ATT_TOP(t);
            if (PF) { ATT_LDK((t + 1) & 3); }
            ATT_SB;
            ATT_MAX(p0, p1, t); ATT_EXP(p0, p1);
            ATT_SB;
            ATT_PVK(t & 3, (t + 1) & 3, !PF);
            if (t + 1 < NT) ATT_MMK(p0, p1);
            ATT_END(t);
        }
    }
#undef ATT_TOP
#undef ATT_END
#undef ATT_WAITBAR
#undef ATT_MAX
#undef ATT_EXP
#undef ATT_LDK
#undef ATT_MMK
#undef ATT_LDV
#undef ATT_MMV
#undef ATT_PVK
#undef ATT_SB
#undef ATT_ISSUE_K
#undef ATT_ISSUE_V
#undef ATT_NEED
    float lt = lsum + shfl_xor_l(lsum, 32, lane);
    if (J.has_sink) lt += __builtin_amdgcn_exp2f(J.sink2 - mref);
    const float inv = 1.0f / lt;
    bf16* op = J.O + (size_t)(wid * 32 + r32) * J.opitch + 8 * hi;
#pragma unroll
    for (int b = 0; b < NB; ++b)
#pragma unroll
        for (int e = 0; e < 4; e += 2) {
            const unsigned a0 = pk2(o[b][4 * e] * inv, o[b][4 * e + 1] * inv), a1 = pk2(o[b][4 * e + 2] * inv, o[b][4 * e + 3] * inv);
            const unsigned b0 = pk2(o[b][4 * e + 4] * inv, o[b][4 * e + 5] * inv), b1 = pk2(o[b][4 * e + 6] * inv, o[b][4 * e + 7] * inv);
            const auto s0 = __builtin_amdgcn_permlane32_swap(a0, b0, false, false), s1 = __builtin_amdgcn_permlane32_swap(a1, b1, false, false);
            *(v4u*)(op + b * 32 + 8 * e) = (v4u){s0[0], s1[0], s0[1], s1[1]}; }
}
constexpr int AU_DL = 512, AU_CL = 1024, AU_BL = 1536, AU_DC = 1792, AU_CC = 2048, AU_END = 2304;
template <int PROBE>
__device__ __forceinline__ void attn_phase(const Params& p, int l, LAS unsigned char* lds) {
    const bf16* Z = wsb(p, WS_Z);
#pragma unroll 1
    for (int u = blockIdx.x; u < AU_END; u += gridDim.x) {
        AttnJob J; bool is128 = false; J.wv = p.ph_hi; J.tab = wsf(p, WS_TAB); J.rope = u < AU_BL; J.window = 0; J.has_sink = false; J.sink2 = 0.f; J.kspitch = DIN;
        const bool xdeal = gridDim.x == 256; const int xcd = blockIdx.x & 7, slot = blockIdx.x >> 3;
        if (u < AU_BL) {
            int v = u & 511; if (xdeal) { const int k = ((v >> 8) << 5) + slot; v = ((xcd * 4 + (k >> 4)) << 4) + (k & 15); }
            const int seq = v >> 7, qb = v & 15; const size_t rs0 = (size_t)M_C + (size_t)seq * T_L, rq = rs0 + qb * 256;
            J.q0 = qb * 256; J.s_t0 = 0; J.s_nt = 64; J.c_nt = 8; J.vtspitch = T_L;
            if (u < AU_DL) { const int hj = (v >> 4) & 7, h = hj >> 1;
                J.Q = Z + rq * DIN + ZC_QD + hj * 64; J.Ks = Z + rs0 * DIN + ZC_KD + hj * 64; J.VTs = wsb(p, VT_DL) + (size_t)((seq * 4 + h) * 128) * T_L;
                J.Kc = wsb(p, CK_DK) + (size_t)((seq * 4 + l) * 512) * 512 + hj * 64; J.kcpitch = 512; J.VTc = wsb(p, CK_DVT) + (size_t)((seq * 4 + l) * 512 + h * 128) * 512;
                J.O = wsb(p, WS_OD) + rq * 1024 + hj * 128; J.opitch = 1024;
                is128 = true;
            } else { const int head = (v >> 4) & 7, kvh = head >> 2; const bool isB = u >= AU_CL;
                J.Q = Z + rq * DIN + (isB ? ZC_QW : ZC_QG) + head * 64; J.Ks = Z + rs0 * DIN + (isB ? ZC_KW : ZC_KG) + kvh * 64; J.VTs = wsb(p, isB ? VT_BL : VT_CL) + (size_t)((seq * 2 + kvh) * 64) * T_L;
                J.Kc = wsb(p, isB ? CK_WK : CK_GK) + (size_t)((seq * 4 + l) * 512) * 128 + kvh * 64; J.kcpitch = 128; J.VTc = wsb(p, isB ? CK_WVT : CK_GVT) + (size_t)((seq * 4 + l) * 128 + kvh * 64) * 512;
                J.O = wsb(p, WS_BR) + (isB ? 1 : 2) * BRW + rq * BRP + head * 64; J.opitch = BRP;
                if (isB) { J.window = 1; J.has_sink = true; J.sink2 = inptr(I_WSINK)[l * 8 + head] * 1.4426950408889634f;
                    const int klo = J.q0 - 128 < 0 ? 0 : J.q0 - 128, khi = J.q0 + 384 > T_L ? T_L : J.q0 + 384; J.s_t0 = klo; J.s_nt = (khi - klo) >> 6; }
            }
        } else {
            int v = (u - AU_BL) & 255; if (xdeal) v = xcd * 32 + slot;
            const int seq = v >> 3; const size_t rs0 = (size_t)seq * T_C;
            J.q0 = 0; J.s_t0 = 0; J.s_nt = 4; J.c_nt = 0; J.vtspitch = T_C; J.Kc = Z; J.VTc = Z; J.kcpitch = 0;
            if (u < AU_DC) { const int hj = v & 7, h = hj >> 1;
                J.Q = Z + rs0 * DIN + ZC_QD + hj * 64; J.Ks = Z + rs0 * DIN + ZC_KD + hj * 64; J.VTs = wsb(p, VT_DC) + (size_t)((seq * 4 + h) * 128) * T_C;
                J.O = wsb(p, WS_OD) + rs0 * 1024 + hj * 128; J.opitch = 1024;
                is128 = true;
            } else { const int head = v & 7, kvh = head >> 2; const bool isB = u >= AU_CC;
                J.Q = Z + rs0 * DIN + (isB ? ZC_QW : ZC_QG) + head * 64; J.Ks = Z + rs0 * DIN + (isB ? ZC_KW : ZC_KG) + kvh * 64; J.VTs = wsb(p, isB ? VT_BC : VT_CC) + (size_t)((seq * 2 + kvh) * 64) * T_C;
                J.O = wsb(p, WS_BR) + (isB ? 1 : 2) * BRW + rs0 * BRP + head * 64; J.opitch = BRP;
                if (isB) { J.has_sink = true; J.sink2 = inptr(I_WSINK)[l * 8 + head] * 1.4426950408889634f; }
            }
        }
        J.qg = inptr(is128 ? I_DQN : J.has_sink ? I_WQN : I_GQN) + l * 64;
        if (PROBE) { J.O = wsb(p, WS_H) + (J.O - (is128 ? wsb(p, WS_OD) : wsb(p, WS_BR))); }
        if (is128) attn_unit<128, PROBE>(J, lds); else attn_unit<64, PROBE>(J, lds);
    }
}

constexpr int NPL = 10;
constexpr int N_PHASES = 1 + DEPTH * NPL;
#ifndef PG8_SP2
#define PG8_SP2 true
#endif
#ifndef PG8_ALIGN
#define PG8_ALIGN true
#endif
__global__ void __launch_bounds__(512, 2) fwd_kernel(Params p_) {
    extern __shared__ __attribute__((aligned(16))) unsigned char lds_raw[];
    LAS unsigned char* lds = (LAS unsigned char*)lds_raw;
    const int tid = threadIdx.x, G = gridDim.x;
    const int lo = p_.ph_lo, hi = p_.ph_hi;
    Params p = p_; p.ph_hi = __builtin_amdgcn_readfirstlane(tid >> 6);
    for (int u = tid; u < (LDS_BYTES - LDSCTL_OFF) / 4; u += 512) ((LAS unsigned*)(lds + LDSCTL_OFF))[u] = 0u;
    __syncthreads();
    XcdBarrier bar = xcd_barrier_post((unsigned*)(p.ws + WS_CTL) + 1024, (volatile LAS unsigned*)(lds + LDSCTL_OFF + 64), p.ph_hi);
#ifndef PH_MASK
#define PH_MASK 0xFFFFFFFFu
#endif
#define IN(k) (lo <= (k) && (k) < hi)
#define EN(b) ((PH_MASK >> (b)) & 1u)
#ifndef ATT_PROBE
#define ATT_PROBE 0
#endif
#ifndef DUP_MASK
#define DUP_MASK 0u
#endif
#define DUP(b) (((DUP_MASK >> (b)) & 1u) ? 2 : 1)
#define SEAM(k) do { if (IN(k) && IN((k) + 1)) xcd_barrier(bar); } while (0)

    if (IN(0) && EN(10)) for (int rep_ = 0; rep_ < DUP(10); ++rep_) { prologue_phase(p, lds); __syncthreads(); }
    SEAM(0);
#pragma unroll 1
    for (int l = 0; l < DEPTH; ++l) {
        const int pb = 1 + l * NPL;
        const bf16* WL = wsb(p, WS_W) + (size_t)l * WL_ELEMS;
        const float* modl = wsf(p, WS_MOD) + (size_t)l * 5 * 12288;
        if (IN(pb + 0) && EN(0)) for (int rep_ = 0; rep_ < DUP(0); ++rep_) { if (l == 0) norm_phase<false>(p, l, 0); else norm_phase<true>(p, l, 0); }
        SEAM(pb + 0);
        if (IN(pb + 1) && EN(1)) for (int rep_ = 0; rep_ < DUP(1); ++rep_) {
            { pg8::Gemm g{wsb(p, WS_H), WL + W_IN_T, MROWS, DIN, DMODEL, 0, 0, p.ph_hi}; pg8::StaticOrder S; S.init(MROWS, DIN, G, (int)blockIdx.x);
              pg8::EpiBf16<0> E{wsb(p, WS_Z), DIN, nullptr, 0};
              pg8::gemm_phase<pg8::EpiBf16<0>, pg8::StaticOrder, PG8_ALIGN, PG8_SP2>(lds, g, S, E); }
            { pg8::Gemm g{(const bf16*)(p.ws + WS_H8), (const bf16*)(p.ws + WS_W8 + (size_t)l * 8192 * 2048), MROWS, 4 * DMODEL, DMODEL / 2, 0, 0, p.ph_hi}; pg8::StaticOrder S; S.init(MROWS, 4 * DMODEL, G, (int)blockIdx.x);
              pg8::EpiGateU8 E{p.ws + WS_G, inptr(I_BGATE) + (size_t)l * 4 * DMODEL, 0};
              pg8::gemm_phase<pg8::EpiGateU8, pg8::StaticOrder, false, PG8_SP2>(lds, g, S, E); }
        }
        SEAM(pb + 1);
        if (IN(pb + 2) && EN(2)) { prep_phase(p, l, lds); __syncthreads(); for (int rep_ = 0; rep_ < DUP(2); ++rep_) lru_pass1(p, l, lds); }
        SEAM(pb + 2);
        if (IN(pb + 3) && EN(3)) {
#if ATT_PROBE
            attn_phase<ATT_PROBE>(p, l, lds); __syncthreads();
#endif
            for (int rep_ = 0; rep_ < DUP(3); ++rep_) { attn_phase<0>(p, l, lds); __syncthreads(); } for (int rep_ = 0; rep_ < DUP(11); ++rep_) lru_pass2(p, l, lds); }
        SEAM(pb + 3);
        if (IN(pb + 4) && EN(4)) for (int rep_ = 0; rep_ < DUP(4); ++rep_) dcomb_phase(p, l);
        SEAM(pb + 4);
        if (IN(pb + 5) && EN(5)) for (int rep_ = 0; rep_ < DUP(5); ++rep_) {
            pg8::Gemm g{wsb(p, WS_BR), WL + W_BR_T, MROWS, DMODEL, DMODEL, 0, 0, p.ph_hi}; pg8::StaticOrder S; S.init(MROWS, DMODEL, G, (int)blockIdx.x);
            pg8::EpiMerge E{p.ws + WS_G, wsb(p, WS_H)};
            pg8::gemm_phase<pg8::EpiMerge, pg8::StaticOrder, PG8_ALIGN, PG8_SP2>(lds, g, S, E);
        }
        SEAM(pb + 5);
        if (IN(pb + 6) && EN(6)) {
            pg8::Gemm g{wsb(p, WS_H), WL + W_O_T, MROWS, DMODEL, DMODEL, 0, 0, p.ph_hi}; pg8::StaticOrder S; S.init(MROWS, DMODEL, G, (int)blockIdx.x);
            if (l == 0) { pg8::EpiRes<false, true> E{inptr(I_XP), inptr(I_XS) - (size_t)M_C * DMODEL, p.ws + WS_XB, modl + 2 * 2048, nullptr, 0};
                pg8::gemm_phase<pg8::EpiRes<false, true>, pg8::StaticOrder, PG8_ALIGN, PG8_SP2>(lds, g, S, E); }
            else { pg8::EpiRes<true, true> E{p.ws + WS_XB, p.ws + WS_XB, p.ws + WS_XB, modl + 2 * 2048, nullptr, 0};
                pg8::gemm_phase<pg8::EpiRes<true, true>, pg8::StaticOrder, PG8_ALIGN, PG8_SP2>(lds, g, S, E); }
        }
        SEAM(pb + 6);
        if (IN(pb + 7) && EN(7)) norm_phase<true>(p, l, 1);
        SEAM(pb + 7);
        if (IN(pb + 8) && EN(8)) for (int rep_ = 0; rep_ < DUP(8); ++rep_) {
            pg8::Gemm g{wsb(p, WS_H), WL + W_FF1_T, MROWS, DFF, DMODEL, 0, 0, p.ph_hi}; pg8::StaticOrder S; S.init(MROWS, DFF, G, (int)blockIdx.x);
            pg8::EpiBf16<2> E{wsb(p, WS_G), DFF, inptr(I_BFF1) + (size_t)l * DFF, 0};
            pg8::gemm_phase<pg8::EpiBf16<2>, pg8::StaticOrder, PG8_ALIGN, PG8_SP2>(lds, g, S, E);
        }
        SEAM(pb + 8);
        if (IN(pb + 9) && EN(9)) {
            pg8::Gemm g{wsb(p, WS_G), WL + W_FF2_T, MROWS, DMODEL, DFF, 0, 0, p.ph_hi}; pg8::StaticOrder S; S.init(MROWS, DMODEL, G, (int)blockIdx.x);
            if (l == DEPTH - 1) { pg8::EpiRes<true, false> E{p.ws + WS_XB, p.ws + WS_XB, p.out, modl + 5 * 2048, inptr(I_BFF2) + (size_t)l * DMODEL, 0};
                pg8::gemm_phase<pg8::EpiRes<true, false>, pg8::StaticOrder, PG8_ALIGN, PG8_SP2>(lds, g, S, E); }
            else { pg8::EpiRes<true, true> E{p.ws + WS_XB, p.ws + WS_XB, p.ws + WS_XB, modl + 5 * 2048, inptr(I_BFF2) + (size_t)l * DMODEL, 0};
                pg8::gemm_phase<pg8::EpiRes<true, true>, pg8::StaticOrder, PG8_ALIGN, PG8_SP2>(lds, g, S, E); }
        }
        SEAM(pb + 9);
    }
#undef IN
#undef SEAM
}

#if DBG
#ifndef CHECK_L
#define CHECK_L 0
#endif
constexpr size_t DBG_ERR = WS_DBG;
constexpr size_t DBG_ZS = WS_DBG + 1 * MiB;
constexpr size_t DBG_XS = WS_DBG + 2 * MiB;
constexpr size_t DBG_XS2 = WS_DBG + 3 * MiB;
constexpr size_t DBG_SC = WS_DBG + 4 * MiB;
constexpr size_t DBG_END = WS_DBG + 16 * MiB;
__device__ __forceinline__ unsigned dh(unsigned x) { x ^= x >> 16; x *= 0x7feb352du; x ^= x >> 15; x *= 0x846ca68bu; x ^= x >> 16; return x; }
__device__ __forceinline__ int srow(int i) {
    switch (i) { case 0: return 0; case 1: return 1; case 2: return 255; case 3: return 256; case 4: return 511; case 5: return 8191; case 6: return 8192; case 7: return 8193; case 8: return 8192 + 127; case 9: return 8192 + 128;
        case 10: return 8192 + 4095; case 11: return 8192 + 4096; case 12: return 8192 + 8191; case 13: return 24575; case 14: return 24575 - 4096; case 15: return 4000; default: break; }
    return (int)(dh(i * 7919u + 13u) % (unsigned)MROWS);
}
__device__ __forceinline__ void rep(const Params& p, int stage, float got, float ref, float atol) {
    float e = fabsf(got - ref) / (fabsf(ref) + atol); if (!(e == e) || !(got == got)) e = 1e6f;
    atomicMax((unsigned*)(p.ws + DBG_ERR) + stage, __float_as_uint(e));
}
__device__ __forceinline__ float f8d(unsigned char b) { const int e = (b >> 3) & 15, m = b & 7; const float v = e ? ldexpf(1.0f + m * 0.125f, e - 7) : ldexpf(m * 0.125f, -6); return (b & 128) ? -v : v; }
__device__ __forceinline__ float bfr(float x) { return __uint_as_float(f2bf(x) << 16); }
__device__ __forceinline__ const float* xrow(const Params& p, int l, int r) { return (r < M_C ? xbase_ctx(p, l) : xbase_lat(p, l)) + (size_t)r * 2048; }
__device__ __forceinline__ int rcond(int r) { return r < M_C ? 0 : 1 + ((r - M_C) >> 12); }

__global__ void ck_prologue(Params p, int l) {
    const int gt = blockIdx.x * blockDim.x + threadIdx.x;
    const bf16* WL = wsb(p, WS_W) + (size_t)l * WL_ELEMS;
    {
        const unsigned h0 = dh(gt * 2654435761u + 1u), h1 = dh(h0 + 77u);
        { const int k = h0 % 2048, n = h1 % 4096; rep(p, 0, bf2f(WL[W_IN_T + (size_t)n * 2048 + k]), bfr(p.in[I_WIN][((size_t)l * 2048 + k) * 4096 + n]), 1e-6f); }
        { const int k = h0 % 2048, n = h1 % 8192; rep(p, 0, f8d(p.ws[WS_W8 + ((size_t)l * 8192 + n) * 2048 + k]) * 0.015625f * 0.5f, p.in[I_WGATE][((size_t)l * 2048 + k) * 8192 + n] * 0.5f, 0.02f); }
        { const int b = h0 & 3, k = (h0 >> 2) % 512, n = h1 % 2048; rep(p, 0, bf2f(WL[W_BR_T + (size_t)n * 2048 + b * 512 + k]), bfr(p.in[I_WBR][(((size_t)l * 4 + b) * 512 + k) * 2048 + n]), 1e-6f); }
        { const int k = h0 % 2048, n = h1 % 2048; rep(p, 0, bf2f(WL[W_O_T + (size_t)n * 2048 + k]), bfr(p.in[I_WO][((size_t)l * 2048 + k) * 2048 + n]), 1e-6f); }
        { const int k = h0 % 2048, n = h1 % 8192; rep(p, 0, bf2f(WL[W_FF1_T + (size_t)n * 2048 + k]), bfr(p.in[I_WFF1][((size_t)l * 2048 + k) * 8192 + n]), 1e-6f); }
        { const int k = h0 % 8192, n = h1 % 2048; rep(p, 0, bf2f(WL[W_FF2_T + (size_t)n * 8192 + k]), bfr(p.in[I_WFF2][((size_t)l * 8192 + k) * 2048 + n]), 1e-6f); }
        { const int bl = h0 & 15, s = (h0 >> 4) % 512, c = h1 % 128;
          rep(p, 2, bf2f(wsb(p, CK_WK)[((size_t)bl * 512 + s) * 128 + c]), bfr(p.in[I_CWK][((size_t)bl * 512 + s) * 128 + c]), 1e-6f);
          rep(p, 2, bf2f(wsb(p, CK_GK)[((size_t)bl * 512 + s) * 128 + c]), bfr(p.in[I_CGK][((size_t)bl * 512 + s) * 128 + c]), 1e-6f);
          rep(p, 2, bf2f(wsb(p, CK_WVT)[((size_t)bl * 128 + c) * 512 + (s ^ ((c & 16) >> 2))]), bfr(p.in[I_CWV][((size_t)bl * 512 + s) * 128 + c]), 1e-6f);
          rep(p, 2, bf2f(wsb(p, CK_GVT)[((size_t)bl * 128 + c) * 512 + (s ^ ((c & 16) >> 2))]), bfr(p.in[I_CGV][((size_t)bl * 512 + s) * 128 + c]), 1e-6f);
          const int c5 = h1 % 512;
          rep(p, 2, bf2f(wsb(p, CK_DK)[((size_t)bl * 512 + s) * 512 + c5]), bfr(p.in[I_CDK][((size_t)bl * 512 + s) * 512 + c5]), 1e-6f);
          rep(p, 2, bf2f(wsb(p, CK_DVT)[((size_t)bl * 512 + c5) * 512 + (s ^ ((c5 & 16) >> 2))]), bfr(p.in[I_CDV][((size_t)bl * 512 + s) * 512 + c5]), 1e-6f);
          const int g = h0 & 1, lkn = (h0 >> 1) & 63, c6 = (h0 >> 8) & 63, d6 = h1 & 63;
          rep(p, 2, bf2f(wsb(p, WS_LRUW)[((size_t)(g * 64 + lkn) * 64 + d6) * 64 + c6]), bfr(p.in[g ? I_LWI : I_LWR][((size_t)lkn * 64 + c6) * 64 + d6]), 1e-6f);
          const int pos = h0 & 63, f = h1 & 15; const float ang = (float)pos * powf(10000.f, -(float)f / 16.f);
          rep(p, 2, wsf(p, WS_TAB)[TAB_COS + pos * 16 + f], cosf(ang), 1e-3f); rep(p, 2, wsf(p, WS_TAB)[TAB_SIN + pos * 16 + f], sinf(ang), 1e-3f); }
    }
    if (gt < 1024) { const int cond = gt % 5, j = dh(gt) % 12288; float s = 0.f;
        for (int k = 0; k < 2048; ++k) { const float c = cond == 0 ? p.in[I_CCTX][k] : p.in[I_C][(cond - 1) * 2048 + k]; s += (c / (1.f + expf(-c))) * p.in[I_WADA][((size_t)l * 2048 + k) * 12288 + j]; }
        rep(p, 1, wsf(p, WS_MOD)[((size_t)l * 5 + cond) * 12288 + j], s + p.in[I_BADA][l * 12288 + j], 1e-2f); }
}
__global__ void ck_norm(Params p, int l, int which, int stage) {
    const int r = srow(blockIdx.x); const float* x = xrow(p, l + which, r); __shared__ float red[256];
    float ss = 0.f; for (int c = threadIdx.x; c < 2048; c += 256) ss += x[c] * x[c];
    red[threadIdx.x] = ss; __syncthreads(); for (int o = 128; o > 0; o >>= 1) { if (threadIdx.x < o) red[threadIdx.x] += red[threadIdx.x + o]; __syncthreads(); }
    const float rstd = 1.f / sqrtf(red[0] / 2048.f + 1e-6f); const float* modl = wsf(p, WS_MOD) + ((size_t)l * 5 + rcond(r)) * 12288 + (which ? 3 : 0) * 2048;
    const float* g = p.in[which ? I_N2G : I_N1G] + l * 2048;
    for (int c = threadIdx.x; c < 2048; c += 256) rep(p, stage, bf2f(wsb(p, WS_H)[(size_t)r * 2048 + c]), x[c] * rstd * g[c] * (1.f + modl[2048 + c]) + modl[c], 0.05f);
}
__global__ void ck_gemm(Params p, int l, int mode, int stage) {
    const int r = srow(blockIdx.x); const bf16* WL = wsb(p, WS_W) + (size_t)l * WL_ELEMS;
    const bf16* A; const bf16* Bt; int N, K;
    if (mode == 0) { A = wsb(p, WS_H); Bt = WL + W_IN_T; N = 4096; K = 2048; } else if (mode == 1) { A = wsb(p, WS_H); Bt = WL + W_GATE_T; N = 8192; K = 2048; }
    else if (mode == 2) { A = wsb(p, WS_H); Bt = WL + W_FF1_T; N = 8192; K = 2048; } else if (mode == 3) { A = wsb(p, WS_H); Bt = WL + W_O_T; N = 2048; K = 2048; }
    else { A = wsb(p, WS_G); Bt = WL + W_FF2_T; N = 2048; K = 8192; }
    const int n = dh(blockIdx.x * 1000u + threadIdx.x * 31u + mode) % N;
    float s = 0.f;
    if (mode == 1) { const unsigned char* a8 = p.ws + WS_H8 + (size_t)r * 2048; const unsigned char* b8 = p.ws + WS_W8 + ((size_t)l * 8192 + n) * 2048; for (int k = 0; k < 2048; ++k) s += f8d(a8[k]) * f8d(b8[k]); s *= 0.015625f; }
    else for (int k = 0; k < K; ++k) s += bf2f(A[(size_t)r * K + k]) * bf2f(Bt[(size_t)n * K + k]);
    const float* modl = wsf(p, WS_MOD) + ((size_t)l * 5 + rcond(r)) * 12288;
    if (mode == 0) rep(p, stage, bf2f(wsb(p, WS_Z)[(size_t)r * 4096 + n]), s, 0.05f);
    if (mode == 1) rep(p, stage, bf2f(wsb(p, WS_G)[(size_t)r * 8192 + n]), 1.f + expf(-(s + p.in[I_BGATE][l * 8192 + n])), 0.05f);
    if (mode == 2) { const float a = fmaxf(s + p.in[I_BFF1][l * 8192 + n], 0.f); rep(p, stage, bf2f(wsb(p, WS_G)[(size_t)r * 8192 + n]), a * a, 0.05f); }
    if (mode == 3) rep(p, stage, p.out[(size_t)r * 2048 + n], wsf(p, DBG_XS)[(size_t)blockIdx.x * 2048 + n] + modl[2 * 2048 + n] * s, 0.05f);
    if (mode == 4) rep(p, stage, p.out[(size_t)r * 2048 + n], wsf(p, DBG_XS2)[(size_t)blockIdx.x * 2048 + n] + modl[5 * 2048 + n] * (s + p.in[I_BFF2][l * 2048 + n]), 0.05f);
}
__global__ void ck_save_z(Params p) { const int r = srow(blockIdx.x); for (int c = threadIdx.x; c < 4096; c += blockDim.x) wsb(p, DBG_ZS)[(size_t)blockIdx.x * 4096 + c] = wsb(p, WS_Z)[(size_t)r * 4096 + c]; }
__global__ void ck_save_x(Params p, int l, size_t dst) { const int r = srow(blockIdx.x); const float* x = xrow(p, l, r); for (int c = threadIdx.x; c < 2048; c += blockDim.x) wsf(p, dst)[(size_t)blockIdx.x * 2048 + c] = x[c]; }
__global__ void ck_prep(Params p, int l, int st) {
    const int r = srow(blockIdx.x); const bf16* zs = wsb(p, DBG_ZS) + (size_t)blockIdx.x * 4096; const bf16* z = wsb(p, WS_Z) + (size_t)r * 4096;
    const bool isctx = r < M_C; const int seq = isctx ? r >> 8 : (r - M_C) >> 12, t = isctx ? r & 255 : (r - M_C) & 4095;
    for (int idx = threadIdx.x; idx < 36 * 64; idx += blockDim.x) {
        const int v = idx >> 6, d = idx & 63;
        int col; const float* gain; bool isq; size_t ko = 0;
        if (v < 8) { col = ZC_QW + v * 64; gain = p.in[I_WQN]; isq = true; } else if (v < 10) { col = ZC_KW + (v - 8) * 64; gain = p.in[I_WKN]; isq = false; ko = O_WK + ((size_t)(seq * 4 + l) * 256 + t) * 128 + (v - 8) * 64; }
        else if (v < 18) { col = ZC_QG + (v - 10) * 64; gain = p.in[I_GQN]; isq = true; } else if (v < 20) { col = ZC_KG + (v - 18) * 64; gain = p.in[I_GKN]; isq = false; ko = O_GK + ((size_t)(seq * 4 + l) * 256 + t) * 128 + (v - 18) * 64; }
        else if (v < 28) { col = ZC_QD + (v - 20) * 64; gain = p.in[I_DQN]; isq = true; } else { col = ZC_KD + (v - 28) * 64; gain = p.in[I_DKN]; isq = false; ko = O_DK + ((size_t)(seq * 4 + l) * 256 + t) * 512 + (v - 28) * 64; }
        float ss = 0.f; for (int e = 0; e < 64; ++e) { const float xe = bf2f(zs[col + e]); ss += xe * xe; }
        const float rstd = 1.f / sqrtf(ss / 64.f + 1e-6f);
        float y = bf2f(zs[col + d]) * rstd * gain[l * 64 + d];
        if (isctx && !isq) rep(p, st + 1, p.out[ko + d], y, 0.02f);
        if (!isctx) { const int axis = d >> 5, half = (d >> 4) & 1, f = d & 15; const float pos = axis ? (float)(t & 63) : (float)(t >> 6); const float ang = pos * powf(10000.f, -(float)f / 16.f), c = cosf(ang), sn = sinf(ang);
            const float x1 = bf2f(zs[col + axis * 32 + f]) * rstd * gain[l * 64 + axis * 32 + f], x2 = bf2f(zs[col + axis * 32 + 16 + f]) * rstd * gain[l * 64 + axis * 32 + 16 + f]; y = half ? x2 * c + x1 * sn : x1 * c - x2 * sn; }
        if (isq) y *= 0.125f * 1.4426950408889634f;
        rep(p, st, bf2f(z[col + d]), y, 0.03f);
    }
    for (int idx = threadIdx.x; idx < 96 * 8; idx += blockDim.x) {
        const int g = idx >> 3, j = idx & 7; int col; size_t vo; const bf16* vt; const int T = isctx ? T_C : T_L;
        if (g < 16) { col = ZC_VW + g * 8; vo = O_WV + ((size_t)(seq * 4 + l) * 256 + t) * 128 + g * 8; vt = wsb(p, isctx ? VT_BC : VT_BL) + (size_t)(seq * 128 + g * 8) * T; }
        else if (g < 32) { col = ZC_VG + (g - 16) * 8; vo = O_GV + ((size_t)(seq * 4 + l) * 256 + t) * 128 + (g - 16) * 8; vt = wsb(p, isctx ? VT_CC : VT_CL) + (size_t)(seq * 128 + (g - 16) * 8) * T; }
        else { col = ZC_VD + (g - 32) * 8; vo = O_DV + ((size_t)(seq * 4 + l) * 256 + t) * 512 + (g - 32) * 8; vt = wsb(p, isctx ? VT_DC : VT_DL) + (size_t)(seq * 512 + (g - 32) * 8) * T; }
        const float zv = bf2f(zs[col + j]); if (isctx) rep(p, st + 1, p.out[vo + j], zv, 1e-3f); rep(p, st + 2, bf2f(vt[(size_t)j * T + (t ^ ((((g < 16 ? g : g < 32 ? g - 16 : g - 32) * 8 + j) & 16) >> 2))]), zv, 1e-6f); rep(p, st + 2, bf2f(z[col + j]), zv, 1e-6f);
    }
}
__global__ void ck_lru(Params p, int l, int stage) {
    const int i = blockIdx.x * blockDim.x + threadIdx.x; if (i >= 48) return;
    const bool lat = i < 16; const int seq = lat ? (i & 3) : (int)(dh(i) % 32u), ch = lat ? (int)(dh(i * 3u + 5u) % 512u) : (int)(dh(i * 5u + 1u) % 512u), n = ch >> 6, cl = ch & 63;
    const int T = lat ? T_L : T_C, row0 = lat ? M_C + seq * T_L : seq * T_C; const bf16* Z = wsb(p, WS_Z); float* HF = wsf(p, DBG_SC) + (size_t)i * 4096;
    for (int dir = 0; dir < 2; ++dir) {
        float h = lat ? p.in[I_SLRU][((size_t)(seq * 4 + l) * 2 + dir) * 512 + ch] : 0.f;
        const float spl = log1pf(expf(-p.in[I_LLAM][(l * 2 + dir) * 512 + ch]));
        for (int s = 0; s < T; ++s) { const int t = dir ? T - 1 - s : s;
            float pr = p.in[I_LBR][(l * 2 + dir) * 512 + ch], pi = p.in[I_LBI][(l * 2 + dir) * 512 + ch], umine = 0.f;
            for (int c = 0; c < 64; ++c) { float u = p.in[I_CONVB][l * 512 + n * 64 + c];
                for (int k = 0; k < 4; ++k) { const int tk = t + k - 1; if (tk >= 0 && tk < T) u += p.in[I_CONVW][(l * 4 + k) * 512 + n * 64 + c] * bf2f(Z[(size_t)(row0 + tk) * 4096 + n * 64 + c]); }
                if (c == cl) umine = u;
                const float ub = bfr(u);
                pr += ub * bfr(p.in[I_LWR][((size_t)((l * 2 + dir) * 8 + n) * 64 + c) * 64 + cl]); pi += ub * bfr(p.in[I_LWI][((size_t)((l * 2 + dir) * 8 + n) * 64 + c) * 64 + cl]); }
            const float rg = 1.f / (1.f + expf(-pr)), ig = 1.f / (1.f + expf(-pi)), la = -8.f * rg * spl, a = expf(la), b = sqrtf(-expm1f(2.f * la)) * ig * umine;
            h = a * h + b;
            if (dir == 0) HF[t] = h;
            else { const float y = bf2f(Z[(size_t)(row0 + t) * 4096 + 512 + ch]); const float gl = 0.5f * y * (1.f + tanhf(0.7978845608028654f * (y + 0.044715f * y * y * y)));
                rep(p, stage, bf2f(wsb(p, WS_BR)[(size_t)(row0 + t) * BRP + ch]), (HF[t] + h) * gl, 0.02f); }
        }
        if (!lat) rep(p, stage + 1, p.out[O_LS + ((size_t)(seq * 4 + l) * 2 + dir) * 512 + ch], h, 0.02f);
    }
}
__global__ void ck_attn(Params p, int l, int stage) {
    const int i = blockIdx.x, lane = threadIdx.x; const unsigned h0 = dh(i * 97u + 3u), h1 = dh(h0 + 11u);
    const int type = i % 3; const bool lat = (i / 3) & 1; const int seq = lat ? (h0 & 3) : (h0 & 31), head = (h0 >> 5) & 7;
    int t = lat ? (int)(h1 % 4096u) : (int)(h1 % 256u); if (i < 12) t = (i & 1) ? (lat ? 4095 : 255) : 0; if (i >= 12 && i < 24 && lat) t = 128 + (i & 1);
    const int T = lat ? T_L : T_C, row0 = lat ? M_C + seq * T_L : seq * T_C, r = row0 + t; const bf16* Z = wsb(p, WS_Z); __shared__ float SC[4608];
    int qcol, kcol, vcol, vw, kvh; const float* ck; const float* cv; int cpitch, ckoff, cvoff;
    if (type == 0) { kvh = head >> 2; qcol = ZC_QW + head * 64; kcol = ZC_KW + kvh * 64; vcol = ZC_VW + kvh * 64; vw = 64; ck = p.in[I_CWK]; cv = p.in[I_CWV]; cpitch = 128; ckoff = kvh * 64; cvoff = kvh * 64; }
    else if (type == 1) { kvh = head >> 2; qcol = ZC_QG + head * 64; kcol = ZC_KG + kvh * 64; vcol = ZC_VG + kvh * 64; vw = 64; ck = p.in[I_CGK]; cv = p.in[I_CGV]; cpitch = 128; ckoff = kvh * 64; cvoff = kvh * 64; }
    else { qcol = ZC_QD + head * 64; kcol = ZC_KD + head * 64; vcol = ZC_VD + (head >> 1) * 128; vw = 128; ck = p.in[I_CDK]; cv = p.in[I_CDV]; cpitch = 512; ckoff = head * 64; cvoff = (head >> 1) * 128; }
    const int nk = lat ? T_L + PAST : T_C; float q[64];
#pragma unroll
    for (int d = 0; d < 64; ++d) q[d] = bf2f(Z[(size_t)r * 4096 + qcol + d]);
    float mx = -1e30f;
    for (int k = lane; k < nk; k += 64) { float s = 0.f; bool ok = true;
        if (k < T) {
#pragma unroll
            for (int d = 0; d < 64; ++d) s += q[d] * bf2f(Z[(size_t)(row0 + k) * 4096 + kcol + d]); if (type == 0 && lat) { int dd = t - k; dd = dd < 0 ? -dd : dd; ok = dd <= 128; } }
        else { const float* kp = ck + ((size_t)(seq * 4 + l) * 512 + (k - T)) * cpitch + ckoff;
#pragma unroll
            for (int d = 0; d < 64; ++d) s += q[d] * kp[d]; }
        s = ok ? s : -INFINITY; SC[k] = s; mx = fmaxf(mx, s); }
    for (int o = 32; o > 0; o >>= 1) mx = fmaxf(mx, __shfl_xor(mx, o));
    float sum = 0.f; for (int k = lane; k < nk; k += 64) { const float e = exp2f(SC[k] - mx); SC[k] = e; sum += e; }
    for (int o = 32; o > 0; o >>= 1) sum += __shfl_xor(sum, o);
    __syncthreads();
    if (type == 0) sum += exp2f(p.in[I_WSINK][l * 8 + head] * 1.4426950408889634f - mx);
    __syncthreads();
    for (int d = lane; d < vw; d += 64) { float o = 0.f;
        for (int k = 0; k < nk; ++k) { const float v = k < T ? bf2f(Z[(size_t)(row0 + k) * 4096 + vcol + d]) : cv[((size_t)(seq * 4 + l) * 512 + (k - T)) * cpitch + cvoff + d]; o += SC[k] * v; }
        o /= sum;
        const float got = type == 0 ? bf2f(wsb(p, WS_BR)[(size_t)r * BRP + 512 + head * 64 + d]) : type == 1 ? bf2f(wsb(p, WS_BR)[(size_t)r * BRP + 1024 + head * 64 + d]) : bf2f(wsb(p, WS_OD)[(size_t)r * 1024 + head * 128 + d]);
        rep(p, stage + type, got, o, 0.02f); }
}
__global__ void ck_dcomb(Params p, int l, int stage) {
    const int r = srow(blockIdx.x), h = threadIdx.x >> 7, e = threadIdx.x & 127; __shared__ float red[512];
    float s1 = 0.f, s2 = 0.f; for (int d = 0; d < 64; ++d) { s1 += p.in[I_LQ1][l * 64 + d] * p.in[I_LK1][l * 64 + d]; s2 += p.in[I_LQ2][l * 64 + d] * p.in[I_LK2][l * 64 + d]; }
    const float li = 0.8f - 0.6f * expf(-0.3f * l), lam = expf(s1) - expf(s2) + li;
    const float o = bf2f(wsb(p, WS_OD)[(size_t)r * 1024 + (h * 2) * 128 + e]) - lam * bf2f(wsb(p, WS_OD)[(size_t)r * 1024 + (h * 2 + 1) * 128 + e]);
    red[threadIdx.x] = o * o; __syncthreads(); for (int st = 64; st > 0; st >>= 1) { if (e < st) red[threadIdx.x] += red[threadIdx.x + st]; __syncthreads(); }
    rep(p, stage, bf2f(wsb(p, WS_BR)[(size_t)r * BRP + 1536 + h * 128 + e]), o / sqrtf(red[h * 128] / 128.f + 1e-6f) * p.in[I_DOG][l * 128 + e] * (1.f - li), 0.02f);
}
__global__ void ck_merge(Params p, int l, int stage) {
    const int r = srow(blockIdx.x), n = dh(blockIdx.x * 777u + threadIdx.x) % 2048; const bf16* WL = wsb(p, WS_W) + (size_t)l * WL_ELEMS; float tot = 0.f;
    for (int b = 0; b < 4; ++b) { float s = 0.f; for (int c = 0; c < 512; ++c) s += bf2f(wsb(p, WS_BR)[(size_t)r * BRP + b * 512 + c]) * bf2f(WL[W_BR_T + (size_t)n * 2048 + b * 512 + c]);
        tot += s / bf2f(wsb(p, WS_G)[(size_t)r * 8192 + b * 2048 + n]); }
    rep(p, stage, bf2f(wsb(p, WS_H)[(size_t)r * 2048 + n]), tot, 0.05f);
}
__global__ void ck_encode(Params p) {
    if (threadIdx.x || blockIdx.x) return; const float* e = wsf(p, DBG_ERR);
    for (int s = 0; s < 64; ++s) if (e[s] > 0.06f) { int q = (int)floorf(log10f(e[s])); q = q < -6 ? -6 : q > 3 ? 3 : q; p.out[0] = (float)(10 + s) * powf(10.f, (float)(12 + q)); return; }
}
static void dbg_run(Params p, int grid, hipStream_t stream) {
    (void)hipMemsetAsync(p.ws + DBG_ERR, 0, 256, stream);
    auto ph = [&](int k) { p.ph_lo = k; p.ph_hi = k + 1; hipLaunchKernelGGL(fwd_kernel, dim3(grid), dim3(512), LDS_BYTES, stream, p); };
    ph(0);
    hipLaunchKernelGGL(ck_prologue, dim3(64), dim3(256), 0, stream, p, CHECK_L);
    for (int l = 0; l < DEPTH; ++l) {
        const int pb = 1 + l * NPL; const bool c = (l == CHECK_L);
        ph(pb + 0); if (c) hipLaunchKernelGGL(ck_norm, dim3(64), dim3(256), 0, stream, p, l, 0, 3);
        ph(pb + 1); if (c) { hipLaunchKernelGGL(ck_gemm, dim3(64), dim3(128), 0, stream, p, l, 0, 4); hipLaunchKernelGGL(ck_gemm, dim3(64), dim3(128), 0, stream, p, l, 1, 5); hipLaunchKernelGGL(ck_save_z, dim3(64), dim3(256), 0, stream, p); }
        ph(pb + 2); if (c) hipLaunchKernelGGL(ck_prep, dim3(64), dim3(256), 0, stream, p, l, 6);
        ph(pb + 3); if (c) { hipLaunchKernelGGL(ck_lru, dim3(1), dim3(64), 0, stream, p, l, 9); hipLaunchKernelGGL(ck_attn, dim3(240), dim3(64), 0, stream, p, l, 11); }
        ph(pb + 4); if (c) hipLaunchKernelGGL(ck_dcomb, dim3(64), dim3(512), 0, stream, p, l, 14);
        ph(pb + 5); if (c) { hipLaunchKernelGGL(ck_merge, dim3(64), dim3(128), 0, stream, p, l, 15); hipLaunchKernelGGL(ck_save_x, dim3(64), dim3(256), 0, stream, p, l, DBG_XS); }
        ph(pb + 6); if (c) { hipLaunchKernelGGL(ck_gemm, dim3(64), dim3(128), 0, stream, p, l, 3, 16); hipLaunchKernelGGL(ck_save_x, dim3(64), dim3(256), 0, stream, p, l + 1, DBG_XS2); }
        ph(pb + 7); if (c) hipLaunchKernelGGL(ck_norm, dim3(64), dim3(256), 0, stream, p, l, 1, 17);
        ph(pb + 8); if (c) hipLaunchKernelGGL(ck_gemm, dim3(64), dim3(128), 0, stream, p, l, 2, 18);
        ph(pb + 9); if (c) hipLaunchKernelGGL(ck_gemm, dim3(64), dim3(128), 0, stream, p, l, 4, 19);
    }
    hipLaunchKernelGGL(ck_encode, dim3(1), dim3(64), 0, stream, p);
}
#endif

extern "C" void kernel_launch(void* const* d_in, const int* in_sizes, int n_in, void* d_out, int out_size, void* d_ws, size_t ws_size, hipStream_t stream) {
    static int grid = 0;
    if (grid == 0) {
        size_t need = WS_END;
#if DBG
        need = DBG_END;
#endif
        if (n_in != N_IN || (size_t)out_size != O_END || ws_size < need) { fprintf(stderr, "kernel_launch: unexpected sizes: n_in %d out %d ws %zu (need %zu); nothing launched\n", n_in, out_size, ws_size, need); grid = -1; return; }
        int dev = 0, cus = 0, per_cu = 0;
        if (hipGetDevice(&dev) != hipSuccess || hipDeviceGetAttribute(&cus, hipDeviceAttributeMultiprocessorCount, dev) != hipSuccess) { grid = -1; return; }
        if (hipFuncSetAttribute((const void*)fwd_kernel, hipFuncAttributeMaxDynamicSharedMemorySize, LDS_BYTES) != hipSuccess) { fprintf(stderr, "kernel_launch: hipFuncSetAttribute failed\n"); grid = -1; return; }
        if (hipOccupancyMaxActiveBlocksPerMultiprocessor(&per_cu, (const void*)fwd_kernel, 512, LDS_BYTES) != hipSuccess || per_cu < 1) { fprintf(stderr, "kernel_launch: occupancy query says %d\n", per_cu); grid = -1; (void)hipGetLastError(); return; }
        grid = cus;
    }
    if (grid < 0) return;
    (void)hipMemsetAsync(d_ws, 0, ZERO_BYTES, stream);
    Params p{};
    for (int i = 0; i < N_IN; ++i) p.in[i] = (const float*)d_in[i];
    p.out = (float*)d_out; p.ws = (unsigned char*)d_ws;
#if DBG
    dbg_run(p, grid, stream);
#else
#if MULTI
    for (int ph = 0; ph < N_PHASES; ++ph) { p.ph_lo = ph; p.ph_hi = ph + 1; hipLaunchKernelGGL(fwd_kernel, dim3(grid), dim3(512), LDS_BYTES, stream, p); }
#else
    p.ph_lo = 0; p.ph_hi = N_PHASES;
    hipLaunchKernelGGL(fwd_kernel, dim3(grid), dim3(512), LDS_BYTES, stream, p);
#endif
#endif
}
```
